# Optimizing an MI355X kernel written in HIP

```python
import math
import jax, jax.numpy as jnp
from jax import lax
import numpy as np

D_MODEL = 1024
BATCH = 4
SEQ = 8192
DEPTH = 2
DEC_BATCH = 128
DEC_SEQ = 4
PAST_LEN = 16384
PAGE_SIZE = 128

HEAD_DIM = 64
N_Q_HEADS = 8
N_KV_HEADS = 2
Q_PER_KV = N_Q_HEADS // N_KV_HEADS
ATTN_WIDTH = N_Q_HEADS * HEAD_DIM
KV_WIDTH = N_KV_HEADS * HEAD_DIM
WINDOW = 128
ROPE_THETA = 10000.0
ATTN_SCALE = HEAD_DIM ** -0.5

SSM_HEAD_DIM = 64
N_SSM_HEADS = 16
SSM_WIDTH = N_SSM_HEADS * SSM_HEAD_DIM
N_SSM_GROUPS = 2
HEADS_PER_GROUP = N_SSM_HEADS // N_SSM_GROUPS
D_STATE = 128
CONV_W = 4
CONV_DIM = SSM_WIDTH + 2 * N_SSM_GROUPS * D_STATE
SSD_CHUNK = 128

MIX_WIDTH = ATTN_WIDTH + SSM_WIDTH
SPLITS = [ATTN_WIDTH,
          ATTN_WIDTH + KV_WIDTH,
          ATTN_WIDTH + 2 * KV_WIDTH,
          ATTN_WIDTH + 2 * KV_WIDTH + SSM_WIDTH,
          ATTN_WIDTH + 2 * KV_WIDTH + SSM_WIDTH + CONV_DIM]
IN_PROJ_WIDTH = ATTN_WIDTH + 2 * KV_WIDTH + SSM_WIDTH + CONV_DIM + N_SSM_HEADS

D_FF = -(-8 * D_MODEL // (3 * 256)) * 256
EPS = 1e-6

kernel_name = "hymba_swa_sink_ssd_step"


def rms_norm(x, g):
    xf = x.astype(jnp.float32)
    y = xf * lax.rsqrt(jnp.mean(xf * xf, axis=-1, keepdims=True) + EPS)
    return (y * g.astype(jnp.float32)).astype(x.dtype)


def rope(x, pos):
    half = HEAD_DIM // 2
    inv = ROPE_THETA ** (-jnp.arange(half, dtype=jnp.float32) / half)
    ang = pos.astype(jnp.float32)[:, None] * inv[None, :]
    cos = jnp.cos(ang)[None, :, None, :]
    sin = jnp.sin(ang)[None, :, None, :]
    xf = x.astype(jnp.float32)
    x1, x2 = xf[..., :half], xf[..., half:]
    return jnp.concatenate([x1 * cos - x2 * sin, x2 * cos + x1 * sin], axis=-1).astype(x.dtype)


def sink_softmax(s, sinks):
    sk = sinks.astype(jnp.float32).reshape(N_KV_HEADS, Q_PER_KV)[:, :, None, None]
    m = jnp.maximum(jnp.max(s, axis=-1, keepdims=True), sk)
    p = jnp.exp(s - m)
    return p / (jnp.sum(p, axis=-1, keepdims=True) + jnp.exp(sk - m))


def banded_window_attention(q, k, v, sinks):
    b, S = q.shape[:2]
    nb = S // WINDOW
    qb = q.reshape(b, nb, WINDOW, N_KV_HEADS, Q_PER_KV, HEAD_DIM)
    kb = k.reshape(b, nb, WINDOW, N_KV_HEADS, HEAD_DIM)
    vb = v.reshape(b, nb, WINDOW, N_KV_HEADS, HEAD_DIM)

    def with_prev(t):
        prev = jnp.pad(t[:, :-1], ((0, 0), (1, 0), (0, 0), (0, 0), (0, 0)))
        return jnp.concatenate([prev, t], axis=2)

    kk, vv = with_prev(kb), with_prev(vb)
    s = jnp.einsum('bnqgrd,bnkgd->bngrqk', qb, kk,
                   preferred_element_type=jnp.float32) * ATTN_SCALE
    qi = jnp.arange(WINDOW)[:, None]
    kj = jnp.arange(2 * WINDOW)[None, :]
    diff = qi + WINDOW - kj
    band = (diff >= 0) & (diff < WINDOW)
    mask = band[None] & ((jnp.arange(nb)[:, None, None] > 0) | (kj[None] >= WINDOW))
    s = jnp.where(mask[:, None, None], s, -jnp.inf)
    p = sink_softmax(s, sinks)
    o = jnp.einsum('bngrqk,bnkgd->bnqgrd', p.astype(v.dtype), vv)
    return o.reshape(b, S, ATTN_WIDTH)


def cached_window_attention(q, k, v, k_cache, v_cache, sinks, pos):
    b, T = q.shape[:2]
    C = k_cache.shape[1]
    kk = jnp.concatenate([k_cache.astype(k.dtype), k], axis=1)
    vv = jnp.concatenate([v_cache.astype(v.dtype), v], axis=1)
    qg = q.reshape(b, T, N_KV_HEADS, Q_PER_KV, HEAD_DIM)
    s = jnp.einsum('btgrd,bkgd->bgrtk', qg, kk,
                   preferred_element_type=jnp.float32) * ATTN_SCALE
    k_pos = jnp.concatenate([pos[0] - C + jnp.arange(C, dtype=jnp.int32), pos])
    diff = pos[:, None] - k_pos[None, :]
    mask = (diff >= 0) & (diff < WINDOW)
    s = jnp.where(mask, s, -jnp.inf)
    p = sink_softmax(s, sinks)
    o = jnp.einsum('bgrtk,bkgd->btgrd', p.astype(v.dtype), vv)
    return o.reshape(b, T, ATTN_WIDTH), kk[:, T:], vv[:, T:]


def causal_conv(xbc, conv_state, w, bias):
    L = xbc.shape[1]
    xp = jnp.concatenate([conv_state.astype(xbc.dtype), xbc], axis=1)
    out = sum(xp[:, i:i + L] * w[i] for i in range(CONV_W)) + bias
    return jax.nn.silu(out), xp[:, L:]


def ssd_scan(x, dt, A, Bm, Cm, h0):
    b, L = x.shape[:2]
    Q = min(SSD_CHUNK, L)
    pad = (-L) % Q
    xf = x.astype(jnp.float32)
    Bf = Bm.astype(jnp.float32)
    Cf = Cm.astype(jnp.float32)
    if pad:
        xf = jnp.pad(xf, ((0, 0), (0, pad), (0, 0), (0, 0)))
        dt = jnp.pad(dt, ((0, 0), (0, pad), (0, 0)))
        Bf = jnp.pad(Bf, ((0, 0), (0, pad), (0, 0), (0, 0)))
        Cf = jnp.pad(Cf, ((0, 0), (0, pad), (0, 0), (0, 0)))
    c = (L + pad) // Q
    G, Hg, P, N = N_SSM_GROUPS, HEADS_PER_GROUP, SSM_HEAD_DIM, D_STATE
    xc = xf.reshape(b, c, Q, G, Hg, P)
    dtc = dt.reshape(b, c, Q, G, Hg)
    Bc = Bf.reshape(b, c, Q, G, N)
    Cc = Cf.reshape(b, c, Q, G, N)
    acum = jnp.cumsum(dtc * A.astype(jnp.float32).reshape(G, Hg), axis=2)
    acT = jnp.moveaxis(acum, 2, -1)
    seg = acT[..., :, None] - acT[..., None, :]
    causal = jnp.tril(jnp.ones((Q, Q), dtype=bool))
    decay = jnp.exp(jnp.where(causal, seg, -jnp.inf))
    cb = jnp.einsum('bcqgn,bcsgn->bcgqs', Cc, Bc)
    xdt = xc * dtc[..., None]
    y_intra = jnp.einsum('bcghqs,bcsghp->bcqghp', cb[:, :, :, None] * decay, xdt)
    decay_end = jnp.exp(acum[:, :, -1:] - acum)
    states = jnp.einsum('bcsgn,bcsghp->bcghpn', Bc, xdt * decay_end[..., None])
    chunk_decay = jnp.exp(acum[:, :, -1])

    def step(h, inp):
        st, dc = inp
        return h * dc[..., None, None] + st, h

    h_init = h0.astype(jnp.float32).reshape(b, G, Hg, P, N)
    h_final, h_starts = lax.scan(step, h_init,
                                 (jnp.moveaxis(states, 1, 0), jnp.moveaxis(chunk_decay, 1, 0)))
    h_starts = jnp.moveaxis(h_starts, 0, 1)
    y_inter = jnp.einsum('bcqgn,bcghpn->bcqghp', Cc, h_starts) * jnp.exp(acum)[..., None]
    y = (y_intra + y_inter).reshape(b, c * Q, N_SSM_HEADS, P)[:, :L]
    return y, h_final.reshape(b, N_SSM_HEADS, P, N)


def hybrid_layer(x, pos, win_kv, conv_state, ssm_state, p):
    b, L, _ = x.shape
    u = rms_norm(x, p['norm_mix'])
    proj = u @ p['w_in']
    q, k, v, z, xbc, dt_raw = jnp.split(proj, SPLITS, axis=-1)
    q = rope(rms_norm(q.reshape(b, L, N_Q_HEADS, HEAD_DIM), p['q_norm']), pos)
    k = rope(rms_norm(k.reshape(b, L, N_KV_HEADS, HEAD_DIM), p['k_norm']), pos)
    v = v.reshape(b, L, N_KV_HEADS, HEAD_DIM)
    if win_kv is None:
        o_attn = banded_window_attention(q, k, v, p['sinks'])
        n_keep = min(WINDOW, L)
        new_k, new_v = k[:, L - n_keep:], v[:, L - n_keep:]
    else:
        o_attn, new_k, new_v = cached_window_attention(q, k, v, win_kv[0], win_kv[1],
                                                       p['sinks'], pos)
    xbc_act, new_conv = causal_conv(xbc, conv_state, p['conv_w'], p['conv_b'])
    xs, Bm, Cm = jnp.split(xbc_act, [SSM_WIDTH, SSM_WIDTH + N_SSM_GROUPS * D_STATE], axis=-1)
    dt = jax.nn.softplus(dt_raw.astype(jnp.float32) + p['dt_bias'].astype(jnp.float32))
    A = -jnp.exp(p['a_log'].astype(jnp.float32))
    xs_h = xs.reshape(b, L, N_SSM_HEADS, SSM_HEAD_DIM)
    y, new_h = ssd_scan(xs_h, dt, A,
                        Bm.reshape(b, L, N_SSM_GROUPS, D_STATE),
                        Cm.reshape(b, L, N_SSM_GROUPS, D_STATE), ssm_state)
    y = y + p['d_skip'].astype(jnp.float32)[:, None] * xs_h.astype(jnp.float32)
    yg = (y.reshape(b, L, SSM_WIDTH) * jax.nn.silu(z.astype(jnp.float32))).reshape(
        b, L, N_SSM_GROUPS, SSM_WIDTH // N_SSM_GROUPS)
    yg = yg * lax.rsqrt(jnp.mean(yg * yg, axis=-1, keepdims=True) + EPS)
    y_ssm = (yg.reshape(b, L, SSM_WIDTH) * p['ssm_norm'].astype(jnp.float32)).astype(x.dtype)
    x = x + jnp.concatenate([o_attn, y_ssm], axis=-1) @ p['w_out']
    hn = rms_norm(x, p['norm_ffn'])
    g, up = jnp.split(hn @ p['w_gate_up'], [D_FF], axis=-1)
    x = x + (jax.nn.silu(g) * up) @ p['w_down']
    return x, new_k, new_v, new_conv, new_h.astype(ssm_state.dtype)


def setup_inputs(seed: int = 0) -> dict:
    key = jax.random.key(seed)
    ks = jax.random.split(key, 24)
    f32 = jnp.float32

    def nrm(k, shape, scale):
        return jax.random.normal(k, shape, f32) * scale

    n_win = min(WINDOW, PAST_LEN)
    dt0 = jnp.exp(jax.random.uniform(ks[10], (DEPTH, N_SSM_HEADS), f32)
                  * (math.log(0.1) - math.log(0.001)) + math.log(0.001))
    return {
        'x_prompt': nrm(ks[0], (BATCH, SEQ, D_MODEL), 1.0),
        'x_sample': nrm(ks[1], (DEC_BATCH, DEC_SEQ, D_MODEL), 1.0),
        'cache_win_k': nrm(ks[2], (DEPTH, DEC_BATCH, n_win, N_KV_HEADS, HEAD_DIM), 1.0),
        'cache_win_v': nrm(ks[3], (DEPTH, DEC_BATCH, n_win, N_KV_HEADS, HEAD_DIM), 1.0),
        'state_conv': nrm(ks[4], (DEPTH, DEC_BATCH, CONV_W - 1, CONV_DIM), 1.0),
        'state_ssm': nrm(ks[5], (DEPTH, DEC_BATCH, N_SSM_HEADS, SSM_HEAD_DIM, D_STATE), 0.5),
        'norm_mix': 1.0 + nrm(ks[6], (DEPTH, D_MODEL), 0.02),
        'w_in': nrm(ks[7], (DEPTH, D_MODEL, IN_PROJ_WIDTH), D_MODEL ** -0.5),
        'q_norm': 1.0 + nrm(ks[8], (DEPTH, HEAD_DIM), 0.02),
        'k_norm': 1.0 + nrm(ks[9], (DEPTH, HEAD_DIM), 0.02),
        'sinks': nrm(ks[11], (DEPTH, N_Q_HEADS), 0.5),
        'conv_w': nrm(ks[12], (DEPTH, CONV_W, CONV_DIM), CONV_W ** -0.5),
        'conv_b': nrm(ks[13], (DEPTH, CONV_DIM), 0.01),
        'dt_bias': dt0 + jnp.log(-jnp.expm1(-dt0)),
        'a_log': jnp.log(jax.random.uniform(ks[14], (DEPTH, N_SSM_HEADS), f32, 1.0, 16.0)),
        'd_skip': 1.0 + nrm(ks[15], (DEPTH, N_SSM_HEADS), 0.1),
        'ssm_norm': 1.0 + nrm(ks[16], (DEPTH, SSM_WIDTH), 0.02),
        'w_out': nrm(ks[17], (DEPTH, MIX_WIDTH, D_MODEL), MIX_WIDTH ** -0.5),
        'norm_ffn': 1.0 + nrm(ks[18], (DEPTH, D_MODEL), 0.02),
        'w_gate_up': nrm(ks[19], (DEPTH, D_MODEL, 2 * D_FF), D_MODEL ** -0.5),
        'w_down': nrm(ks[20], (DEPTH, D_FF, D_MODEL), D_FF ** -0.5),
    }


def reference(x_prompt, x_sample, cache_win_k, cache_win_v, state_conv, state_ssm,
              norm_mix, w_in, q_norm, k_norm, sinks, conv_w, conv_b, dt_bias, a_log,
              d_skip, ssm_norm, w_out, norm_ffn, w_gate_up, w_down):
    b_p = x_prompt.shape[0]
    pos_p = jnp.arange(x_prompt.shape[1], dtype=jnp.int32)
    pos_s = PAST_LEN + jnp.arange(x_sample.shape[1], dtype=jnp.int32)
    conv0 = jnp.zeros((b_p, CONV_W - 1, CONV_DIM), x_prompt.dtype)
    h0 = jnp.zeros((b_p, N_SSM_HEADS, SSM_HEAD_DIM, D_STATE), state_ssm.dtype)

    xp, xs = x_prompt, x_sample
    pk, pv, pc, ph = [], [], [], []
    sk, sv, sc, sh = [], [], [], []
    for l in range(DEPTH):
        p = {'norm_mix': norm_mix[l], 'w_in': w_in[l], 'q_norm': q_norm[l],
             'k_norm': k_norm[l], 'sinks': sinks[l], 'conv_w': conv_w[l],
             'conv_b': conv_b[l], 'dt_bias': dt_bias[l], 'a_log': a_log[l],
             'd_skip': d_skip[l], 'ssm_norm': ssm_norm[l], 'w_out': w_out[l],
             'norm_ffn': norm_ffn[l], 'w_gate_up': w_gate_up[l], 'w_down': w_down[l]}
        xp, k1, v1, c1, h1 = hybrid_layer(xp, pos_p, None, conv0, h0, p)
        xs, k2, v2, c2, h2 = hybrid_layer(xs, pos_s, (cache_win_k[l], cache_win_v[l]),
                                          state_conv[l], state_ssm[l], p)
        pk.append(k1); pv.append(v1); pc.append(c1); ph.append(h1)
        sk.append(k2); sv.append(v2); sc.append(c2); sh.append(h2)

    return (xp, xs,
            jnp.stack(pk), jnp.stack(pv), jnp.stack(pc), jnp.stack(ph),
            jnp.stack(sk), jnp.stack(sv), jnp.stack(sc), jnp.stack(sh))
```

```cpp
#include <hip/hip_runtime.h>
#include <hip/hip_cooperative_groups.h>
#include <cstdio>
#include <cstdint>
#include <cmath>
namespace cg = cooperative_groups;
namespace pg8 {
#define PG8_LAS __attribute__((address_space(3)))
typedef unsigned short bf16_t;
typedef short bf16x8 __attribute__((ext_vector_type(8)));
typedef float f32x4 __attribute__((ext_vector_type(4)));
typedef unsigned u32x4 __attribute__((ext_vector_type(4)));
constexpr int BM = 256, BK = 64, HALF = 128, HTB = HALF * BK * 2  , STAGE_BYTES = 8 * HTB, NXCD = 8, WGM = 8;

__host__ __device__ __forceinline__ int lds_byte(int r, int c) { const int st = (r >> 4) * 2 + (c >> 5), rr = r & 15, cc = c & 31, ob = rr * 64 + cc * 2; return st * 1024 + (ob ^ (((ob >> 9) & 1) << 5)); }
__host__ __device__ __forceinline__ void stage_rc(int b, int& R, int& C) { const int st = b / 1024, sb = b % 1024, swz = sb ^ (((sb >> 9) & 1) << 5); R = (st >> 1) * 16 + swz / 64; C = (st & 1) * 32 + (swz % 64) / 2; }
__host__ __device__ __forceinline__ int perm32(int rho) { const int n = rho >> 4, i = rho & 15; return 8 * (i >> 2) + 4 * n + (i & 3); }

struct Unit { int pm, pn; };
struct Gemm { const bf16_t* A; const bf16_t* Bt; int M, N, K; };

struct StaticOrder {
    int nM, nN, nwg, G, c;
    __host__ __device__ void init(int M, int N, int G_, int c_) { nM = M / BM; nN = N / BM; nwg = nM * nN; G = G_; c = c_; }
    __host__ __device__ bool next(int i, Unit& u) const {
        const long L = (long)i * G + c; if (L >= nwg) return false;
        int wgid = (int)L; { const int q = nwg / NXCD, r = nwg % NXCD, xcd = wgid % NXCD, off = wgid / NXCD; wgid = (xcd < r ? xcd * (q + 1) : r * (q + 1) + (xcd - r) * q) + off; }
        const int nig = WGM * nN, gid = wgid / nig, fm = gid * WGM, gsz = (nM - fm) < WGM ? (nM - fm) : WGM;
        u.pm = fm + ((wgid % nig) % gsz); u.pn = (wgid % nig) / gsz; return true;
    }
    __device__ __forceinline__ void a_ready(const Unit&) const {}
    __device__ __forceinline__ void done(const Unit&) const {}
};
__device__ __forceinline__ unsigned cvt_pk_bf16(float lo, float hi) { unsigned r; asm volatile("v_cvt_pk_bf16_f32 %0, %1, %2" : "=v"(r) : "v"(lo), "v"(hi)); return r; }
typedef float f32x2 __attribute__((ext_vector_type(2)));
template <class Epi, class Sched, bool ALIGN_EPI = false, bool SP2 = false>
__device__ __forceinline__ void gemm_phase(PG8_LAS unsigned char* lds, const Gemm g, const Sched& S, const Epi& E, const int tid) {
    const int wid = __builtin_amdgcn_readfirstlane(tid >> 6), lane = tid & 63, wr = wid >> 2, wc = wid & 3, fr = lane & 15, fq = lane >> 4;
    const int K = g.K, nt = K / BK;
    unsigned voffA[2], voffB[2];
#pragma unroll
    for (int i = 0; i < 2; ++i) { int R, C; stage_rc(tid * 16 + i * 8192, R, C); const int Rb = Epi::PERM ? ((R & ~31) + perm32(R & 31)) : R;
        voffA[i] = (unsigned)(R * K + C) * 2u; voffB[i] = (unsigned)(Rb * K + C) * 2u; }
    const size_t kstep = (size_t)(BK * 2);
    const size_t hstep = (size_t)HALF * K * 2;
    const size_t tstep = 2 * hstep;
    const unsigned ldsw = (unsigned)wid * 1024u;
    const int aoff = lds_byte(wr * 64 + fr, fq * 8), boff = lds_byte(wc * 32 + fr, fq * 8);
#define PG8_SA(b, h) (((b) * 2 + (h)) * HTB)
#define PG8_SB(b, h) ((4 + (b) * 2 + (h)) * HTB)
#define PG8_STAGE(bufoff, gbase, voff) do { _Pragma("unroll") for (int _i = 0; _i < 2; ++_i) \
        __builtin_amdgcn_global_load_lds((const unsigned*)((const char*)(gbase) + (voff)[_i]), (PG8_LAS unsigned*)(lds + (bufoff) + ldsw + _i * 8192), 16, 0, 0); } while (0)
#define PG8_LDA(dst, b, h) do { _Pragma("unroll") for (int m = 0; m < 4; ++m) _Pragma("unroll") for (int k = 0; k < 2; ++k) dst[m][k] = *(const PG8_LAS bf16x8*)(lds + PG8_SA(b, h) + aoff + m * 2048 + k * 1024); } while (0)
#define PG8_LDB(dst, b, h) do { _Pragma("unroll") for (int n = 0; n < 2; ++n) _Pragma("unroll") for (int k = 0; k < 2; ++k) dst[n][k] = *(const PG8_LAS bf16x8*)(lds + PG8_SB(b, h) + boff + n * 2048 + k * 1024); } while (0)
#define PG8_MMA(ai, bj, At, Bt) do { __builtin_amdgcn_s_setprio(1); _Pragma("unroll") for (int m = 0; m < 4; ++m) _Pragma("unroll") for (int n = 0; n < 2; ++n) _Pragma("unroll") for (int k = 0; k < 2; ++k) \
        acc[ai][bj][m][n] = __builtin_amdgcn_mfma_f32_16x16x32_bf16(Bt[n][k], At[m][k], acc[ai][bj][m][n], 0, 0, 0); __builtin_amdgcn_s_setprio(0); } while (0)
#define PG8_WAIT_V(n) asm volatile("s_waitcnt vmcnt(" #n ")" ::: "memory")
#define PG8_WAIT_L(n) asm volatile("s_waitcnt lgkmcnt(" #n ")" ::: "memory")
#define PG8_BAR __builtin_amdgcn_s_barrier()
#define PG8_SCHED __builtin_amdgcn_sched_barrier(0)
    Unit cur, nxt; int ui = 0;
    if (!S.next(0, cur)) return;
    f32x4 acc[2][2][4][2];
#pragma unroll
    for (int a = 0; a < 2; ++a)
#pragma unroll
        for (int b = 0; b < 2; ++b)
#pragma unroll
            for (int m = 0; m < 4; ++m)
#pragma unroll
                for (int n = 0; n < 2; ++n) acc[a][b][m][n] = (f32x4){0.f, 0.f, 0.f, 0.f};
    bf16x8 At[4][2], B0[2][2], B1[2][2];
    const char* cA = (const char*)g.A + (size_t)cur.pm * tstep; const char* cB = (const char*)g.Bt + (size_t)cur.pn * tstep;
    S.a_ready(cur);
    if constexpr (SP2) {
        PG8_STAGE(PG8_SB(0, 0), cB, voffB); PG8_STAGE(PG8_SB(0, 1), cB + hstep, voffB); PG8_STAGE(PG8_SA(0, 0), cA, voffA); PG8_STAGE(PG8_SA(0, 1), cA + hstep, voffA);
        if (wr == 1) PG8_BAR;
        PG8_WAIT_V(2); PG8_BAR;
        PG8_STAGE(PG8_SB(1, 0), cB + kstep, voffB); PG8_STAGE(PG8_SA(1, 0), cA + kstep, voffA); PG8_STAGE(PG8_SB(1, 1), cB + hstep + kstep, voffB);
        PG8_WAIT_V(6); PG8_BAR;
    } else {
        PG8_STAGE(PG8_SB(0, 0), cB, voffB); PG8_STAGE(PG8_SA(0, 0), cA, voffA); PG8_STAGE(PG8_SB(0, 1), cB + hstep, voffB); PG8_STAGE(PG8_SA(0, 1), cA + hstep, voffA);
        if (wr == 1) PG8_BAR;
        PG8_WAIT_V(4); PG8_BAR;
        PG8_STAGE(PG8_SB(1, 0), cB + kstep, voffB); PG8_STAGE(PG8_SA(1, 0), cA + kstep, voffA); PG8_STAGE(PG8_SB(1, 1), cB + hstep + kstep, voffB);
        PG8_WAIT_V(6); PG8_BAR;
    }
    for (;;) {
        const bool has_next = S.next(ui + 1, nxt);
        const char* nA = has_next ? (const char*)g.A + (size_t)nxt.pm * tstep : cA; const char* nB = has_next ? (const char*)g.Bt + (size_t)nxt.pn * tstep : cB;
        for (int t = 0; t < nt; t += 2) {
            const bool last = (t == nt - 2);
            const char* a1 = cA + (size_t)(t + 1) * kstep;
            const char* a2 = last ? nA : cA + (size_t)(t + 2) * kstep; const char* b2 = last ? nB : cB + (size_t)(t + 2) * kstep;
            const char* a3 = a2 + kstep; const char* b3 = b2 + kstep;
            if (last && has_next) S.a_ready(nxt);
            if constexpr (Epi::KSCALE) E.kscale(acc, t, cur, wr, fr);
            if constexpr (SP2) {
            PG8_LDB(B0, 0, 0); PG8_LDB(B1, 0, 1); PG8_SCHED; PG8_LDA(At, 0, 0); PG8_STAGE(PG8_SA(1, 1), a1 + hstep, voffA);
            PG8_WAIT_V(8); PG8_WAIT_L(0); PG8_BAR; PG8_MMA(0, 0, At, B0); PG8_MMA(0, 1, At, B1); PG8_BAR; PG8_SCHED;
            PG8_LDA(At, 0, 1); PG8_STAGE(PG8_SB(0, 0), b2, voffB); PG8_STAGE(PG8_SB(0, 1), b2 + hstep, voffB); PG8_STAGE(PG8_SA(0, 0), a2, voffA);
            PG8_WAIT_V(8); PG8_WAIT_L(0); PG8_BAR; PG8_MMA(1, 0, At, B0); PG8_MMA(1, 1, At, B1); PG8_BAR; PG8_SCHED;
            PG8_LDB(B0, 1, 0); PG8_LDB(B1, 1, 1); PG8_SCHED; PG8_LDA(At, 1, 0); PG8_STAGE(PG8_SA(0, 1), a2 + hstep, voffA);
            PG8_WAIT_V(8); PG8_WAIT_L(0); PG8_BAR; PG8_MMA(0, 0, At, B0); PG8_MMA(0, 1, At, B1); PG8_BAR; PG8_SCHED;
            PG8_LDA(At, 1, 1); PG8_STAGE(PG8_SB(1, 0), b3, voffB); PG8_STAGE(PG8_SB(1, 1), b3 + hstep, voffB); PG8_STAGE(PG8_SA(1, 0), a3, voffA);
            PG8_WAIT_V(8); PG8_WAIT_L(0); PG8_BAR; PG8_MMA(1, 0, At, B0); PG8_MMA(1, 1, At, B1); PG8_BAR; PG8_SCHED;
            } else {
            PG8_LDB(B0, 0, 0); PG8_SCHED; PG8_LDA(At, 0, 0); PG8_STAGE(PG8_SA(1, 1), a1 + hstep, voffA);
            PG8_WAIT_L(8); PG8_BAR; PG8_WAIT_L(0); PG8_MMA(0, 0, At, B0); PG8_BAR; PG8_SCHED;
            PG8_LDB(B1, 0, 1); PG8_STAGE(PG8_SB(0, 0), b2, voffB);
            PG8_BAR; PG8_WAIT_L(0); PG8_MMA(0, 1, At, B1); PG8_BAR;
            PG8_LDA(At, 0, 1); PG8_STAGE(PG8_SA(0, 0), a2, voffA);
            PG8_BAR; PG8_WAIT_L(0); PG8_MMA(1, 0, At, B0); PG8_BAR; PG8_SCHED;
            PG8_STAGE(PG8_SB(0, 1), b2 + hstep, voffB);
            PG8_WAIT_V(6); PG8_BAR; PG8_MMA(1, 1, At, B1); PG8_BAR;
            PG8_LDB(B0, 1, 0); PG8_SCHED; PG8_LDA(At, 1, 0); PG8_STAGE(PG8_SA(0, 1), a2 + hstep, voffA);
            PG8_WAIT_L(8); PG8_BAR; PG8_WAIT_L(0); PG8_MMA(0, 0, At, B0); PG8_BAR; PG8_SCHED;
            PG8_LDB(B1, 1, 1); PG8_STAGE(PG8_SB(1, 0), b3, voffB);
            PG8_BAR; PG8_WAIT_L(0); PG8_MMA(0, 1, At, B1); PG8_BAR;
            PG8_LDA(At, 1, 1); PG8_STAGE(PG8_SA(1, 0), a3, voffA);
            PG8_BAR; PG8_WAIT_L(0); PG8_MMA(1, 0, At, B0); PG8_BAR; PG8_SCHED;
            PG8_STAGE(PG8_SB(1, 1), b3 + hstep, voffB);
            PG8_WAIT_V(6); PG8_BAR; PG8_MMA(1, 1, At, B1); PG8_BAR;
            }
        }
        if constexpr (ALIGN_EPI) { if (wr == 0) PG8_BAR; }
        if constexpr (!Epi::AFTER_DRAIN) { E(acc, cur, wr, wc, fr, fq); S.done(cur); }
        if (!has_next) break;
#pragma unroll
        for (int a = 0; a < 2; ++a)
#pragma unroll
            for (int b = 0; b < 2; ++b)
#pragma unroll
                for (int m = 0; m < 4; ++m)
#pragma unroll
                    for (int n = 0; n < 2; ++n) acc[a][b][m][n] = (f32x4){0.f, 0.f, 0.f, 0.f};
        cur = nxt; cA = nA; cB = nB; ++ui;
        if constexpr (ALIGN_EPI) { if (wr == 1) PG8_BAR; }
    }
    PG8_WAIT_V(0);
    if constexpr (!ALIGN_EPI) { if (wr == 0) PG8_BAR; }
    PG8_BAR;
    if constexpr (Epi::AFTER_DRAIN) { E.fused(acc, cur, wr, wc, fr, fq, lds, wid, lane); S.done(cur); }
#undef PG8_SA
#undef PG8_SB
#undef PG8_STAGE
#undef PG8_LDA
#undef PG8_LDB
#undef PG8_MMA
#undef PG8_WAIT_V
#undef PG8_WAIT_L
#undef PG8_BAR
#undef PG8_SCHED
}
}
#define LAS __attribute__((address_space(3)))
typedef unsigned short u16;
typedef short bf16x8 __attribute__((ext_vector_type(8)));
typedef float f32x4 __attribute__((ext_vector_type(4)));
typedef unsigned u32x4 __attribute__((ext_vector_type(4)));
typedef unsigned u32x2 __attribute__((ext_vector_type(2)));
typedef LAS unsigned char* ldsp;

constexpr int DM = 1024, NL = 2;
constexpr int MP = 4 * 8192, MS = 128 * 4, M = MP + MS;
constexpr int NPROJ = 3328, NIN = 3344, NMIX = 1536, DFF = 2816, NGU = 5632;
constexpr int C_K = 512, C_V = 640, C_Z = 768, C_X = 1792, C_B = 2816, C_C = 3072;
constexpr float EPS = 1e-6f;
constexpr int NPOS = 8196;

constexpr size_t WS_WIN = 0;
constexpr size_t SZ_WIN = (size_t)NIN * DM * 2;
constexpr size_t WS_WOUT = WS_WIN + NL * SZ_WIN;
constexpr size_t SZ_WOUT = (size_t)DM * NMIX * 2;
constexpr size_t WS_WGU = WS_WOUT + NL * SZ_WOUT;
constexpr size_t SZ_WGU = (size_t)NGU * DM * 2;
constexpr size_t WS_WDN = WS_WGU + NL * SZ_WGU;
constexpr size_t SZ_WDN = (size_t)DM * DFF * 2;
constexpr size_t WS_ROPE = WS_WDN + NL * SZ_WDN;
constexpr size_t SZ_ROPE = (size_t)NPOS * 32 * 4;
constexpr size_t WS_XB = WS_ROPE + 2 * SZ_ROPE;
constexpr size_t WS_SSP = WS_XB + (size_t)M * DM * 2;
constexpr size_t WS_PROJ = WS_SSP + (size_t)M * 16 * 4;
constexpr size_t WS_YMIX = WS_PROJ + (size_t)M * NPROJ * 2;
constexpr size_t WS_DT = WS_YMIX + (size_t)M * NMIX * 2;
constexpr size_t WS_CD = WS_DT + (size_t)MP * 16 * 4;
constexpr size_t WS_ST = WS_CD + (size_t)4 * 64 * 16 * 4;
constexpr size_t WS_END = WS_ST + (size_t)4 * 64 * 16 * 64 * 128 * 2;
constexpr size_t WS_RS = WS_END;
constexpr size_t WS_BAR = WS_RS + (size_t)MP * 2 * 4, SZ_BAR = 16384;
static_assert(WS_BAR + SZ_BAR <= (size_t)4 * MP * DM * 4 && WS_BAR % 256 == 0, "workspace");
static_assert(WS_XB % 256 == 0 && WS_SSP % 256 == 0 && WS_PROJ % 256 == 0 && WS_YMIX % 256 == 0 && WS_DT % 256 == 0 && WS_ST % 256 == 0 && WS_ROPE % 256 == 0, "align");

constexpr size_t O_Y = 0;
constexpr size_t O_KP = (size_t)M * DM;
constexpr size_t O_VP = O_KP + (size_t)2 * 4 * 128 * 128;
constexpr size_t O_CP = O_VP + (size_t)2 * 4 * 128 * 128;
constexpr size_t O_HP = O_CP + (size_t)2 * 4 * 3 * 1536;
constexpr size_t O_KS = O_HP + (size_t)2 * 4 * 16 * 64 * 128;
constexpr size_t O_VS = O_KS + (size_t)2 * 128 * 128 * 128;
constexpr size_t O_CS = O_VS + (size_t)2 * 128 * 128 * 128;
constexpr size_t O_HS = O_CS + (size_t)2 * 128 * 3 * 1536;
constexpr size_t O_END = O_HS + (size_t)2 * 128 * 16 * 64 * 128;

constexpr int LDS_BYTES = 147456;

enum { I_XP = 0, I_XS, I_CK, I_CV, I_SCONV, I_SSSM, I_NMIX, I_WIN, I_QN, I_KN, I_SINK, I_CW, I_CB, I_DTB, I_ALOG, I_DSK, I_SNORM, I_WOUT, I_NFFN, I_WGU, I_WDN };

struct Params { const float* in[21]; float* out; unsigned char* ws; int ph_lo, ph_hi; };

typedef float f32x2_t __attribute__((ext_vector_type(2))); typedef __bf16 bf16x2_t __attribute__((ext_vector_type(2)));
__device__ __forceinline__ unsigned pk2(float lo, float hi) { f32x2_t v = {lo, hi}; bf16x2_t b = __builtin_convertvector(v, bf16x2_t); return __builtin_bit_cast(unsigned, b); }
__device__ __forceinline__ unsigned f2bf(float f) { return pk2(f, 0.f) & 0xffffu; }
__device__ __forceinline__ float bf2f(unsigned h) { return __builtin_bit_cast(float, h << 16); }
__device__ __forceinline__ float bflo(unsigned w) { return __builtin_bit_cast(float, w << 16); }
__device__ __forceinline__ float bfhi(unsigned w) { return __builtin_bit_cast(float, w & 0xffff0000u); }
__device__ __forceinline__ float silu_f(float x) { return x * __builtin_amdgcn_rcpf(1.f + __expf(-x)); }
__device__ __forceinline__ float softplus_f(float x) { return x > 15.f ? x : log1pf(__expf(x)); }
__device__ __forceinline__ float wave_sum(float v) {
#pragma unroll
    for (int o = 1; o < 64; o <<= 1) v += __shfl_xor(v, o);
    return v;
}
__device__ __forceinline__ float wave_max(float v) {
#pragma unroll
    for (int o = 1; o < 64; o <<= 1) v = fmaxf(v, __shfl_xor(v, o));
    return v;
}
__device__ __forceinline__ float wave_incl_scan(float v, int lane) {
#pragma unroll
    for (int off = 1; off < 64; off <<= 1) { const float t = __shfl_up(v, off); if (lane >= off) v += t; }
    return v;
}
__device__ __forceinline__ bf16x8 mk8(u32x2 lo, u32x2 hi) { u32x4 w; w.x = lo.x; w.y = lo.y; w.z = hi.x; w.w = hi.y; return __builtin_bit_cast(bf16x8, w); }
__device__ __forceinline__ bf16x8 lds16(ldsp p) { return __builtin_bit_cast(bf16x8, *(LAS u32x4*)p); }
__device__ __forceinline__ bf16x8 lds8x2(ldsp p0, ldsp p1) { return mk8(*(LAS u32x2*)p0, *(LAS u32x2*)p1); }
__device__ __forceinline__ f32x4 mfma16(bf16x8 a, bf16x8 b, f32x4 c) { return __builtin_amdgcn_mfma_f32_16x16x32_bf16(a, b, c, 0, 0, 0); }
#define LDS_WAIT() asm volatile("s_waitcnt lgkmcnt(0)" ::: "memory")

__device__ __forceinline__ float rstd_row(const float* ssp, int row) {
    const f32x4* p = (const f32x4*)(ssp + (size_t)row * 16);
    const f32x4 a = p[0], b = p[1], c = p[2], d = p[3];
    const float s = (((a.x + a.y) + (a.z + a.w)) + ((b.x + b.y) + (b.z + b.w))) + (((c.x + c.y) + (c.z + c.w)) + ((d.x + d.y) + (d.z + d.w)));
    return rsqrtf(s * (1.f / 1024.f) + EPS);
}

struct EpiProj {
    static constexpr bool PERM = true, AFTER_DRAIN = false, KSCALE = false;
    u16* O; const float* ssp; ldsp rsl;
    __device__ __forceinline__ void operator()(const pg8::f32x4 (&acc)[2][2][4][2], const pg8::Unit& u, int wr, int wc, int fr, int fq) const {
        const int row0 = u.pm * 256 + wr * 64 + fr, col0 = u.pn * 256 + wc * 32 + 8 * fq;
        { const int t = wc * 64 + fq * 16 + fr; if (wr == 0) ((LAS float*)rsl)[t] = rstd_row(ssp, u.pm * 256 + t);
          asm volatile("s_waitcnt lgkmcnt(0)" ::: "memory"); __builtin_amdgcn_s_barrier(); asm volatile("" ::: "memory"); }
#pragma unroll
        for (int ai = 0; ai < 2; ++ai)
#pragma unroll
            for (int m = 0; m < 4; ++m) {
                const int row = row0 + ai * 128 + m * 16; const float rs = ((LAS float*)rsl)[wr * 64 + fr + ai * 128 + m * 16]; u16* rowp = O + (size_t)row * NPROJ + col0;
#pragma unroll
                for (int bj = 0; bj < 2; ++bj) {
                    const f32x4 v0 = acc[ai][bj][m][0] * rs, v1 = acc[ai][bj][m][1] * rs; u32x4 w;
                    w.x = pg8::cvt_pk_bf16(v0[0], v0[1]); w.y = pg8::cvt_pk_bf16(v0[2], v0[3]); w.z = pg8::cvt_pk_bf16(v1[0], v1[1]); w.w = pg8::cvt_pk_bf16(v1[2], v1[3]);
                    *(u32x4*)(rowp + bj * 128) = w; }
            }
    }
};
struct EpiSwiglu {
    static constexpr bool PERM = true, AFTER_DRAIN = false, KSCALE = false;
    u16* O; const float* ssp; ldsp rsl;
    __device__ __forceinline__ void operator()(const pg8::f32x4 (&acc)[2][2][4][2], const pg8::Unit& u, int wr, int wc, int fr, int fq) const {
        const int row0 = u.pm * 256 + wr * 64 + fr, col0 = u.pn * 128 + wc * 32 + 8 * fq;
        { const int t = wc * 64 + fq * 16 + fr; if (wr == 0) ((LAS float*)rsl)[t] = rstd_row(ssp, u.pm * 256 + t);
          asm volatile("s_waitcnt lgkmcnt(0)" ::: "memory"); __builtin_amdgcn_s_barrier(); asm volatile("" ::: "memory"); }
#pragma unroll
        for (int ai = 0; ai < 2; ++ai)
#pragma unroll
            for (int m = 0; m < 4; ++m) {
                const int row = row0 + ai * 128 + m * 16; const float rs = ((LAS float*)rsl)[wr * 64 + fr + ai * 128 + m * 16];
                float h[8];
#pragma unroll
                for (int n = 0; n < 2; ++n)
#pragma unroll
                    for (int j = 0; j < 4; ++j) { const float g = acc[ai][0][m][n][j] * rs, up = acc[ai][1][m][n][j] * rs; h[n * 4 + j] = silu_f(g) * up; }
                u32x4 w; w.x = pg8::cvt_pk_bf16(h[0], h[1]); w.y = pg8::cvt_pk_bf16(h[2], h[3]); w.z = pg8::cvt_pk_bf16(h[4], h[5]); w.w = pg8::cvt_pk_bf16(h[6], h[7]);
                *(u32x4*)(O + (size_t)row * DFF + col0) = w;
            }
    }
};
template <bool KS> struct EpiResT {
    static constexpr bool PERM = false, AFTER_DRAIN = false, KSCALE = KS;
    u16* xb; float* outf; float* ssp; const float* rs;
    __device__ __forceinline__ void kscale(pg8::f32x4 (&acc)[2][2][4][2], int t, const pg8::Unit& u, int wr, int fr) const {
        if (t != 8 && t != 16) return;
#pragma unroll
        for (int ai = 0; ai < 2; ++ai)
#pragma unroll
            for (int m = 0; m < 4; ++m) {
                const int row = u.pm * 256 + wr * 64 + fr + ai * 128 + m * 16; const float s0 = rs[2 * row], s1 = rs[2 * row + 1];
                const float f = t == 8 ? s0 * __builtin_amdgcn_rcpf(s1) : s1;
#pragma unroll
                for (int bj = 0; bj < 2; ++bj)
#pragma unroll
                    for (int n = 0; n < 2; ++n) acc[ai][bj][m][n] = acc[ai][bj][m][n] * f;
            }
    }
    __device__ __forceinline__ void operator()(const pg8::f32x4 (&acc)[2][2][4][2], const pg8::Unit& u, int wr, int wc, int fr, int fq) const {
        const int row0 = u.pm * 256 + wr * 64 + fr, col0 = u.pn * 256 + wc * 32 + 4 * fq;
#pragma unroll
        for (int ai = 0; ai < 2; ++ai) {
            u32x2 rw[4][2][2];
#pragma unroll
            for (int m = 0; m < 4; ++m)
#pragma unroll
                for (int bj = 0; bj < 2; ++bj)
#pragma unroll
                    for (int n = 0; n < 2; ++n) rw[m][bj][n] = *(const u32x2*)(xb + (size_t)(row0 + ai * 128 + m * 16) * DM + col0 + bj * 128 + n * 16);
#pragma unroll
            for (int m = 0; m < 4; ++m) {
                const int row = row0 + ai * 128 + m * 16;
                u16* xp = xb + (size_t)row * DM + col0; float ss = 0.f;
#pragma unroll
                for (int bj = 0; bj < 2; ++bj)
#pragma unroll
                    for (int n = 0; n < 2; ++n) {
                        const u32x2 w0 = rw[m][bj][n]; const f32x4 r = {bflo(w0.x), bfhi(w0.x), bflo(w0.y), bfhi(w0.y)}; const f32x4 v = acc[ai][bj][m][n] + r;
                        if (outf) *(f32x4*)(outf + (size_t)row * DM + col0 + bj * 128 + n * 16) = v;
                        u32x2 w; w.x = pg8::cvt_pk_bf16(v[0], v[1]); w.y = pg8::cvt_pk_bf16(v[2], v[3]);
                        *(u32x2*)(xp + bj * 128 + n * 16) = w; ss += (v[0] * v[0] + v[1] * v[1]) + (v[2] * v[2] + v[3] * v[3]); }
                ss += __shfl_xor(ss, 16); ss += __shfl_xor(ss, 32);
                if (fq == 0) ssp[(size_t)row * 16 + u.pn * 4 + wc] = ss;
            }
        }
    }
};
struct Ctx {
    const float* in[21]; float* out; unsigned char* ws;
    u16 *WinT, *WoutT, *WguT, *WdnT; float *COS, *SIN; u16* XB; float* SSP; u16* PROJ; u16* YMIX; float* DT; float* CD; u16* ST; float* RS;
};

__device__ __forceinline__ void tr_item(const float* __restrict__ W, int K, int N, const float* __restrict__ gk, u16* WT, int perm, LAS float* scr, int item, int lane) {
    const int nblk = (N + 31) >> 5, kb = item / nblk, nb = item - kb * nblk, k0 = 64 * kb, n0 = 32 * nb;
    const int kd0 = perm == 2 ? (k0 < 512 ? k0 + 1024 : k0 - 512) : k0;
    const int nn = n0 + (lane & 31);
    float wv[32];
#pragma unroll
    for (int i = 0; i < 32; ++i) { const int kk = 2 * i + (lane >> 5); wv[i] = (nn < N) ? W[(size_t)(k0 + kk) * N + nn] : 0.f; }
#pragma unroll
    for (int i = 0; i < 32; ++i) { const int kk = 2 * i + (lane >> 5); float v = wv[i]; if (gk) { if (perm == 2) { if (k0 >= 512) v *= gk[k0 + kk - 512]; } else v *= gk[k0 + kk]; } scr[kk * 33 + (lane & 31)] = v; }
    LDS_WAIT(); asm volatile("" ::: "memory");
    const int c = lane & 7;
#pragma unroll
    for (int j = 0; j < 4; ++j) {
        const int nl = (lane >> 3) + 8 * j, n = n0 + nl;
        if (n < N) {
            int dr = n; if (perm == 1) { const int up = n >= DFF, f = up ? n - DFF : n; dr = (f >> 7) * 256 + up * 128 + (f & 127); }
            const LAS float* s = scr + (8 * c) * 33 + nl;
            u32x4 o; o.x = pk2(s[0 * 33], s[1 * 33]); o.y = pk2(s[2 * 33], s[3 * 33]); o.z = pk2(s[4 * 33], s[5 * 33]); o.w = pk2(s[6 * 33], s[7 * 33]);
            *(u32x4*)(WT + (size_t)dr * K + kd0 + 8 * c) = o; }
    }
    LDS_WAIT(); asm volatile("" ::: "memory");
}
constexpr int I_IN = (DM / 64) * ((NIN + 31) / 32), I_OUT = (NMIX / 64) * (DM / 32), I_GU = (DM / 64) * (NGU / 32), I_DN = (DFF / 64) * (DM / 32), I_L = I_IN + I_OUT + I_GU + I_DN;
__device__ __forceinline__ void tr_layer_item(const Ctx& X, int l, int r, LAS float* scr, int lane) {
    if (r < I_IN) { tr_item(X.in[I_WIN] + (size_t)l * DM * NIN, DM, NIN, X.in[I_NMIX] + l * DM, X.WinT + (size_t)l * NIN * DM, 0, scr, r, lane); return; } r -= I_IN;
    if (r < I_OUT) { tr_item(X.in[I_WOUT] + (size_t)l * NMIX * DM, NMIX, DM, X.in[I_SNORM] + l * 1024, X.WoutT + (size_t)l * DM * NMIX, 2, scr, r, lane); return; } r -= I_OUT;
    if (r < I_GU) { tr_item(X.in[I_WGU] + (size_t)l * DM * NGU, DM, NGU, X.in[I_NFFN] + l * DM, X.WguT + (size_t)l * NGU * DM, 1, scr, r, lane); return; } r -= I_GU;
    tr_item(X.in[I_WDN] + (size_t)l * DFF * DM, DFF, DM, nullptr, X.WdnT + (size_t)l * DM * DFF, 0, scr, r, lane);
}
__device__ __forceinline__ void idle_weight_items(const Ctx& X, ldsp L, int stage, int nwg, int G, int bx, int wid, int lane) {
    const int nround = (nwg + G - 1) / G, first_idle = nwg - (nround - 1) * G;
    LAS float* scr = (LAS float*)(L + wid * 16384);
    int nw = (G - first_idle) * 8, wi = (bx - first_idle) * 8 + wid;
    if (first_idle >= G) { nw = G * 8; wi = bx * 8 + wid; }
    else if (bx < first_idle) return;
    if (stage == 0) { for (int r = I_IN + wi; r < I_IN + I_OUT + I_GU; r += nw) tr_layer_item(X, 0, r, scr, lane); }
    else { for (int r = I_IN + I_OUT + I_GU + wi; r < 2 * I_L; r += nw) { if (r < I_L) tr_layer_item(X, 0, r, scr, lane); else tr_layer_item(X, 1, r - I_L, scr, lane); } }
}
__device__ __forceinline__ void phase_prologue(const Ctx& X, ldsp L, int tid, int wid, int lane) {
    LAS float* scr = (LAS float*)(L + wid * 16384);
    const int gw = blockIdx.x * 8 + wid, NGW = gridDim.x * 8;
    for (int it = gw; it < I_IN; it += NGW) tr_layer_item(X, 0, it, scr, lane);
    for (int rb = gw * 4; rb < M; rb += NGW * 4) {
        f32x4 v[4][4];
#pragma unroll
        for (int rr = 0; rr < 4; ++rr) { const int row = rb + rr; const float* xr = row < MP ? X.in[I_XP] + (size_t)row * DM : X.in[I_XS] + (size_t)(row - MP) * DM;
#pragma unroll
            for (int j = 0; j < 4; ++j) v[rr][j] = ((const f32x4*)xr)[lane + 64 * j]; }
#pragma unroll
        for (int rr = 0; rr < 4; ++rr) { const int row = rb + rr; float ss = 0.f;
#pragma unroll
            for (int j = 0; j < 4; ++j) { const f32x4 w4 = v[rr][j]; ss += (w4.x * w4.x + w4.y * w4.y) + (w4.z * w4.z + w4.w * w4.w);
                u32x2 w; w.x = pk2(w4.x, w4.y); w.y = pk2(w4.z, w4.w); ((u32x2*)(X.XB + (size_t)row * DM))[lane + 64 * j] = w; }
            ss = wave_sum(ss);
            if (lane < 16) X.SSP[(size_t)row * 16 + lane] = lane == 0 ? ss : 0.f; }
    }
    for (int idx = blockIdx.x * 512 + tid; idx < NPOS * 32; idx += gridDim.x * 512) {
        const int pi = idx >> 5, j = idx & 31; const float pos = pi < 8192 ? (float)pi : (float)(16384 + pi - 8192);
        const float inv = powf(10000.f, -(float)j * (1.f / 32.f));
        float sv, cv; sincosf(pos * inv, &sv, &cv); X.COS[idx] = cv; X.SIN[idx] = sv;
    }
}

struct ConvCol { float w0, w1, w2, w3, bias, a, b, c; const u16* p; };
__device__ __forceinline__ void conv_init(ConvCol& cc, const u16* proj, int row, bool havePrev, int xcol, const float* cw, const float* cb) {
    cc.w0 = cw[xcol]; cc.w1 = cw[1536 + xcol]; cc.w2 = cw[2 * 1536 + xcol]; cc.w3 = cw[3 * 1536 + xcol]; cc.bias = cb[xcol];
    cc.p = proj + (size_t)row * NPROJ + C_X + xcol;
    cc.a = havePrev ? bf2f(cc.p[-3 * NPROJ]) : 0.f; cc.b = havePrev ? bf2f(cc.p[-2 * NPROJ]) : 0.f; cc.c = havePrev ? bf2f(cc.p[-1 * NPROJ]) : 0.f;
}
__device__ __forceinline__ float conv_step(ConvCol& cc) {
    const float d = bf2f(*cc.p); cc.p += NPROJ;
    const float v = fmaf(cc.a, cc.w0, fmaf(cc.b, cc.w1, fmaf(cc.c, cc.w2, fmaf(d, cc.w3, cc.bias))));
    cc.a = cc.b; cc.b = cc.c; cc.c = d; return silu_f(v);
}

struct ConvW { float w0, w1, w2, w3, bias; };
__device__ __forceinline__ ConvW conv_w(const float* cw, const float* cb, int xcol) { ConvW w; w.w0 = cw[xcol]; w.w1 = cw[1536 + xcol]; w.w2 = cw[2 * 1536 + xcol]; w.w3 = cw[3 * 1536 + xcol]; w.bias = cb[xcol]; return w; }
template <int NS> __device__ __forceinline__ void conv_load(float (&raw)[NS + 3], const u16* proj, int row, bool havePrev, int xcol) {
    const u16* p = proj + (size_t)row * NPROJ + C_X + xcol;
#pragma unroll
    for (int k = 0; k < NS + 3; ++k) { unsigned v = 0u; if (k >= 3 || havePrev) v = p[(k - 3) * NPROJ]; raw[k] = bf2f(v); }
}
__device__ __forceinline__ float conv_tap(const ConvW& w, float a, float b, float c, float d) { return silu_f(fmaf(a, w.w0, fmaf(b, w.w1, fmaf(c, w.w2, fmaf(d, w.w3, w.bias))))); }

struct ConvW4 { f32x4 w0, w1, w2, w3, bias; };
__device__ __forceinline__ ConvW4 conv4_w(const float* cw, const float* cb, int xcol0) { ConvW4 w; w.w0 = *(const f32x4*)(cw + xcol0); w.w1 = *(const f32x4*)(cw + 1536 + xcol0); w.w2 = *(const f32x4*)(cw + 2 * 1536 + xcol0); w.w3 = *(const f32x4*)(cw + 3 * 1536 + xcol0); w.bias = *(const f32x4*)(cb + xcol0); return w; }
template <int NT> __device__ __forceinline__ void conv4_load(float (&raw)[NT + 3][4], const u16* proj, int row, bool havePrev, int xcol0) {
    const u16* p = proj + (size_t)row * NPROJ + C_X + xcol0;
#pragma unroll
    for (int k = 0; k < NT + 3; ++k) { u32x2 v = {0u, 0u}; if (k >= 3 || havePrev) v = *(const u32x2*)(p + (k - 3) * NPROJ); raw[k][0] = bflo(v.x); raw[k][1] = bfhi(v.x); raw[k][2] = bflo(v.y); raw[k][3] = bfhi(v.y); }
}
#define CONV4_TAP(w, raw, k, e) silu_f(fmaf(raw[(k)][e], w.w0[e], fmaf(raw[(k) + 1][e], w.w1[e], fmaf(raw[(k) + 2][e], w.w2[e], fmaf(raw[(k) + 3][e], w.w3[e], w.bias[e])))))
__device__ __forceinline__ void acum_scan(LAS float* DTL, LAS float* ACL, const float* alog, int wid, int lane) {
#pragma unroll
    for (int hh = 0; hh < 2; ++hh) {
        const int h = 2 * wid + hh; const float A = -expf(alog[h]);
        float v0 = DTL[h * 128 + lane] * A, v1 = DTL[h * 128 + 64 + lane] * A;
        v0 = wave_incl_scan(v0, lane); v1 = wave_incl_scan(v1, lane); v1 += __shfl(v0, 63);
        ACL[h * 128 + lane] = v0; ACL[h * 128 + 64 + lane] = v1;
    }
}

__device__ __forceinline__ void dt_unit(const Ctx& X, int l, int b, int c, int wid, int lane) {
    const int i = lane & 15, g = lane >> 4, r0 = b * 8192 + c * 128;
    const u16* ap = X.XB + (size_t)(r0 + 16 * wid + i) * DM + 8 * g; const u16* bp = X.WinT + (size_t)l * NIN * DM + (size_t)(NPROJ + i) * DM + 8 * g;
    f32x4 acc = {0.f, 0.f, 0.f, 0.f};
#pragma unroll 16
    for (int kk = 0; kk < 32; ++kk) { const bf16x8 a = *(const bf16x8*)(ap + 32 * kk), w = *(const bf16x8*)(bp + 32 * kk); acc = mfma16(a, w, acc); }
    const float bias = X.in[I_DTB][l * 16 + i];
#pragma unroll
    for (int j = 0; j < 4; ++j) { const int tok = 16 * wid + 4 * g + j; X.DT[(size_t)(r0 + tok) * 16 + i] = softplus_f(acc[j] * rstd_row(X.SSP, r0 + tok) + bias); }
}
__device__ __forceinline__ void idle_dt_units(const Ctx& X, int l, int nwg, int G, int bx, int wid, int lane) {
    const int nround = (nwg + G - 1) / G, first_idle = nwg - (nround - 1) * G;
    int nw = G - first_idle, wi = bx - first_idle;
    if (first_idle >= G) { nw = G; wi = bx; }
    else if (bx < first_idle) return;
    for (int u = wi; u < 256; u += nw) dt_unit(X, l, u >> 6, u & 63, wid, lane);
}

constexpr int XTP = 132;
__device__ __forceinline__ void ssd_states_unit(const Ctx& X, int l, int b, int c, ldsp L, int tid, int wid, int lane) {
    LAS float* DTL = (LAS float*)L; LAS float* ACL = (LAS float*)(L + 8192);
    LAS u16* BT = (LAS u16*)(L + 16384);
    LAS u16* XT = (LAS u16*)(L + 16384 + 33792);
    const int i = lane & 15, g = lane >> 4, r0 = b * 8192 + c * 128;
    const float* cw = X.in[I_CW] + (size_t)l * 4 * 1536; const float* cb = X.in[I_CB] + (size_t)l * 1536;
    { const f32x4 d4 = *(const f32x4*)(X.DT + (size_t)r0 * 16 + tid * 4); const int s_ = tid >> 2, h0 = (tid & 3) * 4;
      DTL[(h0 + 0) * 128 + s_] = d4.x; DTL[(h0 + 1) * 128 + s_] = d4.y; DTL[(h0 + 2) * 128 + s_] = d4.z; DTL[(h0 + 3) * 128 + s_] = d4.w; }
    __syncthreads();
    acum_scan(DTL, ACL, X.in[I_ALOG] + l * 16, wid, lane);
    __syncthreads();
    if (tid < 16) X.CD[(b * 64 + c) * 16 + tid] = __expf(ACL[tid * 128 + 127]);
    LAS float* WSL = (LAS float*)(L + 16384 + 33792 + 67584);
#pragma unroll
    for (int e = 0; e < 4; ++e) { const int idx = tid * 4 + e, h = idx >> 7; WSL[idx] = DTL[idx] * __expf(ACL[h * 128 + 127] - ACL[idx]); }
    __syncthreads();
    for (int hq = 0; hq < 4; ++hq) {
        const int grp = hq >> 1;
        if ((hq & 1) == 0) {
            const int cg = lane & 31, tok0 = 16 * wid + 8 * (lane >> 5), xcol0 = 1024 + 128 * grp + 4 * cg; const ConvW4 w = conv4_w(cw, cb, xcol0);
            float raw[11][4]; conv4_load<8>(raw, X.PROJ, r0 + tok0, !(c == 0 && tok0 == 0), xcol0);
#pragma unroll
            for (int e = 0; e < 4; ++e)
#pragma unroll
                for (int kq = 0; kq < 2; ++kq) { u32x2 pw; pw.x = pk2(CONV4_TAP(w, raw, 4 * kq, e), CONV4_TAP(w, raw, 4 * kq + 1, e)); pw.y = pk2(CONV4_TAP(w, raw, 4 * kq + 2, e), CONV4_TAP(w, raw, 4 * kq + 3, e));
                    *(LAS u32x2*)(BT + (4 * cg + e) * XTP + tok0 + 4 * kq) = pw; }
        }
        {
            const int cg = lane, tok0 = 16 * wid, xcol0 = 256 * hq + 4 * cg, h = 4 * hq + (cg >> 4); const ConvW4 w = conv4_w(cw, cb, xcol0);
            float raw[19][4]; conv4_load<16>(raw, X.PROJ, r0 + tok0, !(c == 0 && tok0 == 0), xcol0);
            float ws[16];
#pragma unroll
            for (int k4 = 0; k4 < 4; ++k4) { const f32x4 t4 = *(LAS f32x4*)(WSL + h * 128 + tok0 + 4 * k4); ws[4 * k4] = t4.x; ws[4 * k4 + 1] = t4.y; ws[4 * k4 + 2] = t4.z; ws[4 * k4 + 3] = t4.w; }
#pragma unroll
            for (int e = 0; e < 4; ++e)
#pragma unroll
                for (int kq = 0; kq < 4; ++kq) { u32x2 pw; pw.x = pk2(CONV4_TAP(w, raw, 4 * kq, e) * ws[4 * kq], CONV4_TAP(w, raw, 4 * kq + 1, e) * ws[4 * kq + 1]); pw.y = pk2(CONV4_TAP(w, raw, 4 * kq + 2, e) * ws[4 * kq + 2], CONV4_TAP(w, raw, 4 * kq + 3, e) * ws[4 * kq + 3]);
                    *(LAS u32x2*)(XT + (4 * cg + e) * XTP + tok0 + 4 * kq) = pw; }
        }
        __syncthreads();
        {
            const int hl = wid >> 1, ph = wid & 1, h = 4 * hq + hl;
            f32x4 acc[2][8];
#pragma unroll
            for (int pp = 0; pp < 2; ++pp)
#pragma unroll
                for (int nt = 0; nt < 8; ++nt) acc[pp][nt] = (f32x4){0.f, 0.f, 0.f, 0.f};
#pragma unroll 1
            for (int ks = 0; ks < 4; ++ks) {
                bf16x8 bfr[8], xfr[2];
#pragma unroll
                for (int nt = 0; nt < 8; ++nt) { ldsp p = (ldsp)(BT + (16 * nt + i) * XTP + 32 * ks + 8 * g); bfr[nt] = lds8x2(p, p + 8); }
#pragma unroll
                for (int pp = 0; pp < 2; ++pp) { ldsp p = (ldsp)(XT + (hl * 64 + 16 * (2 * ph + pp) + i) * XTP + 32 * ks + 8 * g); xfr[pp] = lds8x2(p, p + 8); }
#pragma unroll
                for (int pp = 0; pp < 2; ++pp)
#pragma unroll
                    for (int nt = 0; nt < 8; ++nt) acc[pp][nt] = mfma16(bfr[nt], xfr[pp], acc[pp][nt]);
            }
            u16* sb = X.ST + ((size_t)((b * 64 + c) * 16 + h)) * 8192;
#pragma unroll
            for (int pp = 0; pp < 2; ++pp)
#pragma unroll
                for (int nt = 0; nt < 8; ++nt) { const int p = 16 * (2 * ph + pp) + i, n = 16 * nt + 4 * g; u32x2 w; w.x = pk2(acc[pp][nt][0], acc[pp][nt][1]); w.y = pk2(acc[pp][nt][2], acc[pp][nt][3]);
                    *(u32x2*)(sb + p * 128 + n) = w; }
        }
        __syncthreads();
    }
}

__device__ __forceinline__ void ssd_sample_unit(const Ctx& X, int l, int b, int grp, ldsp L, int tid, int wid, int lane) {
    LAS float* XS = (LAS float*)L;
    LAS float* BS = (LAS float*)(L + 8192);
    LAS float* CS = (LAS float*)(L + 10240);
    LAS float* DTS = (LAS float*)(L + 12288);
    LAS float* YG = (LAS float*)(L + 12544);
    const float* cw = X.in[I_CW] + (size_t)l * 4 * 1536; const float* cb = X.in[I_CB] + (size_t)l * 1536;
    const int row0 = MP + b * 4;
    for (int ci = tid; ci < 768; ci += 512) {
        const int xcol = ci < 512 ? 512 * grp + ci : (ci < 640 ? 1024 + 128 * grp + (ci - 512) : 1280 + 128 * grp + (ci - 640));
        float xp[7];
#pragma unroll
        for (int j = 0; j < 3; ++j) xp[j] = X.in[I_SCONV][((size_t)(l * 128 + b) * 3 + j) * 1536 + xcol];
#pragma unroll
        for (int t = 0; t < 4; ++t) xp[3 + t] = bf2f(X.PROJ[(size_t)(row0 + t) * NPROJ + C_X + xcol]);
        const float w0 = cw[xcol], w1 = cw[1536 + xcol], w2 = cw[2 * 1536 + xcol], w3 = cw[3 * 1536 + xcol], bias = cb[xcol];
#pragma unroll
        for (int t = 0; t < 4; ++t) {
            const float v = silu_f(fmaf(xp[t], w0, fmaf(xp[t + 1], w1, fmaf(xp[t + 2], w2, fmaf(xp[t + 3], w3, bias)))));
            if (ci < 512) XS[t * 512 + ci] = v; else if (ci < 640) BS[t * 128 + ci - 512] = v; else CS[t * 128 + ci - 640] = v;
        }
#pragma unroll
        for (int j = 0; j < 3; ++j) X.out[O_CS + ((size_t)(l * 128 + b) * 3 + j) * 1536 + xcol] = xp[4 + j];
    }
    {
        const int h = 8 * grp + wid; const u16* wp = X.WinT + (size_t)l * NIN * DM + (size_t)(NPROJ + h) * DM + lane * 16;
        const u32x4 wa = *(const u32x4*)wp, wb = *(const u32x4*)(wp + 8);
#pragma unroll
        for (int t = 0; t < 4; ++t) {
            const u16* xp = X.XB + (size_t)(row0 + t) * DM + lane * 16; const u32x4 xa = *(const u32x4*)xp, xb = *(const u32x4*)(xp + 8);
            float s = 0.f;
#pragma unroll
            for (int e = 0; e < 4; ++e) { s += bflo(xa[e]) * bflo(wa[e]) + bfhi(xa[e]) * bfhi(wa[e]); s += bflo(xb[e]) * bflo(wb[e]) + bfhi(xb[e]) * bfhi(wb[e]); }
            s = wave_sum(s);
            const float dt = softplus_f(s * rstd_row(X.SSP, row0 + t) + X.in[I_DTB][l * 16 + h]);
            if (lane == 0) DTS[t * 8 + wid] = dt;
        }
    }
    __syncthreads();
    const int p = tid >> 3, nq = tid & 7, n0 = 16 * nq;
    f32x4 nx[4];
    {
        const size_t sidx0 = ((size_t)((l * 128 + b) * 16 + 8 * grp) * 64 + p) * 128 + n0;
#pragma unroll
        for (int e4 = 0; e4 < 4; ++e4) nx[e4] = *(const f32x4*)(X.in[I_SSSM] + sidx0 + 4 * e4);
    }
    for (int hh = 0; hh < 8; ++hh) {
        const int h = 8 * grp + hh; const size_t sidx = ((size_t)((l * 128 + b) * 16 + h) * 64 + p) * 128 + n0;
        float hst[16];
#pragma unroll
        for (int e4 = 0; e4 < 4; ++e4) { const f32x4 v = nx[e4]; hst[4 * e4] = v.x; hst[4 * e4 + 1] = v.y; hst[4 * e4 + 2] = v.z; hst[4 * e4 + 3] = v.w; }
        if (hh < 7) {
#pragma unroll
            for (int e4 = 0; e4 < 4; ++e4) nx[e4] = *(const f32x4*)(X.in[I_SSSM] + sidx + 8192 + 4 * e4);
        }
        const float A = -expf(X.in[I_ALOG][l * 16 + h]), Dh = X.in[I_DSK][l * 16 + h];
        float y[4];
#pragma unroll
        for (int t = 0; t < 4; ++t) {
            const float dt = DTS[t * 8 + hh], dA = __expf(dt * A), dx = dt * XS[t * 512 + hh * 64 + p]; float acc = 0.f;
#pragma unroll
            for (int e = 0; e < 16; ++e) { hst[e] = fmaf(hst[e], dA, dx * BS[t * 128 + n0 + e]); acc = fmaf(hst[e], CS[t * 128 + n0 + e], acc); }
            y[t] = acc;
        }
#pragma unroll
        for (int e4 = 0; e4 < 4; ++e4) { f32x4 v; v.x = hst[4 * e4]; v.y = hst[4 * e4 + 1]; v.z = hst[4 * e4 + 2]; v.w = hst[4 * e4 + 3]; *(f32x4*)(X.out + O_HS + sidx + 4 * e4) = v; }
#pragma unroll
        for (int t = 0; t < 4; ++t) {
            float yy = y[t]; yy += __shfl_xor(yy, 1); yy += __shfl_xor(yy, 2); yy += __shfl_xor(yy, 4);
            if (nq == 0) { const float yv = yy + Dh * XS[t * 512 + hh * 64 + p]; const float z = bf2f(X.PROJ[(size_t)(row0 + t) * NPROJ + C_Z + 64 * h + p]); YG[t * 512 + hh * 64 + p] = yv * silu_f(z); }
        }
    }
    __syncthreads();
    if (wid < 4) {
        const int t = wid; float ss = 0.f;
#pragma unroll
        for (int k = 0; k < 8; ++k) { const float v = YG[t * 512 + lane + 64 * k]; ss += v * v; }
        ss = wave_sum(ss); const float rs = rsqrtf(ss * (1.f / 512.f) + EPS);
#pragma unroll
        for (int k = 0; k < 8; ++k) { const int col = lane + 64 * k; X.YMIX[(size_t)(row0 + t) * NMIX + 512 * grp + col] = (u16)f2bf(YG[t * 512 + col] * rs); }
    }
}
constexpr int KNP = 72;
constexpr int VTP = 264;
__device__ __forceinline__ void attn_prompt_unit(const Ctx& X, int l, int b, int nb, ldsp L, int tid, int wid, int lane) {
    LAS u16* Kn = (LAS u16*)L;
    LAS u16* Vt = (LAS u16*)(L + 73728);
    const int i = lane & 15, g = lane >> 4;
    {
        const int key = tid >> 1, part = tid & 1, tk = nb * 128 - 128 + key; const bool last = (nb == 63) && key >= 128;
        if (tk < 0) {
#pragma unroll
            for (int kvh = 0; kvh < 2; ++kvh) {
                LAS u16* kd = Kn + (kvh * 256 + key) * KNP + 16 * part; LAS u16* vd = Vt + (kvh * 64 + 16 * part) * VTP + key;
                *(LAS u32x4*)(kd) = (u32x4){0u, 0u, 0u, 0u}; *(LAS u32x4*)(kd + 8) = (u32x4){0u, 0u, 0u, 0u}; *(LAS u32x4*)(kd + 32) = (u32x4){0u, 0u, 0u, 0u}; *(LAS u32x4*)(kd + 40) = (u32x4){0u, 0u, 0u, 0u};
#pragma unroll
                for (int d = 0; d < 16; ++d) { vd[d * VTP] = 0; vd[(32 + d) * VTP] = 0; }
            }
        } else {
            const u16* src0 = X.PROJ + (size_t)(b * 8192 + tk) * NPROJ + 16 * part;
            u32x4 kw[2][4], vw[2][4];
#pragma unroll
            for (int kvh = 0; kvh < 2; ++kvh) {
                const u16* src = src0 + 64 * kvh;
                kw[kvh][0] = *(const u32x4*)(src + C_K); kw[kvh][1] = *(const u32x4*)(src + C_K + 8); kw[kvh][2] = *(const u32x4*)(src + C_K + 32); kw[kvh][3] = *(const u32x4*)(src + C_K + 40);
                vw[kvh][0] = *(const u32x4*)(src + C_V); vw[kvh][1] = *(const u32x4*)(src + C_V + 8); vw[kvh][2] = *(const u32x4*)(src + C_V + 32); vw[kvh][3] = *(const u32x4*)(src + C_V + 40);
            }
            float cs[16], sn[16];
            {
                const f32x4* cp = (const f32x4*)(X.COS + (size_t)tk * 32 + 16 * part); const f32x4* sp = (const f32x4*)(X.SIN + (size_t)tk * 32 + 16 * part);
#pragma unroll
                for (int e = 0; e < 4; ++e) { const f32x4 c4 = cp[e], s4 = sp[e]; cs[4 * e] = c4.x; cs[4 * e + 1] = c4.y; cs[4 * e + 2] = c4.z; cs[4 * e + 3] = c4.w; sn[4 * e] = s4.x; sn[4 * e + 1] = s4.y; sn[4 * e + 2] = s4.z; sn[4 * e + 3] = s4.w; }
            }
            const float* kn = X.in[I_KN] + l * 64 + 16 * part;
#pragma unroll
            for (int kvh = 0; kvh < 2; ++kvh) {
                LAS u16* kd = Kn + (kvh * 256 + key) * KNP + 16 * part; LAS u16* vd = Vt + (kvh * 64 + 16 * part) * VTP + key;
                float x1[16], x2[16]; float ss = 0.f;
#pragma unroll
                for (int q = 0; q < 4; ++q) { x1[2 * q] = bflo(kw[kvh][0][q]); x1[2 * q + 1] = bfhi(kw[kvh][0][q]); x1[8 + 2 * q] = bflo(kw[kvh][1][q]); x1[8 + 2 * q + 1] = bfhi(kw[kvh][1][q]);
                    x2[2 * q] = bflo(kw[kvh][2][q]); x2[2 * q + 1] = bfhi(kw[kvh][2][q]); x2[8 + 2 * q] = bflo(kw[kvh][3][q]); x2[8 + 2 * q + 1] = bfhi(kw[kvh][3][q]); }
#pragma unroll
                for (int d = 0; d < 16; ++d) ss += x1[d] * x1[d] + x2[d] * x2[d];
                ss += __shfl_xor(ss, 1);
                const float rs = rsqrtf(ss * (1.f / 64.f) + EPS);
#pragma unroll
                for (int d = 0; d < 16; ++d) { const float u1 = x1[d] * rs * kn[d], u2 = x2[d] * rs * kn[d + 32], c = cs[d], sv = sn[d]; x1[d] = u1 * c - u2 * sv; x2[d] = u2 * c + u1 * sv; }
#pragma unroll
                for (int e = 0; e < 2; ++e) { u32x4 w; w.x = pk2(x1[8 * e], x1[8 * e + 1]); w.y = pk2(x1[8 * e + 2], x1[8 * e + 3]); w.z = pk2(x1[8 * e + 4], x1[8 * e + 5]); w.w = pk2(x1[8 * e + 6], x1[8 * e + 7]); *(LAS u32x4*)(kd + 8 * e) = w;
                    u32x4 v; v.x = pk2(x2[8 * e], x2[8 * e + 1]); v.y = pk2(x2[8 * e + 2], x2[8 * e + 3]); v.z = pk2(x2[8 * e + 4], x2[8 * e + 5]); v.w = pk2(x2[8 * e + 6], x2[8 * e + 7]); *(LAS u32x4*)(kd + 32 + 8 * e) = v; }
                const size_t oidx = (((size_t)(l * 4 + b) * 128 + (key - 128)) * 2 + kvh) * 64 + 16 * part;
                if (last) { float* o = X.out + O_KP + oidx;
#pragma unroll
                    for (int e = 0; e < 4; ++e) { *(f32x4*)(o + 4 * e) = (f32x4){x1[4 * e], x1[4 * e + 1], x1[4 * e + 2], x1[4 * e + 3]}; *(f32x4*)(o + 32 + 4 * e) = (f32x4){x2[4 * e], x2[4 * e + 1], x2[4 * e + 2], x2[4 * e + 3]}; } }
#pragma unroll
                for (int hf = 0; hf < 2; ++hf)
#pragma unroll
                    for (int e = 0; e < 2; ++e) { const u32x4 w = vw[kvh][2 * hf + e];
#pragma unroll
                        for (int q = 0; q < 4; ++q) { vd[(32 * hf + 8 * e + 2 * q) * VTP] = (u16)(w[q] & 0xffffu); vd[(32 * hf + 8 * e + 2 * q + 1) * VTP] = (u16)(w[q] >> 16); }
                        if (last) { float* ov = X.out + O_VP + oidx + 32 * hf + 8 * e; *(f32x4*)(ov) = (f32x4){bflo(w[0]), bfhi(w[0]), bflo(w[1]), bfhi(w[1])}; *(f32x4*)(ov + 4) = (f32x4){bflo(w[2]), bfhi(w[2]), bflo(w[3]), bfhi(w[3])}; } }
            }
        }
    }
    __syncthreads();
    const int kvh = wid >> 2; const float sink = X.in[I_SINK][l * 8 + wid];
    const float* qn = X.in[I_QN] + l * 64;
    u32x4 nqa, nqb; f32x4 ncs0, ncs1, nsn0, nsn1;
    {
        const int tq0 = nb * 128 + i; const size_t row0q = (size_t)b * 8192 + tq0;
        nqa = *(const u32x4*)(X.PROJ + row0q * NPROJ + 64 * wid + 8 * g); nqb = *(const u32x4*)(X.PROJ + row0q * NPROJ + 64 * wid + 32 + 8 * g);
        ncs0 = *(const f32x4*)(X.COS + (size_t)tq0 * 32 + 8 * g); ncs1 = *(const f32x4*)(X.COS + (size_t)tq0 * 32 + 8 * g + 4);
        nsn0 = *(const f32x4*)(X.SIN + (size_t)tq0 * 32 + 8 * g); nsn1 = *(const f32x4*)(X.SIN + (size_t)tq0 * 32 + 8 * g + 4);
    }
    for (int qt = 0; qt < 8; ++qt) {
        const int qi = 16 * qt + i, tq = nb * 128 + qi; const size_t row = (size_t)b * 8192 + tq;
        bf16x8 qf0, qf1;
        {
            const u32x4 wa = nqa, wb = nqb; const f32x4 c0 = ncs0, c1 = ncs1, s0v = nsn0, s1v = nsn1;
            {
                const int qn_ = qt < 7 ? qt + 1 : 7; const int tqn = nb * 128 + 16 * qn_ + i; const size_t rown = (size_t)b * 8192 + tqn;
                nqa = *(const u32x4*)(X.PROJ + rown * NPROJ + 64 * wid + 8 * g); nqb = *(const u32x4*)(X.PROJ + rown * NPROJ + 64 * wid + 32 + 8 * g);
                ncs0 = *(const f32x4*)(X.COS + (size_t)tqn * 32 + 8 * g); ncs1 = *(const f32x4*)(X.COS + (size_t)tqn * 32 + 8 * g + 4);
                nsn0 = *(const f32x4*)(X.SIN + (size_t)tqn * 32 + 8 * g); nsn1 = *(const f32x4*)(X.SIN + (size_t)tqn * 32 + 8 * g + 4);
            }
            float x1[8], x2[8]; float ss = 0.f;
#pragma unroll
            for (int q = 0; q < 4; ++q) { x1[2 * q] = bflo(wa[q]); x1[2 * q + 1] = bfhi(wa[q]); x2[2 * q] = bflo(wb[q]); x2[2 * q + 1] = bfhi(wb[q]); }
#pragma unroll
            for (int e = 0; e < 8; ++e) ss += x1[e] * x1[e] + x2[e] * x2[e];
            ss += __shfl_xor(ss, 16); ss += __shfl_xor(ss, 32);
            const float rs = rsqrtf(ss * (1.f / 64.f) + EPS) * 0.125f;
            const float cs[8] = {c0.x, c0.y, c0.z, c0.w, c1.x, c1.y, c1.z, c1.w}, sn[8] = {s0v.x, s0v.y, s0v.z, s0v.w, s1v.x, s1v.y, s1v.z, s1v.w};
            float o1[8], o2[8];
#pragma unroll
            for (int e = 0; e < 8; ++e) { const float a = x1[e] * rs * qn[8 * g + e], bb = x2[e] * rs * qn[32 + 8 * g + e], c = cs[e], s = sn[e]; o1[e] = a * c - bb * s; o2[e] = bb * c + a * s; }
            u32x4 w0, w1; w0.x = pk2(o1[0], o1[1]); w0.y = pk2(o1[2], o1[3]); w0.z = pk2(o1[4], o1[5]); w0.w = pk2(o1[6], o1[7]);
            w1.x = pk2(o2[0], o2[1]); w1.y = pk2(o2[2], o2[3]); w1.z = pk2(o2[4], o2[5]); w1.w = pk2(o2[6], o2[7]);
            qf0 = __builtin_bit_cast(bf16x8, w0); qf1 = __builtin_bit_cast(bf16x8, w1);
        }
        f32x4 s[9]; float mx = -INFINITY;
#pragma unroll
        for (int kk = 0; kk < 9; ++kk) {
            const int kt = qt + kk; ldsp kp = (ldsp)(Kn + (kvh * 256 + 16 * kt + i) * KNP + 8 * g);
            f32x4 a = {0.f, 0.f, 0.f, 0.f}; a = mfma16(lds16(kp), qf0, a); a = mfma16(lds16(kp + 64), qf1, a);
#pragma unroll
            for (int j = 0; j < 4; ++j) { const int kj = 16 * kt + 4 * g + j; const bool ok = (kj > qi) && (kj <= qi + 128) && (nb > 0 || kj >= 128); a[j] = ok ? a[j] : -INFINITY; mx = fmaxf(mx, a[j]); }
            s[kk] = a;
        }
        mx = fmaxf(mx, __shfl_xor(mx, 16)); mx = fmaxf(mx, __shfl_xor(mx, 32)); mx = fmaxf(mx, sink);
        float sum = 0.f;
#pragma unroll
        for (int kk = 0; kk < 9; ++kk)
#pragma unroll
            for (int j = 0; j < 4; ++j) { const float p = __expf(s[kk][j] - mx); s[kk][j] = p; sum += p; }
        sum += __shfl_xor(sum, 16); sum += __shfl_xor(sum, 32);
        const float inv = 1.f / (sum + __expf(sink - mx));
        f32x4 o[4];
#pragma unroll
        for (int dt = 0; dt < 4; ++dt) o[dt] = (f32x4){0.f, 0.f, 0.f, 0.f};
#pragma unroll
        for (int pi = 0; pi < 5; ++pi) {
            const int k0 = 2 * pi, k1 = (2 * pi + 1 < 9) ? 2 * pi + 1 : 2 * pi;
            u32x4 pw; pw.x = pk2(s[k0][0], s[k0][1]); pw.y = pk2(s[k0][2], s[k0][3]);
            if (2 * pi + 1 < 9) { pw.z = pk2(s[k1][0], s[k1][1]); pw.w = pk2(s[k1][2], s[k1][3]); } else { pw.z = 0u; pw.w = 0u; }
            const bf16x8 pf = __builtin_bit_cast(bf16x8, pw);
#pragma unroll
            for (int dt = 0; dt < 4; ++dt) {
                LAS u16* vr = Vt + (kvh * 64 + 16 * dt + i) * VTP + 4 * g;
                const bf16x8 vf = lds8x2((ldsp)(vr + 16 * (qt + k0)), (ldsp)(vr + 16 * (qt + k1)));
                o[dt] = mfma16(vf, pf, o[dt]);
            }
        }
#pragma unroll
        for (int dt = 0; dt < 4; ++dt) { u32x2 w; w.x = pk2(o[dt][0] * inv, o[dt][1] * inv); w.y = pk2(o[dt][2] * inv, o[dt][3] * inv);
            *(u32x2*)(X.YMIX + row * NMIX + 1024 + 64 * wid + 16 * dt + 4 * g) = w; }
    }
}

__device__ __forceinline__ void scan_unit(const Ctx& X, int l, int hs, int tid) {
    const int b = hs >> 7, h = (hs >> 3) & 15, pq = hs & 7;
    const int p = 8 * pq + (tid >> 6), n = (tid & 63) * 2;
    u16* base = X.ST + ((size_t)(b * 64) * 16 + h) * 8192 + p * 128 + n;
    const float* cd = X.CD + (b * 64) * 16 + h;
    float h0 = 0.f, h1 = 0.f;
    for (int c0 = 0; c0 < 64; c0 += 32) {
        unsigned st[32]; float dc[32];
#pragma unroll
        for (int e = 0; e < 32; ++e) { st[e] = *(const unsigned*)(base + (size_t)(c0 + e) * 16 * 8192); dc[e] = cd[(c0 + e) * 16]; }
#pragma unroll
        for (int e = 0; e < 32; ++e) {
            *(unsigned*)(base + (size_t)(c0 + e) * 16 * 8192) = pk2(h0, h1);
            h0 = fmaf(h0, dc[e], bflo(st[e])); h1 = fmaf(h1, dc[e], bfhi(st[e]));
        }
    }
    float* o = X.out + O_HP + ((size_t)((l * 4 + b) * 16 + h) * 64 + p) * 128 + n; o[0] = h0; o[1] = h1;
}

constexpr int KCP = 132;
__device__ __forceinline__ void attn_sample_unit(const Ctx& X, int l, int b, ldsp L, int tid, int wid, int lane) {
    LAS u16* KC = (LAS u16*)L;
    LAS u16* VC = (LAS u16*)(L + 34848);
    LAS float* QS = (LAS float*)(L + 69696);
    LAS float* SS = (LAS float*)(L + 77888);
    const int row0 = MP + b * 4;
#pragma unroll
    for (int k = 0; k < 8; ++k) {
        const int idx = tid + 512 * k, j = idx >> 5, c4 = (idx & 31) * 4; const size_t off = ((size_t)(l * 128 + b) * 128 + j) * 128 + c4;
        const f32x4 kv = *(const f32x4*)(X.in[I_CK] + off), vv = *(const f32x4*)(X.in[I_CV] + off);
        { u32x2 kw2; kw2.x = pk2(kv.x, kv.y); kw2.y = pk2(kv.z, kv.w); *(LAS u32x2*)(KC + j * KCP + c4) = kw2; u32x2 vw2; vw2.x = pk2(vv.x, vv.y); vw2.y = pk2(vv.z, vv.w); *(LAS u32x2*)(VC + j * KCP + c4) = vw2; }
        if (j >= 4) { const size_t oo = ((size_t)(l * 128 + b) * 128 + (j - 4)) * 128 + c4; *(f32x4*)(X.out + O_KS + oo) = kv; *(f32x4*)(X.out + O_VS + oo) = vv; }
    }
    {
        const int t = wid >> 1, kvh = wid & 1; const u16* src = X.PROJ + (size_t)(row0 + t) * NPROJ;
        const float x = bf2f(src[C_K + 64 * kvh + lane]); const float ss = wave_sum(x * x);
        const float xn = x * rsqrtf(ss * (1.f / 64.f) + EPS) * X.in[I_KN][l * 64 + lane]; const float pr = __shfl_xor(xn, 32);
        const float c = X.COS[(size_t)(8192 + t) * 32 + (lane & 31)], s = X.SIN[(size_t)(8192 + t) * 32 + (lane & 31)];
        const float o = lane < 32 ? xn * c - pr * s : xn * c + pr * s;
        KC[(128 + t) * KCP + kvh * 64 + lane] = (u16)f2bf(o);
        const size_t oo = ((size_t)(l * 128 + b) * 128 + 124 + t) * 128 + kvh * 64 + lane;
        X.out[O_KS + oo] = o;
        const unsigned vraw = src[C_V + 64 * kvh + lane]; VC[(128 + t) * KCP + kvh * 64 + lane] = (u16)vraw; X.out[O_VS + oo] = bf2f(vraw);
    }
#pragma unroll
    for (int k = 0; k < 4; ++k) {
        const int pair = 4 * wid + k, t = pair >> 3, head = pair & 7;
        const float x = bf2f(X.PROJ[(size_t)(row0 + t) * NPROJ + 64 * head + lane]); const float ss = wave_sum(x * x);
        const float xn = x * rsqrtf(ss * (1.f / 64.f) + EPS) * X.in[I_QN][l * 64 + lane]; const float pr = __shfl_xor(xn, 32);
        const float c = X.COS[(size_t)(8192 + t) * 32 + (lane & 31)], s = X.SIN[(size_t)(8192 + t) * 32 + (lane & 31)];
        QS[pair * 64 + lane] = (lane < 32 ? xn * c - pr * s : xn * c + pr * s) * 0.125f;
    }
    __syncthreads();
    for (int it = 0; it < 9; ++it) {
        const int idx = tid + 512 * it;
        if (idx < 32 * 132) {
            const int pair = idx / 132, key = idx - pair * 132, t = pair >> 3, head = pair & 7, kvh = head >> 2;
            const bool ok = key < 128 ? key > t : (key - 128) <= t;
            float s = 0.f;
#pragma unroll
            for (int d = 0; d < 64; d += 4) { const u32x2 kw2 = *(LAS u32x2*)(KC + key * KCP + kvh * 64 + d); const f32x4 q4 = *(LAS f32x4*)(QS + pair * 64 + d);
                s = fmaf(q4.x, bflo(kw2.x), s); s = fmaf(q4.y, bfhi(kw2.x), s); s = fmaf(q4.z, bflo(kw2.y), s); s = fmaf(q4.w, bfhi(kw2.y), s); }
            SS[pair * 136 + key] = ok ? s : -INFINITY;
        }
    }
    __syncthreads();
#pragma unroll
    for (int k = 0; k < 4; ++k) {
        const int pair = 4 * wid + k, head = pair & 7; const float sink = X.in[I_SINK][l * 8 + head];
        const float v0 = SS[pair * 136 + lane], v1 = SS[pair * 136 + 64 + lane], v2 = lane < 4 ? SS[pair * 136 + 128 + lane] : -INFINITY;
        const float mx = fmaxf(wave_max(fmaxf(fmaxf(v0, v1), v2)), sink);
        const float e0 = __expf(v0 - mx), e1 = __expf(v1 - mx), e2 = __expf(v2 - mx);
        const float inv = 1.f / (wave_sum(e0 + e1 + e2) + __expf(sink - mx));
        SS[pair * 136 + lane] = e0 * inv; SS[pair * 136 + 64 + lane] = e1 * inv; if (lane < 4) SS[pair * 136 + 128 + lane] = e2 * inv;
    }
    __syncthreads();
    {
        const int pair = tid >> 4, d4 = (tid & 15) * 4, head = pair & 7, kvh = head >> 2, t = pair >> 3;
        float a0 = 0.f, a1 = 0.f, a2 = 0.f, a3 = 0.f;
        for (int key = 0; key < 132; ++key) {
            const float p = SS[pair * 136 + key]; const u32x2 vw2 = *(LAS u32x2*)(VC + key * KCP + kvh * 64 + d4); const unsigned w0 = vw2.x, w1 = vw2.y;
            a0 = fmaf(p, bflo(w0), a0); a1 = fmaf(p, bfhi(w0), a1); a2 = fmaf(p, bflo(w1), a2); a3 = fmaf(p, bfhi(w1), a3);
        }
        u32x2 w; w.x = pk2(a0, a1); w.y = pk2(a2, a3); *(u32x2*)(X.YMIX + (size_t)(row0 + t) * NMIX + 1024 + 64 * head + d4) = w;
    }
}

constexpr int CNP = 136;
template <int MODE> __device__ __forceinline__ void ssd_out_unit(const Ctx& X, int l, int b, int c, ldsp L, int tid, int wid, int lane) {
    LAS float* DTL = (LAS float*)L; LAS float* ACL = (LAS float*)(L + 8192);
    LAS u16* CcL = (LAS u16*)(L + 16384);
    LAS u16* CBL = (LAS u16*)(L + 16384 + 34816);
    LAS float* SSQ = (LAS float*)(L + 16384 + 34816 + 18432);
    LAS u16* XT = (LAS u16*)(L + 73728);
    LAS u16* BcL = XT;
    const int i = lane & 15, g = lane >> 4, r0 = b * 8192 + c * 128;
    const float* cw = X.in[I_CW] + (size_t)l * 4 * 1536; const float* cb = X.in[I_CB] + (size_t)l * 1536;
    { const f32x4 d4 = *(const f32x4*)(X.DT + (size_t)r0 * 16 + tid * 4); const int s_ = tid >> 2, h0 = (tid & 3) * 4;
      DTL[(h0 + 0) * 128 + s_] = d4.x; DTL[(h0 + 1) * 128 + s_] = d4.y; DTL[(h0 + 2) * 128 + s_] = d4.z; DTL[(h0 + 3) * 128 + s_] = d4.w; }
    __syncthreads();
    acum_scan(DTL, ACL, X.in[I_ALOG] + l * 16, wid, lane);
    if (c == 63) for (int idx = tid; idx < 3 * 1536; idx += 512) { const int j = idx / 1536, col = idx - j * 1536;
        X.out[O_CP + ((size_t)(l * 4 + b) * 3 + j) * 1536 + col] = bf2f(X.PROJ[(size_t)(b * 8192 + 8189 + j) * NPROJ + C_X + col]); }
    __syncthreads();
    for (int grp = 0; grp < 2; ++grp) {
        {
            const int cg = lane, tok0 = 16 * wid, isC = cg >> 5, n0 = 4 * (cg & 31), xcol0 = 1024 + 256 * isC + 128 * grp + n0; const ConvW4 w = conv4_w(cw, cb, xcol0);
            float raw[19][4]; conv4_load<16>(raw, X.PROJ, r0 + tok0, !(c == 0 && tok0 == 0), xcol0);
            LAS u16* dst = (isC ? CcL : BcL) + tok0 * CNP + n0;
#pragma unroll
            for (int k = 0; k < 16; ++k) { u32x2 pw; pw.x = pk2(CONV4_TAP(w, raw, k, 0), CONV4_TAP(w, raw, k, 1)); pw.y = pk2(CONV4_TAP(w, raw, k, 2), CONV4_TAP(w, raw, k, 3)); *(LAS u32x2*)(dst + k * CNP) = pw; }
        }
        __syncthreads();
        if (MODE != 1) for (int tix = wid; tix < 36; tix += 8) {
            int qt = 0; while ((qt + 1) * (qt + 2) / 2 <= tix) ++qt; const int st = tix - qt * (qt + 1) / 2;
            f32x4 a = {0.f, 0.f, 0.f, 0.f};
#pragma unroll
            for (int kk = 0; kk < 4; ++kk) a = mfma16(lds16((ldsp)(BcL + (16 * st + i) * CNP + 32 * kk + 8 * g)), lds16((ldsp)(CcL + (16 * qt + i) * CNP + 32 * kk + 8 * g)), a);
            { u32x2 cw; cw.x = pk2(a[0], a[1]); cw.y = pk2(a[2], a[3]); *(LAS u32x2*)(CBL + (tix * 64 + lane) * 4) = cw; }
        }
        __syncthreads();
        for (int quad = 0; quad < 2; ++quad) {
            const int hq = 2 * grp + quad;
            bf16x8 hsf[4][4];
            {
                const int cg = lane, tok0 = 16 * wid, xcol0 = 256 * hq + 4 * cg; const ConvW4 w = conv4_w(cw, cb, xcol0);
                float raw[19][4]; conv4_load<16>(raw, X.PROJ, r0 + tok0, !(c == 0 && tok0 == 0), xcol0);
                {
                    const u16* hsb = X.ST + ((size_t)((b * 64 + c) * 16 + 4 * hq + (wid >> 1))) * 8192;
#pragma unroll
                    for (int pt = 0; pt < 4; ++pt)
#pragma unroll
                        for (int kk = 0; kk < 4; ++kk) hsf[pt][kk] = *(const bf16x8*)(hsb + (16 * pt + i) * 128 + 32 * kk + 8 * g);
                }
#pragma unroll
                for (int e = 0; e < 4; ++e)
#pragma unroll
                    for (int kq = 0; kq < 4; ++kq) { u32x2 pw; pw.x = pk2(CONV4_TAP(w, raw, 4 * kq, e), CONV4_TAP(w, raw, 4 * kq + 1, e)); pw.y = pk2(CONV4_TAP(w, raw, 4 * kq + 2, e), CONV4_TAP(w, raw, 4 * kq + 3, e));
                        *(LAS u32x2*)(XT + (4 * cg + e) * XTP + tok0 + 4 * kq) = pw; }
            }
            __syncthreads();
            if (MODE != 1) {
                const int hl = wid >> 1, half = wid & 1, h = 4 * hq + hl, hh = quad * 4 + hl;
                const float Dh = X.in[I_DSK][l * 16 + h];
                for (int qx = 0; qx < 4; ++qx) {
                    const int qt = qx == 0 ? half : (qx == 1 ? 3 - half : (qx == 2 ? 4 + half : 7 - half));
                    const int q = 16 * qt + i; const float aq = ACL[h * 128 + q], eaq = __expf(aq);
                    const size_t row = (size_t)r0 + q; u32x2 zw[4];
#pragma unroll
                    for (int pt = 0; pt < 4; ++pt) zw[pt] = *(const u32x2*)(X.PROJ + row * NPROJ + C_Z + 64 * h + 16 * pt + 4 * g);
                    f32x4 accy[4], acci[4];
#pragma unroll
                    for (int pt = 0; pt < 4; ++pt) { accy[pt] = (f32x4){0.f, 0.f, 0.f, 0.f}; acci[pt] = (f32x4){0.f, 0.f, 0.f, 0.f}; }
#pragma unroll
                    for (int kk = 0; kk < 4; ++kk) { const bf16x8 cf = lds16((ldsp)(CcL + q * CNP + 32 * kk + 8 * g));
#pragma unroll
                        for (int pt = 0; pt < 4; ++pt) accy[pt] = mfma16(hsf[pt][kk], cf, accy[pt]); }
                    const int tb = qt * (qt + 1) / 2, npair = qt / 2 + 1;
                    for (int pi = 0; pi < npair; ++pi) {
                        const int st0 = 2 * pi; const bool has1 = (st0 + 1) <= qt; const int st1 = has1 ? st0 + 1 : st0;
                        float m0[4], m1[4];
                        {
                            const int sa0 = 16 * st0 + 4 * g, sb0 = 16 * st1 + 4 * g;
                            const u32x2 cwa = *(LAS u32x2*)(CBL + ((tb + st0) * 64 + lane) * 4), cwb = *(LAS u32x2*)(CBL + ((tb + st1) * 64 + lane) * 4);
                            const f32x4 aca = *(LAS f32x4*)(ACL + h * 128 + sa0), acb = *(LAS f32x4*)(ACL + h * 128 + sb0);
                            const f32x4 dta = *(LAS f32x4*)(DTL + h * 128 + sa0), dtb = *(LAS f32x4*)(DTL + h * 128 + sb0);
                            const float ca[4] = {bflo(cwa.x), bfhi(cwa.x), bflo(cwa.y), bfhi(cwa.y)}, cb4[4] = {bflo(cwb.x), bfhi(cwb.x), bflo(cwb.y), bfhi(cwb.y)};
#pragma unroll
                            for (int j = 0; j < 4; ++j) {
                                const float va = ca[j] * __expf(fminf(aq - aca[j], 0.f)) * dta[j], vb = cb4[j] * __expf(fminf(aq - acb[j], 0.f)) * dtb[j];
                                m0[j] = (sa0 + j) <= q ? va : 0.f; m1[j] = (has1 && (sb0 + j) <= q) ? vb : 0.f;
                            }
                        }
                        u32x4 mw; mw.x = pk2(m0[0], m0[1]); mw.y = pk2(m0[2], m0[3]); mw.z = pk2(m1[0], m1[1]); mw.w = pk2(m1[2], m1[3]);
                        const bf16x8 mf = __builtin_bit_cast(bf16x8, mw);
#pragma unroll
                        for (int pt = 0; pt < 4; ++pt) { LAS u16* xr = XT + (hl * 64 + 16 * pt + i) * XTP + 4 * g;
                            acci[pt] = mfma16(lds8x2((ldsp)(xr + 16 * st0), (ldsp)(xr + 16 * st1)), mf, acci[pt]); }
                    }
                    float ss = 0.f;
#pragma unroll
                    for (int pt = 0; pt < 4; ++pt) {
                        const int p0 = 16 * pt + 4 * g;
                        const float z[4] = {bflo(zw[pt].x), bfhi(zw[pt].x), bflo(zw[pt].y), bfhi(zw[pt].y)}; float o[4];
#pragma unroll
                        for (int j = 0; j < 4; ++j) { const float xv = bf2f(XT[(hl * 64 + p0 + j) * XTP + q]); const float y = acci[pt][j] + eaq * accy[pt][j] + Dh * xv; o[j] = y * silu_f(z[j]); ss += o[j] * o[j]; }
                        u32x2 w; w.x = pk2(o[0], o[1]); w.y = pk2(o[2], o[3]); *(u32x2*)(X.YMIX + row * NMIX + 64 * h + p0) = w;
                    }
                    ss += __shfl_xor(ss, 16); ss += __shfl_xor(ss, 32);
                    if (g == 0) SSQ[q * 8 + hh] = ss;
                }
            }
            __syncthreads();
        }
        if (MODE == 0 && tid < 128) {
            const f32x4 s0 = *(LAS f32x4*)(SSQ + tid * 8), s1 = *(LAS f32x4*)(SSQ + tid * 8 + 4);
            X.RS[((size_t)r0 + tid) * 2 + grp] = rsqrtf((((s0.x + s0.y) + (s0.z + s0.w)) + ((s1.x + s1.y) + (s1.z + s1.w))) * (1.f / 512.f) + EPS);
        }
        __syncthreads();
    }
}
constexpr int N_PHASES = 1 + 7 * NL;

__device__ __forceinline__ void small_res_unit(const u16* A, const u16* WT, int K, float* outf, u16* xb, float* ssp, int u, ldsp L, int tid, int wid, int lane) {
    const int rt = u >> 4, ct = u & 15, i = lane & 15, g = lane >> 4;
    const int trow = 32 * rt + 16 * (wid >> 2) + i, col0 = 64 * ct + 16 * (wid & 3);
    const u16* ap = A + (size_t)(MP + trow) * K + 8 * g; const u16* wp = WT + (size_t)(col0 + i) * K + 8 * g;
    f32x4 acc = {0.f, 0.f, 0.f, 0.f};
    if (K == NMIX) {
#pragma unroll 24
        for (int kk = 0; kk < NMIX / 32; ++kk) acc = mfma16(*(const bf16x8*)(wp + 32 * kk), *(const bf16x8*)(ap + 32 * kk), acc);
    } else {
#pragma unroll 22
        for (int kk = 0; kk < DFF / 32; ++kk) acc = mfma16(*(const bf16x8*)(wp + 32 * kk), *(const bf16x8*)(ap + 32 * kk), acc);
    }
    const size_t o = (size_t)(MP + trow) * DM + col0 + 4 * g;
    const u32x2 rw = *(const u32x2*)(xb + o); const f32x4 r = {bflo(rw.x), bfhi(rw.x), bflo(rw.y), bfhi(rw.y)};
    const f32x4 v = acc + r;
    if (outf) *(f32x4*)(outf + o) = v;
    u32x2 w; w.x = pk2(v[0], v[1]); w.y = pk2(v[2], v[3]); *(u32x2*)(xb + o) = w;
    float ss = (v[0] * v[0] + v[1] * v[1]) + (v[2] * v[2] + v[3] * v[3]); ss += __shfl_xor(ss, 16); ss += __shfl_xor(ss, 32);
    LAS float* red = (LAS float*)L;
    if (g == 0) red[wid * 16 + i] = ss;
    __syncthreads();
    if (tid < 32) { const int hw = tid >> 4, t = tid & 15; ssp[(size_t)(MP + 32 * rt + 16 * hw + t) * 16 + ct] = (red[(4 * hw) * 16 + t] + red[(4 * hw + 1) * 16 + t]) + (red[(4 * hw + 2) * 16 + t] + red[(4 * hw + 3) * 16 + t]); }
    __syncthreads();
}

__device__ __forceinline__ void small_swiglu_unit(const u16* A, const u16* WT, const float* ssp, u16* H, int u, int wid, int lane) {
    const int rt = u / 44, ct = u - rt * 44, i = lane & 15, g = lane >> 4;
    const int trow = MP + 32 * rt + 16 * (wid >> 2) + i, f0 = 64 * ct + 16 * (wid & 3);
    const int wrow = (f0 >> 7) * 256 + (f0 & 127) + i;
    const u16* ap = A + (size_t)trow * DM + 8 * g; const u16* gp = WT + (size_t)wrow * DM + 8 * g; const u16* up = gp + (size_t)128 * DM;
    f32x4 ag = {0.f, 0.f, 0.f, 0.f}, au = {0.f, 0.f, 0.f, 0.f};
#pragma unroll 8
    for (int kk = 0; kk < DM / 32; ++kk) { const bf16x8 a = *(const bf16x8*)(ap + 32 * kk); ag = mfma16(*(const bf16x8*)(gp + 32 * kk), a, ag); au = mfma16(*(const bf16x8*)(up + 32 * kk), a, au); }
    const float rs = rstd_row(ssp, trow);
    u32x2 w; w.x = pk2(silu_f(ag[0] * rs) * (au[0] * rs), silu_f(ag[1] * rs) * (au[1] * rs)); w.y = pk2(silu_f(ag[2] * rs) * (au[2] * rs), silu_f(ag[3] * rs) * (au[3] * rs));
    *(u32x2*)(H + (size_t)trow * DFF + f0 + 4 * g) = w;
}
#define XB_TMO      128
#define XB_XCNT(j)  (256  + 64 * (j))
#define XB_XSUB(j)  (1280 + 64 * (j))
#define XB_XGEN(j)  (2304 + 64 * (j))
#define XB_TOP      3328
#define XB_TOPGEN   3392
#define XCD_BAR_WORDS 3456
#define XB_SPIN_CAP (1u << 18)

__device__ __forceinline__ unsigned xb_ld(unsigned* p)              { return __hip_atomic_load(p, __ATOMIC_RELAXED, __HIP_MEMORY_SCOPE_AGENT); }
__device__ __forceinline__ unsigned xb_add(unsigned* p, unsigned v) { return __hip_atomic_fetch_add(p, v, __ATOMIC_RELAXED, __HIP_MEMORY_SCOPE_AGENT); }
__device__ __forceinline__ unsigned xb_xcc_id() { return (unsigned)__builtin_amdgcn_s_getreg((3 << 11) | 20) & 0xFu; }
#define XB_SPIN(cond, bar) do { unsigned _sp = 0; while (cond) { __builtin_amdgcn_s_sleep(1); \
    if ((++_sp & 255u) == 0u) { if (xb_ld(&(bar)[XB_TMO])) break; if (_sp > XB_SPIN_CAP) { atomicAdd(&(bar)[XB_TMO], 1u); break; } } } } while (0)

struct XcdBarrier {
    unsigned* bar; unsigned x;
    volatile LAS unsigned* st;
};

__device__ __forceinline__ XcdBarrier xcd_barrier_post(unsigned* bar, volatile LAS unsigned* st) {
    XcdBarrier b; b.bar = bar; b.x = xb_xcc_id(); b.st = st;
    if (threadIdx.x == 0) (void)xb_add(&bar[XB_XCNT(b.x)], 1u);
    return b;
}
__device__ __forceinline__ void xcd_barrier_complete(unsigned* bar, unsigned x, unsigned& nloc, unsigned& nx) {
    const unsigned G = gridDim.x * gridDim.y * gridDim.z;
    unsigned sum, cnt, mine, sp = 0u;
    for (;;) {
        sum = 0u; cnt = 0u; mine = 0u;
#pragma unroll
        for (unsigned j = 0; j < 16; ++j) { const unsigned c = xb_ld(&bar[XB_XCNT(j)]); sum += c; cnt += (c > 0u) ? 1u : 0u; mine = (j == x) ? c : mine; }
        if (sum == G) break;
        __builtin_amdgcn_s_sleep(1);
        if ((++sp & 255u) == 0u) { if (xb_ld(&bar[XB_TMO])) break; if (sp > XB_SPIN_CAP) { atomicAdd(&bar[XB_TMO], 1u); break; } }
    }
    nloc = mine > 0u ? mine : 1u; nx = cnt > 0u ? cnt : 1u;
}

__device__ __forceinline__ void xcd_barrier(const XcdBarrier& b) {
    asm volatile("s_waitcnt vmcnt(0)" ::: "memory");
    __syncthreads();
    if (threadIdx.x == 0) {
        unsigned* bar = b.bar;
        __builtin_amdgcn_s_waitcnt(0);
        unsigned nloc = b.st[0], nx = b.st[1];
        if (nloc == 0u) { xcd_barrier_complete(bar, b.x, nloc, nx); b.st[0] = nloc; b.st[1] = nx; }
        const unsigned old = xb_add(&bar[XB_XSUB(b.x)], 1u);
        const unsigned gen = old / nloc;
        if (old + 1u == (gen + 1u) * nloc) {
            __builtin_amdgcn_fence(__ATOMIC_RELEASE, "agent");
            asm volatile("s_waitcnt vmcnt(0)" ::: "memory");
            const unsigned og = xb_add(&bar[XB_TOP], 1u);
            const unsigned tg = og / nx;
            if (og + 1u == (tg + 1u) * nx) xb_add(&bar[XB_TOPGEN], 1u);
            else XB_SPIN(xb_ld(&bar[XB_TOPGEN]) == tg, bar);
            __builtin_amdgcn_fence(__ATOMIC_ACQUIRE, "agent");
            xb_add(&bar[XB_XGEN(b.x)], 1u);
            asm volatile("s_waitcnt vmcnt(0)" ::: "memory");
        } else {
            XB_SPIN(xb_ld(&bar[XB_XGEN(b.x)]) == gen, bar);
            __builtin_amdgcn_fence(__ATOMIC_ACQUIRE, "agent");
            asm volatile("s_waitcnt vmcnt(0)" ::: "memory");
        }
    }
    __syncthreads();
}

#ifndef REP_SUB
#define REP_SUB 0
#endif
#ifndef REP_PH
#define REP_PH -1
#endif
#ifndef REP_MASK
#define REP_MASK 0
#endif
#ifndef UN_MASK
#define UN_MASK 31
#endif
#ifndef PH_MASK
#define PH_MASK 255
#endif
__global__ void __launch_bounds__(512, 2) hymba_mk(Params P) {
    extern __shared__ __attribute__((aligned(16))) unsigned char lds_raw[];
    ldsp L = (ldsp)lds_raw;
    u16* HB;
    volatile LAS unsigned* bst = (volatile LAS unsigned*)(L + LDS_BYTES - 64);
    if (threadIdx.x < 2) bst[threadIdx.x] = 0u;
    __syncthreads();
    const XcdBarrier xbar = xcd_barrier_post((unsigned*)(P.ws + WS_BAR), bst);
    if (P.ph_hi < 0) cg::this_grid().sync();
    for (int phi = P.ph_lo; phi < P.ph_hi + (REP_PH >= 0 ? 1 : 0); ++phi) {
        if (phi > P.ph_lo) xcd_barrier(xbar);
        const int ph = (REP_PH >= 0 && phi > REP_PH) ? phi - 1 : phi; const int rep = (REP_PH >= 0 && phi == REP_PH + 1) ? 1 : 0;
#ifdef EXTRA_SYNCS
        if (phi == 1) for (int es = 0; es < EXTRA_SYNCS; ++es) xcd_barrier(xbar);
#endif
        const __attribute__((address_space(4))) Params* pp = (const __attribute__((address_space(4))) Params*)__builtin_amdgcn_kernarg_segment_ptr();
        asm volatile("" : "+s"(pp));
        int tid = threadIdx.x; asm volatile("" : "+v"(tid));
        int bx = blockIdx.x, G = gridDim.x; asm volatile("" : "+s"(bx), "+s"(G));
        const int lane = tid & 63, wid = __builtin_amdgcn_readfirstlane(tid >> 6);
        Ctx X;
#pragma unroll
        for (int k = 0; k < 21; ++k) X.in[k] = pp->in[k];
        X.out = pp->out; X.ws = pp->ws;
        X.WinT = (u16*)(X.ws + WS_WIN); X.WoutT = (u16*)(X.ws + WS_WOUT); X.WguT = (u16*)(X.ws + WS_WGU); X.WdnT = (u16*)(X.ws + WS_WDN);
        X.COS = (float*)(X.ws + WS_ROPE); X.SIN = (float*)(X.ws + WS_ROPE + SZ_ROPE); X.XB = (u16*)(X.ws + WS_XB); X.SSP = (float*)(X.ws + WS_SSP);
        X.PROJ = (u16*)(X.ws + WS_PROJ); X.YMIX = (u16*)(X.ws + WS_YMIX); X.DT = (float*)(X.ws + WS_DT); X.CD = (float*)(X.ws + WS_CD); X.ST = (u16*)(X.ws + WS_ST); X.RS = (float*)(X.ws + WS_RS);
        HB = X.PROJ;
        if (ph == 0) { if (PH_MASK & 128) phase_prologue(X, L, tid, wid, lane); if (REP_MASK & 128) { __syncthreads(); phase_prologue(X, L, tid, wid, lane); } continue; }
        const int l = (ph - 1) / 7, k = (ph - 1) % 7;
        {
        if (k == 0 && (PH_MASK & 1)) {
            pg8::Gemm g{X.XB, X.WinT + (size_t)l * NIN * DM, M, NPROJ, DM}; pg8::StaticOrder S; S.init(M, NPROJ, G, bx);
            EpiProj E{X.PROJ, X.SSP, L + 131072};
            pg8::gemm_phase<EpiProj, pg8::StaticOrder, true, true>(L, g, S, E, tid);
            if (rep == 0) idle_dt_units(X, l, 130 * 13, G, bx, wid, lane);
            if (l == 0 && rep == 0) idle_weight_items(X, L, 0, 130 * 13, G, bx, wid, lane);
        } else if (k == 1 && (PH_MASK & 2)) {
            for (int u = bx; u < 512; u += G) {
                __syncthreads(); asm volatile("" : "+v"(tid)); const int lane = tid & 63, wid = __builtin_amdgcn_readfirstlane(tid >> 6);
                if (rep && REP_SUB == 1 && u >= 256) continue; if (rep && REP_SUB == 2 && u < 256) continue;
                if (u < 256) { if (UN_MASK & 8) ssd_states_unit(X, l, u >> 6, u & 63, L, tid, wid, lane); }
                else { if (UN_MASK & 16) ssd_sample_unit(X, l, (u - 256) >> 1, (u - 256) & 1, L, tid, wid, lane); }
            }
        } else if (k == 2 && (PH_MASK & 4)) {
#define PHB_SYNC() do { __syncthreads(); asm volatile("" : "+v"(tid)); } while (0)
            for (int u = bx; u < 256; u += G) { PHB_SYNC(); const int lane = tid & 63, wid = __builtin_amdgcn_readfirstlane(tid >> 6); attn_prompt_unit(X, l, u >> 6, u & 63, L, tid, wid, lane); }
            for (int u = bx; u < 128; u += G) { PHB_SYNC(); const int lane = tid & 63, wid = __builtin_amdgcn_readfirstlane(tid >> 6); attn_sample_unit(X, l, u, L, tid, wid, lane); }
            {
                int s0 = bx, sn = bx < 512 ? (512 - bx + G - 1) / G : 0, ss = G;
                if (G == 256) { if (bx < 128) { s0 = bx; sn = 1; ss = 1; } else { s0 = 128 + 3 * (bx - 128); sn = 3; ss = 1; } }
                if (rep == 0) for (int i2 = 0; i2 < sn; ++i2) scan_unit(X, l, s0 + i2 * ss, tid);
            }
        } else if (k == 3 && (PH_MASK & 8)) {
            for (int u = bx; u < 256; u += G) { __syncthreads(); asm volatile("" : "+v"(tid)); const int lane = tid & 63, wid = __builtin_amdgcn_readfirstlane(tid >> 6); if (rep && REP_SUB != 0) ssd_out_unit<REP_SUB>(X, l, u >> 6, u & 63, L, tid, wid, lane); else ssd_out_unit<0>(X, l, u >> 6, u & 63, L, tid, wid, lane); }
        } else if (k == 4 && (PH_MASK & 16)) {
            pg8::Gemm g{X.YMIX, X.WoutT + (size_t)l * DM * NMIX, MP, DM, NMIX}; pg8::StaticOrder S; S.init(MP, DM, G, bx);
            EpiResT<true> E{X.XB, nullptr, X.SSP, X.RS};
            pg8::gemm_phase<EpiResT<true>, pg8::StaticOrder, true, true>(L, g, S, E, tid);
            for (int u = bx; u < 256; u += G) small_res_unit(X.YMIX, X.WoutT + (size_t)l * DM * NMIX, NMIX, nullptr, X.XB, X.SSP, u, L, tid, wid, lane);
#if (REP_MASK & 256)
            if (l == 0) for (int rr = 0; rr < 4; ++rr) for (int u = bx; u < 256; u += G) small_res_unit(X.YMIX, X.WoutT + (size_t)l * DM * NMIX, NMIX, nullptr, X.XB, X.SSP, u, L, tid, wid, lane);
#endif
        } else if (k == 5 && (PH_MASK & 32)) {
            pg8::Gemm g{X.XB, X.WguT + (size_t)l * NGU * DM, M, NGU, DM}; pg8::StaticOrder S; S.init(M, NGU, G, bx);
            EpiSwiglu E{HB, X.SSP, L + 131072};
            pg8::gemm_phase<EpiSwiglu, pg8::StaticOrder, true, true>(L, g, S, E, tid);
            if (l == 0 && rep == 0) idle_weight_items(X, L, 1, 130 * 22, G, bx, wid, lane);
        } else if (PH_MASK & 64) {
            pg8::Gemm g{HB, X.WdnT + (size_t)l * DM * DFF, MP, DM, DFF}; pg8::StaticOrder S; S.init(MP, DM, G, bx);
            EpiResT<false> E{X.XB, l == NL - 1 ? X.out : nullptr, X.SSP, nullptr};
            pg8::gemm_phase<EpiResT<false>, pg8::StaticOrder, true, true>(L, g, S, E, tid);
            for (int u = bx; u < 256; u += G) small_res_unit(HB, X.WdnT + (size_t)l * DM * DFF, DFF, l == NL - 1 ? X.out : nullptr, X.XB, X.SSP, u, L, tid, wid, lane);
        }
        }
    }
}

#ifndef MK_ONE_LAUNCH
#define MK_ONE_LAUNCH 1
#endif
extern "C" void kernel_launch(void* const* d_in, const int* in_sizes, int n_in, void* d_out, int out_size, void* d_ws, size_t ws_size, hipStream_t stream) {
    static int grid = 0;
    if (grid == 0) {
        if (n_in != 21 || (size_t)out_size != O_END || ws_size < WS_BAR + SZ_BAR) { fprintf(stderr, "kernel_launch: unexpected shapes (n_in %d out %d ws %zu)\n", n_in, out_size, ws_size); grid = -1; return; }
        int dev = 0, cus = 0, per_cu = 0;
        (void)hipGetDevice(&dev); (void)hipDeviceGetAttribute(&cus, hipDeviceAttributeMultiprocessorCount, dev);
        if (hipFuncSetAttribute((const void*)hymba_mk, hipFuncAttributeMaxDynamicSharedMemorySize, LDS_BYTES) != hipSuccess) { fprintf(stderr, "kernel_launch: hipFuncSetAttribute failed\n"); grid = -1; return; }
        if (hipOccupancyMaxActiveBlocksPerMultiprocessor(&per_cu, (const void*)hymba_mk, 512, LDS_BYTES) != hipSuccess || per_cu < 1) { fprintf(stderr, "kernel_launch: occupancy query gave %d\n", per_cu); per_cu = 1; }
        (void)hipGetLastError();
        grid = cus * per_cu;
    }
    if (grid < 0) return;
    Params p{};
    for (int i = 0; i < 21; ++i) p.in[i] = (const float*)d_in[i];
    p.out = (float*)d_out; p.ws = (unsigned char*)d_ws;
#if MK_ONE_LAUNCH
    p.ph_lo = 0; p.ph_hi = N_PHASES;
    (void)hipMemsetAsync((unsigned char*)d_ws + WS_BAR, 0, SZ_BAR, stream);
    void* args[] = {&p};
    hipError_t e = hipLaunchCooperativeKernel((const void*)hymba_mk, dim3(grid), dim3(512), args, LDS_BYTES, stream);
    if (e != hipSuccess) fprintf(stderr, "cooperative launch failed: %s (grid %d)\n", hipGetErrorString(e), grid);
#else
    for (int ph = 0; ph < N_PHASES; ++ph) { p.ph_lo = ph; p.ph_hi = ph + 1; hipLaunchKernelGGL(hymba_mk, dim3(grid), dim3(512), LDS_BYTES, stream, p); }
#endif
}
```

```cpp
#include <hip/hip_runtime.h>
#include <hip/hip_cooperative_groups.h>
#include <cstdio>
#include <cstdint>
#include <cmath>
namespace cg = cooperative_groups;
namespace pg8 {
#define PG8_LAS __attribute__((address_space(3)))
typedef unsigned short bf16_t;
typedef short bf16x8 __attribute__((ext_vector_type(8)));
typedef float f32x4 __attribute__((ext_vector_type(4)));
typedef unsigned u32x4 __attribute__((ext_vector_type(4)));
constexpr int BM = 256, BK = 64, HALF = 128, HTB = HALF * BK * 2  , STAGE_BYTES = 8 * HTB, NXCD = 8, WGM = 8;

__host__ __device__ __forceinline__ int lds_byte(int r, int c) { const int st = (r >> 4) * 2 + (c >> 5), rr = r & 15, cc = c & 31, ob = rr * 64 + cc * 2; return st * 1024 + (ob ^ (((ob >> 9) & 1) << 5)); }
__host__ __device__ __forceinline__ void stage_rc(int b, int& R, int& C) { const int st = b / 1024, sb = b % 1024, swz = sb ^ (((sb >> 9) & 1) << 5); R = (st >> 1) * 16 + swz / 64; C = (st & 1) * 32 + (swz % 64) / 2; }
__host__ __device__ __forceinline__ int perm32(int rho) { const int n = rho >> 4, i = rho & 15; return 8 * (i >> 2) + 4 * n + (i & 3); }

struct Unit { int pm, pn; };
struct Gemm { const bf16_t* A; const bf16_t* Bt; int M, N, K; };

struct StaticOrder {
    int nM, nN, nwg, G, c;
    __host__ __device__ void init(int M, int N, int G_, int c_) { nM = M / BM; nN = N / BM; nwg = nM * nN; G = G_; c = c_; }
    __host__ __device__ bool next(int i, Unit& u) const {
        const long L = (long)i * G + c; if (L >= nwg) return false;
        int wgid = (int)L; { const int q = nwg / NXCD, r = nwg % NXCD, xcd = wgid % NXCD, off = wgid / NXCD; wgid = (xcd < r ? xcd * (q + 1) : r * (q + 1) + (xcd - r) * q) + off; }
        const int nig = WGM * nN, gid = wgid / nig, fm = gid * WGM, gsz = (nM - fm) < WGM ? (nM - fm) : WGM;
        u.pm = fm + ((wgid % nig) % gsz); u.pn = (wgid % nig) / gsz; return true;
    }
    __device__ __forceinline__ void a_ready(const Unit&) const {}
    __device__ __forceinline__ void done(const Unit&) const {}
};
__device__ __forceinline__ unsigned cvt_pk_bf16(float lo, float hi) { unsigned r; asm volatile("v_cvt_pk_bf16_f32 %0, %1, %2" : "=v"(r) : "v"(lo), "v"(hi)); return r; }
typedef float f32x2 __attribute__((ext_vector_type(2)));
template <class Epi, class Sched, bool ALIGN_EPI = false, bool SP2 = false>
__device__ __forceinline__ void gemm_phase(PG8_LAS unsigned char* lds, const Gemm g, const Sched& S, const Epi& E, const int tid) {
    const int wid = __builtin_amdgcn_readfirstlane(tid >> 6), lane = tid & 63, wr = wid >> 2, wc = wid & 3, fr = lane & 15, fq = lane >> 4;
    const int K = g.K, nt = K / BK;
    unsigned voffA[2], voffB[2];
#pragma unroll
    for (int i = 0; i < 2; ++i) { int R, C; stage_rc(tid * 16 + i * 8192, R, C); const int Rb = Epi::PERM ? ((R & ~31) + perm32(R & 31)) : R;
        voffA[i] = (unsigned)(R * K + C) * 2u; voffB[i] = (unsigned)(Rb * K + C) * 2u; }
    const size_t kstep = (size_t)(BK * 2);
    const size_t hstep = (size_t)HALF * K * 2;
    const size_t tstep = 2 * hstep;
    const unsigned ldsw = (unsigned)wid * 1024u;
    const int aoff = lds_byte(wr * 64 + fr, fq * 8), boff = lds_byte(wc * 32 + fr, fq * 8);
#define PG8_SA(b, h) (((b) * 2 + (h)) * HTB)
#define PG8_SB(b, h) ((4 + (b) * 2 + (h)) * HTB)
#define PG8_STAGE(bufoff, gbase, voff) do { _Pragma("unroll") for (int _i = 0; _i < 2; ++_i) \
        __builtin_amdgcn_global_load_lds((const unsigned*)((const char*)(gbase) + (voff)[_i]), (PG8_LAS unsigned*)(lds + (bufoff) + ldsw + _i * 8192), 16, 0, 0); } while (0)
#define PG8_LDA(dst, b, h) do { _Pragma("unroll") for (int m = 0; m < 4; ++m) _Pragma("unroll") for (int k = 0; k < 2; ++k) dst[m][k] = *(const PG8_LAS bf16x8*)(lds + PG8_SA(b, h) + aoff + m * 2048 + k * 1024); } while (0)
#define PG8_LDB(dst, b, h) do { _Pragma("unroll") for (int n = 0; n < 2; ++n) _Pragma("unroll") for (int k = 0; k < 2; ++k) dst[n][k] = *(const PG8_LAS bf16x8*)(lds + PG8_SB(b, h) + boff + n * 2048 + k * 1024); } while (0)
#define PG8_MMA(ai, bj, At, Bt) do { __builtin_amdgcn_s_setprio(1); _Pragma("unroll") for (int m = 0; m < 4; ++m) _Pragma("unroll") for (int n = 0; n < 2; ++n) _Pragma("unroll") for (int k = 0; k < 2; ++k) \
        acc[ai][bj][m][n] = __builtin_amdgcn_mfma_f32_16x16x32_bf16(Bt[n][k], At[m][k], acc[ai][bj][m][n], 0, 0, 0); __builtin_amdgcn_s_setprio(0); } while (0)
#define PG8_WAIT_V(n) asm volatile("s_waitcnt vmcnt(" #n ")" ::: "memory")
#define PG8_WAIT_L(n) asm volatile("s_waitcnt lgkmcnt(" #n ")" ::: "memory")
#define PG8_BAR __builtin_amdgcn_s_barrier()
#define PG8_SCHED __builtin_amdgcn_sched_barrier(0)
    Unit cur, nxt; int ui = 0;
    if (!S.next(0, cur)) return;
    f32x4 acc[2][2][4][2];
#pragma unroll
    for (int a = 0; a < 2; ++a)
#pragma unroll
        for (int b = 0; b < 2; ++b)
#pragma unroll
            for (int m = 0; m < 4; ++m)
#pragma unroll
                for (int n = 0; n < 2; ++n) acc[a][b][m][n] = (f32x4){0.f, 0.f, 0.f, 0.f};
    bf16x8 At[4][2], B0[2][2], B1[2][2];
    const char* cA = (const char*)g.A + (size_t)cur.pm * tstep; const char* cB = (const char*)g.Bt + (size_t)cur.pn * tstep;
    S.a_ready(cur);
    if constexpr (SP2) {
        PG8_STAGE(PG8_SB(0, 0), cB, voffB); PG8_STAGE(PG8_SB(0, 1), cB + hstep, voffB); PG8_STAGE(PG8_SA(0, 0), cA, voffA); PG8_STAGE(PG8_SA(0, 1), cA + hstep, voffA);
        if (wr == 1) PG8_BAR;
        PG8_WAIT_V(2); PG8_BAR;
        PG8_STAGE(PG8_SB(1, 0), cB + kstep, voffB); PG8_STAGE(PG8_SA(1, 0), cA + kstep, voffA); PG8_STAGE(PG8_SB(1, 1), cB + hstep + kstep, voffB);
        PG8_WAIT_V(6); PG8_BAR;
    } else {
        PG8_STAGE(PG8_SB(0, 0), cB, voffB); PG8_STAGE(PG8_SA(0, 0), cA, voffA); PG8_STAGE(PG8_SB(0, 1), cB + hstep, voffB); PG8_STAGE(PG8_SA(0, 1), cA + hstep, voffA);
        if (wr == 1) PG8_BAR;
        PG8_WAIT_V(4); PG8_BAR;
        PG8_STAGE(PG8_SB(1, 0), cB + kstep, voffB); PG8_STAGE(PG8_SA(1, 0), cA + kstep, voffA); PG8_STAGE(PG8_SB(1, 1), cB + hstep + kstep, voffB);
        PG8_WAIT_V(6); PG8_BAR;
    }
    for (;;) {
        const bool has_next = S.next(ui + 1, nxt);
        const char* nA = has_next ? (const char*)g.A + (size_t)nxt.pm * tstep : cA; const char* nB = has_next ? (const char*)g.Bt + (size_t)nxt.pn * tstep : cB;
        for (int t = 0; t < nt; t += 2) {
            const bool last = (t == nt - 2);
            const char* a1 = cA + (size_t)(t + 1) * kstep;
            const char* a2 = last ? nA : cA + (size_t)(t + 2) * kstep; const char* b2 = last ? nB : cB + (size_t)(t + 2) * kstep;
            const char* a3 = a2 + kstep; const char* b3 = b2 + kstep;
            if (last && has_next) S.a_ready(nxt);
            if constexpr (Epi::KSCALE) E.kscale(acc, t, cur, wr, fr);
            if constexpr (SP2) {
            PG8_LDB(B0, 0, 0); PG8_LDB(B1, 0, 1); PG8_SCHED; PG8_LDA(At, 0, 0); PG8_STAGE(PG8_SA(1, 1), a1 + hstep, voffA);
            PG8_WAIT_V(8); PG8_WAIT_L(0); PG8_BAR; PG8_MMA(0, 0, At, B0); PG8_MMA(0, 1, At, B1); PG8_BAR; PG8_SCHED;
            PG8_LDA(At, 0, 1); PG8_STAGE(PG8_SB(0, 0), b2, voffB); PG8_STAGE(PG8_SB(0, 1), b2 + hstep, voffB); PG8_STAGE(PG8_SA(0, 0), a2, voffA);
            PG8_WAIT_V(8); PG8_WAIT_L(0); PG8_BAR; PG8_MMA(1, 0, At, B0); PG8_MMA(1, 1, At, B1); PG8_BAR; PG8_SCHED;
            PG8_LDB(B0, 1, 0); PG8_LDB(B1, 1, 1); PG8_SCHED; PG8_LDA(At, 1, 0); PG8_STAGE(PG8_SA(0, 1), a2 + hstep, voffA);
            PG8_WAIT_V(8); PG8_WAIT_L(0); PG8_BAR; PG8_MMA(0, 0, At, B0); PG8_MMA(0, 1, At, B1); PG8_BAR; PG8_SCHED;
            PG8_LDA(At, 1, 1); PG8_STAGE(PG8_SB(1, 0), b3, voffB); PG8_STAGE(PG8_SB(1, 1), b3 + hstep, voffB); PG8_STAGE(PG8_SA(1, 0), a3, voffA);
            PG8_WAIT_V(8); PG8_WAIT_L(0); PG8_BAR; PG8_MMA(1, 0, At, B0); PG8_MMA(1, 1, At, B1); PG8_BAR; PG8_SCHED;
            } else {
            PG8_LDB(B0, 0, 0); PG8_SCHED; PG8_LDA(At, 0, 0); PG8_STAGE(PG8_SA(1, 1), a1 + hstep, voffA);
            PG8_WAIT_L(8); PG8_BAR; PG8_WAIT_L(0); PG8_MMA(0, 0, At, B0); PG8_BAR; PG8_SCHED;
            PG8_LDB(B1, 0, 1); PG8_STAGE(PG8_SB(0, 0), b2, voffB);
            PG8_BAR; PG8_WAIT_L(0); PG8_MMA(0, 1, At, B1); PG8_BAR;
            PG8_LDA(At, 0, 1); PG8_STAGE(PG8_SA(0, 0), a2, voffA);
            PG8_BAR; PG8_WAIT_L(0); PG8_MMA(1, 0, At, B0); PG8_BAR; PG8_SCHED;
            PG8_STAGE(PG8_SB(0, 1), b2 + hstep, voffB);
            PG8_WAIT_V(6); PG8_BAR; PG8_MMA(1, 1, At, B1); PG8_BAR;
            PG8_LDB(B0, 1, 0); PG8_SCHED; PG8_LDA(At, 1, 0); PG8_STAGE(PG8_SA(0, 1), a2 + hstep, voffA);
            PG8_WAIT_L(8); PG8_BAR; PG8_WAIT_L(0); PG8_MMA(0, 0, At, B0); PG8_BAR; PG8_SCHED;
            PG8_LDB(B1, 1, 1); PG8_STAGE(PG8_SB(1, 0), b3, voffB);
            PG8_BAR; PG8_WAIT_L(0); PG8_MMA(0, 1, At, B1); PG8_BAR;
            PG8_LDA(At, 1, 1); PG8_STAGE(PG8_SA(1, 0), a3, voffA);
            PG8_BAR; PG8_WAIT_L(0); PG8_MMA(1, 0, At, B0); PG8_BAR; PG8_SCHED;
            PG8_STAGE(PG8_SB(1, 1), b3 + hstep, voffB);
            PG8_WAIT_V(6); PG8_BAR; PG8_MMA(1, 1, At, B1); PG8_BAR;
            }
        }
        if constexpr (ALIGN_EPI) { if (wr == 0) PG8_BAR; }
        if constexpr (!Epi::AFTER_DRAIN) { E(acc, cur, wr, wc, fr, fq); S.done(cur); }
        if (!has_next) break;
#pragma unroll
        for (int a = 0; a < 2; ++a)
#pragma unroll
            for (int b = 0; b < 2; ++b)
#pragma unroll
                for (int m = 0; m < 4; ++m)
#pragma unroll
                    for (int n = 0; n < 2; ++n) acc[a][b][m][n] = (f32x4){0.f, 0.f, 0.f, 0.f};
        cur = nxt; cA = nA; cB = nB; ++ui;
        if constexpr (ALIGN_EPI) { if (wr == 1) PG8_BAR; }
    }
    PG8_WAIT_V(0);
    if constexpr (!ALIGN_EPI) { if (wr == 0) PG8_BAR; }
    PG8_BAR;
    if constexpr (Epi::AFTER_DRAIN) { E.fused(acc, cur, wr, wc, fr, fq, lds, wid, lane); S.done(cur); }
#undef PG8_SA
#undef PG8_SB
#undef PG8_STAGE
#undef PG8_LDA
#undef PG8_LDB
#undef PG8_MMA
#undef PG8_WAIT_V
#undef PG8_WAIT_L
#undef PG8_BAR
#undef PG8_SCHED
}
}
#define LAS __attribute__((address_space(3)))
typedef unsigned short u16;
typedef short bf16x8 __attribute__((ext_vector_type(8)));
typedef float f32x4 __attribute__((ext_vector_type(4)));
typedef unsigned u32x4 __attribute__((ext_vector_type(4)));
typedef unsigned u32x2 __attribute__((ext_vector_type(2)));
typedef LAS unsigned char* ldsp;

constexpr int DM = 1024, NL = 2;
constexpr int MP = 4 * 8192, MS = 128 * 4, M = MP + MS;
constexpr int NPROJ = 3328, NIN = 3344, NMIX = 1536, DFF = 2816, NGU = 5632;
constexpr int C_K = 512, C_V = 640, C_Z = 768, C_X = 1792, C_B = 2816, C_C = 3072;
constexpr float EPS = 1e-6f;
constexpr int NPOS = 8196;

constexpr size_t WS_WIN = 0;
constexpr size_t SZ_WIN = (size_t)NIN * DM * 2;
constexpr size_t WS_WOUT = WS_WIN + NL * SZ_WIN;
constexpr size_t SZ_WOUT = (size_t)DM * NMIX * 2;
constexpr size_t WS_WGU = WS_WOUT + NL * SZ_WOUT;
constexpr size_t SZ_WGU = (size_t)NGU * DM * 2;
constexpr size_t WS_WDN = WS_WGU + NL * SZ_WGU;
constexpr size_t SZ_WDN = (size_t)DM * DFF * 2;
constexpr size_t WS_ROPE = WS_WDN + NL * SZ_WDN;
constexpr size_t SZ_ROPE = (size_t)NPOS * 32 * 4;
constexpr size_t WS_XB = WS_ROPE + 2 * SZ_ROPE;
constexpr size_t WS_SSP = WS_XB + (size_t)M * DM * 2;
constexpr size_t WS_PROJ = WS_SSP + (size_t)M * 16 * 4;
constexpr size_t WS_YMIX = WS_PROJ + (size_t)M * NPROJ * 2;
constexpr size_t WS_DT = WS_YMIX + (size_t)M * NMIX * 2;
constexpr size_t WS_CD = WS_DT + (size_t)MP * 16 * 4;
constexpr size_t WS_ST = WS_CD + (size_t)4 * 64 * 16 * 4;
constexpr size_t WS_END = WS_ST + (size_t)4 * 64 * 16 * 64 * 128 * 2;
constexpr size_t WS_RS = WS_END;
constexpr size_t WS_BAR = WS_RS + (size_t)MP * 2 * 4, SZ_BAR = 16384;
static_assert(WS_BAR + SZ_BAR <= (size_t)4 * MP * DM * 4 && WS_BAR % 256 == 0, "workspace");
static_assert(WS_XB % 256 == 0 && WS_SSP % 256 == 0 && WS_PROJ % 256 == 0 && WS_YMIX % 256 == 0 && WS_DT % 256 == 0 && WS_ST % 256 == 0 && WS_ROPE % 256 == 0, "align");

constexpr size_t O_Y = 0;
constexpr size_t O_KP = (size_t)M * DM;
constexpr size_t O_VP = O_KP + (size_t)2 * 4 * 128 * 128;
constexpr size_t O_CP = O_VP + (size_t)2 * 4 * 128 * 128;
constexpr size_t O_HP = O_CP + (size_t)2 * 4 * 3 * 1536;
constexpr size_t O_KS = O_HP + (size_t)2 * 4 * 16 * 64 * 128;
constexpr size_t O_VS = O_KS + (size_t)2 * 128 * 128 * 128;
constexpr size_t O_CS = O_VS + (size_t)2 * 128 * 128 * 128;
constexpr size_t O_HS = O_CS + (size_t)2 * 128 * 3 * 1536;
constexpr size_t O_END = O_HS + (size_t)2 * 128 * 16 * 64 * 128;

constexpr int LDS_BYTES = 147456;

enum { I_XP = 0, I_XS, I_CK, I_CV, I_SCONV, I_SSSM, I_NMIX, I_WIN, I_QN, I_KN, I_SINK, I_CW, I_CB, I_DTB, I_ALOG, I_DSK, I_SNORM, I_WOUT, I_NFFN, I_WGU, I_WDN };

struct Params { const float* in[21]; float* out; unsigned char* ws; int ph_lo, ph_hi; };

typedef float f32x2_t __attribute__((ext_vector_type(2))); typedef __bf16 bf16x2_t __attribute__((ext_vector_type(2)));
__device__ __forceinline__ unsigned pk2(float lo, float hi) { f32x2_t v = {lo, hi}; bf16x2_t b = __builtin_convertvector(v, bf16x2_t); return __builtin_bit_cast(unsigned, b); }
__device__ __forceinline__ unsigned f2bf(float f) { return pk2(f, 0.f) & 0xffffu; }
__device__ __forceinline__ float bf2f(unsigned h) { return __builtin_bit_cast(float, h << 16); }
__device__ __forceinline__ float bflo(unsigned w) { return __builtin_bit_cast(float, w << 16); }
__device__ __forceinline__ float bfhi(unsigned w) { return __builtin_bit_cast(float, w & 0xffff0000u); }
__device__ __forceinline__ float silu_f(float x) { return x * __builtin_amdgcn_rcpf(1.f + __expf(-x)); }
__device__ __forceinline__ float softplus_f(float x) { return x > 15.f ? x : log1pf(__expf(x)); }
__device__ __forceinline__ float wave_sum(float v) {
#pragma unroll
    for (int o = 1; o < 64; o <<= 1) v += __shfl_xor(v, o);
    return v;
}
__device__ __forceinline__ float wave_max(float v) {
#pragma unroll
    for (int o = 1; o < 64; o <<= 1) v = fmaxf(v, __shfl_xor(v, o));
    return v;
}
__device__ __forceinline__ float wave_incl_scan(float v, int lane) {
#pragma unroll
    for (int off = 1; off < 64; off <<= 1) { const float t = __shfl_up(v, off); if (lane >= off) v += t; }
    return v;
}
__device__ __forceinline__ bf16x8 mk8(u32x2 lo, u32x2 hi) { u32x4 w; w.x = lo.x; w.y = lo.y; w.z = hi.x; w.w = hi.y; return __builtin_bit_cast(bf16x8, w); }
__device__ __forceinline__ bf16x8 lds16(ldsp p) { return __builtin_bit_cast(bf16x8, *(LAS u32x4*)p); }
__device__ __forceinline__ bf16x8 lds8x2(ldsp p0, ldsp p1) { return mk8(*(LAS u32x2*)p0, *(LAS u32x2*)p1); }
__device__ __forceinline__ f32x4 mfma16(bf16x8 a, bf16x8 b, f32x4 c) { return __builtin_amdgcn_mfma_f32_16x16x32_bf16(a, b, c, 0, 0, 0); }
#define LDS_WAIT() asm volatile("s_waitcnt lgkmcnt(0)" ::: "memory")

__device__ __forceinline__ float rstd_row(const float* ssp, int row) {
    const f32x4* p = (const f32x4*)(ssp + (size_t)row * 16);
    const f32x4 a = p[0], b = p[1], c = p[2], d = p[3];
    const float s = (((a.x + a.y) + (a.z + a.w)) + ((b.x + b.y) + (b.z + b.w))) + (((c.x + c.y) + (c.z + c.w)) + ((d.x + d.y) + (d.z + d.w)));
    return rsqrtf(s * (1.f / 1024.f) + EPS);
}

struct EpiProj {
    static constexpr bool PERM = true, AFTER_DRAIN = false, KSCALE = false;
    u16* O; const float* ssp; ldsp rsl;
    __device__ __forceinline__ void operator()(const pg8::f32x4 (&acc)[2][2][4][2], const pg8::Unit& u, int wr, int wc, int fr, int fq) const {
        const int row0 = u.pm * 256 + wr * 64 + fr, col0 = u.pn * 256 + wc * 32 + 8 * fq;
        { const int t = wc * 64 + fq * 16 + fr; if (wr == 0) ((LAS float*)rsl)[t] = rstd_row(ssp, u.pm * 256 + t);
          asm volatile("s_waitcnt lgkmcnt(0)" ::: "memory"); __builtin_amdgcn_s_barrier(); asm volatile("" ::: "memory"); }
#pragma unroll
        for (int ai = 0; ai < 2; ++ai)
#pragma unroll
            for (int m = 0; m < 4; ++m) {
                const int row = row0 + ai * 128 + m * 16; const float rs = ((LAS float*)rsl)[wr * 64 + fr + ai * 128 + m * 16]; u16* rowp = O + (size_t)row * NPROJ + col0;
#pragma unroll
                for (int bj = 0; bj < 2; ++bj) {
                    const f32x4 v0 = acc[ai][bj][m][0] * rs, v1 = acc[ai][bj][m][1] * rs; u32x4 w;
                    w.x = pg8::cvt_pk_bf16(v0[0], v0[1]); w.y = pg8::cvt_pk_bf16(v0[2], v0[3]); w.z = pg8::cvt_pk_bf16(v1[0], v1[1]); w.w = pg8::cvt_pk_bf16(v1[2], v1[3]);
                    *(u32x4*)(rowp + bj * 128) = w; }
            }
    }
};
struct EpiSwiglu {
    static constexpr bool PERM = true, AFTER_DRAIN = false, KSCALE = false;
    u16* O; const float* ssp; ldsp rsl;
    __device__ __forceinline__ void operator()(const pg8::f32x4 (&acc)[2][2][4][2], const pg8::Unit& u, int wr, int wc, int fr, int fq) const {
        const int row0 = u.pm * 256 + wr * 64 + fr, col0 = u.pn * 128 + wc * 32 + 8 * fq;
        { const int t = wc * 64 + fq * 16 + fr; if (wr == 0) ((LAS float*)rsl)[t] = rstd_row(ssp, u.pm * 256 + t);
          asm volatile("s_waitcnt lgkmcnt(0)" ::: "memory"); __builtin_amdgcn_s_barrier(); asm volatile("" ::: "memory"); }
#pragma unroll
        for (int ai = 0; ai < 2; ++ai)
#pragma unroll
            for (int m = 0; m < 4; ++m) {
                const int row = row0 + ai * 128 + m * 16; const float rs = ((LAS float*)rsl)[wr * 64 + fr + ai * 128 + m * 16];
                float h[8];
#pragma unroll
                for (int n = 0; n < 2; ++n)
#pragma unroll
                    for (int j = 0; j < 4; ++j) { const float g = acc[ai][0][m][n][j] * rs, up = acc[ai][1][m][n][j] * rs; h[n * 4 + j] = silu_f(g) * up; }
                u32x4 w; w.x = pg8::cvt_pk_bf16(h[0], h[1]); w.y = pg8::cvt_pk_bf16(h[2], h[3]); w.z = pg8::cvt_pk_bf16(h[4], h[5]); w.w = pg8::cvt_pk_bf16(h[6], h[7]);
                *(u32x4*)(O + (size_t)row * DFF + col0) = w;
            }
    }
};
template <bool KS> struct EpiResT {
    static constexpr bool PERM = false, AFTER_DRAIN = false, KSCALE = KS;
    u16* xb; float* outf; float* ssp; const float* rs;
    __device__ __forceinline__ void kscale(pg8::f32x4 (&acc)[2][2][4][2], int t, const pg8::Unit& u, int wr, int fr) const {
        if (t != 8 && t != 16) return;
#pragma unroll
        for (int ai = 0; ai < 2; ++ai)
#pragma unroll
            for (int m = 0; m < 4; ++m) {
                const int row = u.pm * 256 + wr * 64 + fr + ai * 128 + m * 16; const float s0 = rs[2 * row], s1 = rs[2 * row + 1];
                const float f = t == 8 ? s0 * __builtin_amdgcn_rcpf(s1) : s1;
#pragma unroll
                for (int bj = 0; bj < 2; ++bj)
#pragma unroll
                    for (int n = 0; n < 2; ++n) acc[ai][bj][m][n] = acc[ai][bj][m][n] * f;
            }
    }
    __device__ __forceinline__ void operator()(const pg8::f32x4 (&acc)[2][2][4][2], const pg8::Unit& u, int wr, int wc, int fr, int fq) const {
        const int row0 = u.pm * 256 + wr * 64 + fr, col0 = u.pn * 256 + wc * 32 + 4 * fq;
#pragma unroll
        for (int ai = 0; ai < 2; ++ai) {
            u32x2 rw[4][2][2];
#pragma unroll
            for (int m = 0; m < 4; ++m)
#pragma unroll
                for (int bj = 0; bj < 2; ++bj)
#pragma unroll
                    for (int n = 0; n < 2; ++n) rw[m][bj][n] = *(const u32x2*)(xb + (size_t)(row0 + ai * 128 + m * 16) * DM + col0 + bj * 128 + n * 16);
#pragma unroll
            for (int m = 0; m < 4; ++m) {
                const int row = row0 + ai * 128 + m * 16;
                u16* xp = xb + (size_t)row * DM + col0; float ss = 0.f;
#pragma unroll
                for (int bj = 0; bj < 2; ++bj)
#pragma unroll
                    for (int n = 0; n < 2; ++n) {
                        const u32x2 w0 = rw[m][bj][n]; const f32x4 r = {bflo(w0.x), bfhi(w0.x), bflo(w0.y), bfhi(w0.y)}; const f32x4 v = acc[ai][bj][m][n] + r;
                        if (outf) *(f32x4*)(outf + (size_t)row * DM + col0 + bj * 128 + n * 16) = v;
                        u32x2 w; w.x = pg8::cvt_pk_bf16(v[0], v[1]); w.y = pg8::cvt_pk_bf16(v[2], v[3]);
                        *(u32x2*)(xp + bj * 128 + n * 16) = w; ss += (v[0] * v[0] + v[1] * v[1]) + (v[2] * v[2] + v[3] * v[3]); }
                ss += __shfl_xor(ss, 16); ss += __shfl_xor(ss, 32);
                if (fq == 0) ssp[(size_t)row * 16 + u.pn * 4 + wc] = ss;
            }
        }
    }
};
struct Ctx {
    const float* in[21]; float* out; unsigned char* ws;
    u16 *WinT, *WoutT, *WguT, *WdnT; float *COS, *SIN; u16* XB; float* SSP; u16* PROJ; u16* YMIX; float* DT; float* CD; u16* ST; float* RS;
};

__device__ __forceinline__ void tr_item(const float* __restrict__ W, int K, int N, const float* __restrict__ gk, u16* WT, int perm, LAS float* scr, int item, int lane) {
    const int nblk = (N + 31) >> 5, kb = item / nblk, nb = item - kb * nblk, k0 = 64 * kb, n0 = 32 * nb;
    const int kd0 = perm == 2 ? (k0 < 512 ? k0 + 1024 : k0 - 512) : k0;
    const int nn = n0 + (lane & 31);
    float wv[32];
#pragma unroll
    for (int i = 0; i < 32; ++i) { const int kk = 2 * i + (lane >> 5); wv[i] = (nn < N) ? W[(size_t)(k0 + kk) * N + nn] : 0.f; }
#pragma unroll
    for (int i = 0; i < 32; ++i) { const int kk = 2 * i + (lane >> 5); float v = wv[i]; if (gk) { if (perm == 2) { if (k0 >= 512) v *= gk[k0 + kk - 512]; } else v *= gk[k0 + kk]; } scr[kk * 33 + (lane & 31)] = v; }
    LDS_WAIT(); asm volatile("" ::: "memory");
    const int c = lane & 7;
#pragma unroll
    for (int j = 0; j < 4; ++j) {
        const int nl = (lane >> 3) + 8 * j, n = n0 + nl;
        if (n < N) {
            int dr = n; if (perm == 1) { const int up = n >= DFF, f = up ? n - DFF : n; dr = (f >> 7) * 256 + up * 128 + (f & 127); }
            const LAS float* s = scr + (8 * c) * 33 + nl;
            u32x4 o; o.x = pk2(s[0 * 33], s[1 * 33]); o.y = pk2(s[2 * 33], s[3 * 33]); o.z = pk2(s[4 * 33], s[5 * 33]); o.w = pk2(s[6 * 33], s[7 * 33]);
            *(u32x4*)(WT + (size_t)dr * K + kd0 + 8 * c) = o; }
    }
    LDS_WAIT(); asm volatile("" ::: "memory");
}
constexpr int I_IN = (DM / 64) * ((NIN + 31) / 32), I_OUT = (NMIX / 64) * (DM / 32), I_GU = (DM / 64) * (NGU / 32), I_DN = (DFF / 64) * (DM / 32), I_L = I_IN + I_OUT + I_GU + I_DN;
__device__ __forceinline__ void tr_layer_item(const Ctx& X, int l, int r, LAS float* scr, int lane) {
    if (r < I_IN) { tr_item(X.in[I_WIN] + (size_t)l * DM * NIN, DM, NIN, X.in[I_NMIX] + l * DM, X.WinT + (size_t)l * NIN * DM, 0, scr, r, lane); return; } r -= I_IN;
    if (r < I_OUT) { tr_item(X.in[I_WOUT] + (size_t)l * NMIX * DM, NMIX, DM, X.in[I_SNORM] + l * 1024, X.WoutT + (size_t)l * DM * NMIX, 2, scr, r, lane); return; } r -= I_OUT;
    if (r < I_GU) { tr_item(X.in[I_WGU] + (size_t)l * DM * NGU, DM, NGU, X.in[I_NFFN] + l * DM, X.WguT + (size_t)l * NGU * DM, 1, scr, r, lane); return; } r -= I_GU;
    tr_item(X.in[I_WDN] + (size_t)l * DFF * DM, DFF, DM, nullptr, X.WdnT + (size_t)l * DM * DFF, 0, scr, r, lane);
}
__device__ __forceinline__ void idle_weight_items(const Ctx& X, ldsp L, int stage, int nwg, int G, int bx, int wid, int lane) {
    const int nround = (nwg + G - 1) / G, first_idle = nwg - (nround - 1) * G;
    LAS float* scr = (LAS float*)(L + wid * 16384);
    int nw = (G - first_idle) * 8, wi = (bx - first_idle) * 8 + wid;
    if (first_idle >= G) { nw = G * 8; wi = bx * 8 + wid; }
    else if (bx < first_idle) return;
    if (stage == 0) { for (int r = I_IN + wi; r < I_IN + I_OUT + I_GU; r += nw) tr_layer_item(X, 0, r, scr, lane); }
    else { for (int r = I_IN + I_OUT + I_GU + wi; r < 2 * I_L; r += nw) { if (r < I_L) tr_layer_item(X, 0, r, scr, lane); else tr_layer_item(X, 1, r - I_L, scr, lane); } }
}
__device__ __forceinline__ void phase_prologue(const Ctx& X, ldsp L, int tid, int wid, int lane) {
    LAS float* scr = (LAS float*)(L + wid * 16384);
    const int gw = blockIdx.x * 8 + wid, NGW = gridDim.x * 8;
    for (int it = gw; it < I_IN; it += NGW) tr_layer_item(X, 0, it, scr, lane);
    for (int rb = gw * 4; rb < M; rb += NGW * 4) {
        f32x4 v[4][4];
#pragma unroll
        for (int rr = 0; rr < 4; ++rr) { const int row = rb + rr; const float* xr = row < MP ? X.in[I_XP] + (size_t)row * DM : X.in[I_XS] + (size_t)(row - MP) * DM;
#pragma unroll
            for (int j = 0; j < 4; ++j) v[rr][j] = ((const f32x4*)xr)[lane + 64 * j]; }
#pragma unroll
        for (int rr = 0; rr < 4; ++rr) { const int row = rb + rr; float ss = 0.f;
#pragma unroll
            for (int j = 0; j < 4; ++j) { const f32x4 w4 = v[rr][j]; ss += (w4.x * w4.x + w4.y * w4.y) + (w4.z * w4.z + w4.w * w4.w);
                u32x2 w; w.x = pk2(w4.x, w4.y); w.y = pk2(w4.z, w4.w); ((u32x2*)(X.XB + (size_t)row * DM))[lane + 64 * j] = w; }
            ss = wave_sum(ss);
            if (lane < 16) X.SSP[(size_t)row * 16 + lane] = lane == 0 ? ss : 0.f; }
    }
    for (int idx = blockIdx.x * 512 + tid; idx < NPOS * 32; idx += gridDim.x * 512) {
        const int pi = idx >> 5, j = idx & 31; const float pos = pi < 8192 ? (float)pi : (float)(16384 + pi - 8192);
        const float inv = powf(10000.f, -(float)j * (1.f / 32.f));
        float sv, cv; sincosf(pos * inv, &sv, &cv); X.COS[idx] = cv; X.SIN[idx] = sv;
    }
}

struct ConvCol { float w0, w1, w2, w3, bias, a, b, c; const u16* p; };
__device__ __forceinline__ void conv_init(ConvCol& cc, const u16* proj, int row, bool havePrev, int xcol, const float* cw, const float* cb) {
    cc.w0 = cw[xcol]; cc.w1 = cw[1536 + xcol]; cc.w2 = cw[2 * 1536 + xcol]; cc.w3 = cw[3 * 1536 + xcol]; cc.bias = cb[xcol];
    cc.p = proj + (size_t)row * NPROJ + C_X + xcol;
    cc.a = havePrev ? bf2f(cc.p[-3 * NPROJ]) : 0.f; cc.b = havePrev ? bf2f(cc.p[-2 * NPROJ]) : 0.f; cc.c = havePrev ? bf2f(cc.p[-1 * NPROJ]) : 0.f;
}
__device__ __forceinline__ float conv_step(ConvCol& cc) {
    const float d = bf2f(*cc.p); cc.p += NPROJ;
    const float v = fmaf(cc.a, cc.w0, fmaf(cc.b, cc.w1, fmaf(cc.c, cc.w2, fmaf(d, cc.w3, cc.bias))));
    cc.a = cc.b; cc.b = cc.c; cc.c = d; return silu_f(v);
}

struct ConvW { float w0, w1, w2, w3, bias; };
__device__ __forceinline__ ConvW conv_w(const float* cw, const float* cb, int xcol) { ConvW w; w.w0 = cw[xcol]; w.w1 = cw[1536 + xcol]; w.w2 = cw[2 * 1536 + xcol]; w.w3 = cw[3 * 1536 + xcol]; w.bias = cb[xcol]; return w; }
template <int NS> __device__ __forceinline__ void conv_load(float (&raw)[NS + 3], const u16* proj, int row, bool havePrev, int xcol) {
    const u16* p = proj + (size_t)row * NPROJ + C_X + xcol;
#pragma unroll
    for (int k = 0; k < NS + 3; ++k) { unsigned v = 0u; if (k >= 3 || havePrev) v = p[(k - 3) * NPROJ]; raw[k] = bf2f(v); }
}
__device__ __forceinline__ float conv_tap(const ConvW& w, float a, float b, float c, float d) { return silu_f(fmaf(a, w.w0, fmaf(b, w.w1, fmaf(c, w.w2, fmaf(d, w.w3, w.bias))))); }

struct ConvW4 { f32x4 w0, w1, w2, w3, bias; };
__device__ __forceinline__ ConvW4 conv4_w(const float* cw, const float* cb, int xcol0) { ConvW4 w; w.w0 = *(const f32x4*)(cw + xcol0); w.w1 = *(const f32x4*)(cw + 1536 + xcol0); w.w2 = *(const f32x4*)(cw + 2 * 1536 + xcol0); w.w3 = *(const f32x4*)(cw + 3 * 1536 + xcol0); w.bias = *(const f32x4*)(cb + xcol0); return w; }
template <int NT> __device__ __forceinline__ void conv4_load(float (&raw)[NT + 3][4], const u16* proj, int row, bool havePrev, int xcol0) {
    const u16* p = proj + (size_t)row * NPROJ + C_X + xcol0;
#pragma unroll
    for (int k = 0; k < NT + 3; ++k) { u32x2 v = {0u, 0u}; if (k >= 3 || havePrev) v = *(const u32x2*)(p + (k - 3) * NPROJ); raw[k][0] = bflo(v.x); raw[k][1] = bfhi(v.x); raw[k][2] = bflo(v.y); raw[k][3] = bfhi(v.y); }
}
#define CONV4_TAP(w, raw, k, e) silu_f(fmaf(raw[(k)][e], w.w0[e], fmaf(raw[(k) + 1][e], w.w1[e], fmaf(raw[(k) + 2][e], w.w2[e], fmaf(raw[(k) + 3][e], w.w3[e], w.bias[e])))))
__device__ __forceinline__ void acum_scan(LAS float* DTL, LAS float* ACL, const float* alog, int wid, int lane) {
#pragma unroll
    for (int hh = 0; hh < 2; ++hh) {
        const int h = 2 * wid + hh; const float A = -expf(alog[h]);
        float v0 = DTL[h * 128 + lane] * A, v1 = DTL[h * 128 + 64 + lane] * A;
        v0 = wave_incl_scan(v0, lane); v1 = wave_incl_scan(v1, lane); v1 += __shfl(v0, 63);
        ACL[h * 128 + lane] = v0; ACL[h * 128 + 64 + lane] = v1;
    }
}

constexpr int XTP = 132;
__device__ __forceinline__ void ssd_states_unit(const Ctx& X, int l, int b, int c, ldsp L, int tid, int wid, int lane) {
    LAS float* DTL = (LAS float*)L; LAS float* ACL = (LAS float*)(L + 8192);
    LAS u16* BT = (LAS u16*)(L + 16384);
    LAS u16* XT = (LAS u16*)(L + 16384 + 33792);
    const int i = lane & 15, g = lane >> 4, r0 = b * 8192 + c * 128;
    const float* cw = X.in[I_CW] + (size_t)l * 4 * 1536; const float* cb = X.in[I_CB] + (size_t)l * 1536;
    {
        const u16* ap = X.XB + (size_t)(r0 + 16 * wid + i) * DM + 8 * g; const u16* bp = X.WinT + (size_t)l * NIN * DM + (size_t)(NPROJ + i) * DM + 8 * g;
        f32x4 acc = {0.f, 0.f, 0.f, 0.f};
#pragma unroll 16
        for (int kk = 0; kk < 32; ++kk) { const bf16x8 a = *(const bf16x8*)(ap + 32 * kk), w = *(const bf16x8*)(bp + 32 * kk); acc = mfma16(a, w, acc); }
        const float bias = X.in[I_DTB][l * 16 + i];
#pragma unroll
        for (int j = 0; j < 4; ++j) { const int tok = 16 * wid + 4 * g + j; const float dt = softplus_f(acc[j] * rstd_row(X.SSP, r0 + tok) + bias);
            DTL[i * 128 + tok] = dt; X.DT[(size_t)(r0 + tok) * 16 + i] = dt; }
    }
    __syncthreads();
    acum_scan(DTL, ACL, X.in[I_ALOG] + l * 16, wid, lane);
    __syncthreads();
    if (tid < 16) X.CD[(b * 64 + c) * 16 + tid] = __expf(ACL[tid * 128 + 127]);
    LAS float* WSL = (LAS float*)(L + 16384 + 33792 + 67584);
#pragma unroll
    for (int e = 0; e < 4; ++e) { const int idx = tid * 4 + e, h = idx >> 7; WSL[idx] = DTL[idx] * __expf(ACL[h * 128 + 127] - ACL[idx]); }
    __syncthreads();
    for (int hq = 0; hq < 4; ++hq) {
        const int grp = hq >> 1;
        if ((hq & 1) == 0) {
            const int cg = lane & 31, tok0 = 16 * wid + 8 * (lane >> 5), xcol0 = 1024 + 128 * grp + 4 * cg; const ConvW4 w = conv4_w(cw, cb, xcol0);
            float raw[11][4]; conv4_load<8>(raw, X.PROJ, r0 + tok0, !(c == 0 && tok0 == 0), xcol0);
#pragma unroll
            for (int e = 0; e < 4; ++e)
#pragma unroll
                for (int kq = 0; kq < 2; ++kq) { u32x2 pw; pw.x = pk2(CONV4_TAP(w, raw, 4 * kq, e), CONV4_TAP(w, raw, 4 * kq + 1, e)); pw.y = pk2(CONV4_TAP(w, raw, 4 * kq + 2, e), CONV4_TAP(w, raw, 4 * kq + 3, e));
                    *(LAS u32x2*)(BT + (4 * cg + e) * XTP + tok0 + 4 * kq) = pw; }
        }
        {
            const int cg = lane, tok0 = 16 * wid, xcol0 = 256 * hq + 4 * cg, h = 4 * hq + (cg >> 4); const ConvW4 w = conv4_w(cw, cb, xcol0);
            float raw[19][4]; conv4_load<16>(raw, X.PROJ, r0 + tok0, !(c == 0 && tok0 == 0), xcol0);
            float ws[16];
#pragma unroll
            for (int k4 = 0; k4 < 4; ++k4) { const f32x4 t4 = *(LAS f32x4*)(WSL + h * 128 + tok0 + 4 * k4); ws[4 * k4] = t4.x; ws[4 * k4 + 1] = t4.y; ws[4 * k4 + 2] = t4.z; ws[4 * k4 + 3] = t4.w; }
#pragma unroll
            for (int e = 0; e < 4; ++e)
#pragma unroll
                for (int kq = 0; kq < 4; ++kq) { u32x2 pw; pw.x = pk2(CONV4_TAP(w, raw, 4 * kq, e) * ws[4 * kq], CONV4_TAP(w, raw, 4 * kq + 1, e) * ws[4 * kq + 1]); pw.y = pk2(CONV4_TAP(w, raw, 4 * kq + 2, e) * ws[4 * kq + 2], CONV4_TAP(w, raw, 4 * kq + 3, e) * ws[4 * kq + 3]);
                    *(LAS u32x2*)(XT + (4 * cg + e) * XTP + tok0 + 4 * kq) = pw; }
        }
        __syncthreads();
        {
            const int hl = wid >> 1, ph = wid & 1, h = 4 * hq + hl;
            f32x4 acc[2][8];
#pragma unroll
            for (int pp = 0; pp < 2; ++pp)
#pragma unroll
                for (int nt = 0; nt < 8; ++nt) acc[pp][nt] = (f32x4){0.f, 0.f, 0.f, 0.f};
#pragma unroll 1
            for (int ks = 0; ks < 4; ++ks) {
                bf16x8 bfr[8], xfr[2];
#pragma unroll
                for (int nt = 0; nt < 8; ++nt) { ldsp p = (ldsp)(BT + (16 * nt + i) * XTP + 32 * ks + 8 * g); bfr[nt] = lds8x2(p, p + 8); }
#pragma unroll
                for (int pp = 0; pp < 2; ++pp) { ldsp p = (ldsp)(XT + (hl * 64 + 16 * (2 * ph + pp) + i) * XTP + 32 * ks + 8 * g); xfr[pp] = lds8x2(p, p + 8); }
#pragma unroll
                for (int pp = 0; pp < 2; ++pp)
#pragma unroll
                    for (int nt = 0; nt < 8; ++nt) acc[pp][nt] = mfma16(bfr[nt], xfr[pp], acc[pp][nt]);
            }
            u16* sb = X.ST + ((size_t)((b * 64 + c) * 16 + h)) * 8192;
#pragma unroll
            for (int pp = 0; pp < 2; ++pp)
#pragma unroll
                for (int nt = 0; nt < 8; ++nt) { const int p = 16 * (2 * ph + pp) + i, n = 16 * nt + 4 * g; u32x2 w; w.x = pk2(acc[pp][nt][0], acc[pp][nt][1]); w.y = pk2(acc[pp][nt][2], acc[pp][nt][3]);
                    *(u32x2*)(sb + p * 128 + n) = w; }
        }
        __syncthreads();
    }
}

__device__ __forceinline__ void ssd_sample_unit(const Ctx& X, int l, int b, int grp, ldsp L, int tid, int wid, int lane) {
    LAS float* XS = (LAS float*)L;
    LAS float* BS = (LAS float*)(L + 8192);
    LAS float* CS = (LAS float*)(L + 10240);
    LAS float* DTS = (LAS float*)(L + 12288);
    LAS float* YG = (LAS float*)(L + 12544);
    const float* cw = X.in[I_CW] + (size_t)l * 4 * 1536; const float* cb = X.in[I_CB] + (size_t)l * 1536;
    const int row0 = MP + b * 4;
    for (int ci = tid; ci < 768; ci += 512) {
        const int xcol = ci < 512 ? 512 * grp + ci : (ci < 640 ? 1024 + 128 * grp + (ci - 512) : 1280 + 128 * grp + (ci - 640));
        float xp[7];
#pragma unroll
        for (int j = 0; j < 3; ++j) xp[j] = X.in[I_SCONV][((size_t)(l * 128 + b) * 3 + j) * 1536 + xcol];
#pragma unroll
        for (int t = 0; t < 4; ++t) xp[3 + t] = bf2f(X.PROJ[(size_t)(row0 + t) * NPROJ + C_X + xcol]);
        const float w0 = cw[xcol], w1 = cw[1536 + xcol], w2 = cw[2 * 1536 + xcol], w3 = cw[3 * 1536 + xcol], bias = cb[xcol];
#pragma unroll
        for (int t = 0; t < 4; ++t) {
            const float v = silu_f(fmaf(xp[t], w0, fmaf(xp[t + 1], w1, fmaf(xp[t + 2], w2, fmaf(xp[t + 3], w3, bias)))));
            if (ci < 512) XS[t * 512 + ci] = v; else if (ci < 640) BS[t * 128 + ci - 512] = v; else CS[t * 128 + ci - 640] = v;
        }
#pragma unroll
        for (int j = 0; j < 3; ++j) X.out[O_CS + ((size_t)(l * 128 + b) * 3 + j) * 1536 + xcol] = xp[4 + j];
    }
    {
        const int h = 8 * grp + wid; const u16* wp = X.WinT + (size_t)l * NIN * DM + (size_t)(NPROJ + h) * DM + lane * 16;
        const u32x4 wa = *(const u32x4*)wp, wb = *(const u32x4*)(wp + 8);
#pragma unroll
        for (int t = 0; t < 4; ++t) {
            const u16* xp = X.XB + (size_t)(row0 + t) * DM + lane * 16; const u32x4 xa = *(const u32x4*)xp, xb = *(const u32x4*)(xp + 8);
            float s = 0.f;
#pragma unroll
            for (int e = 0; e < 4; ++e) { s += bflo(xa[e]) * bflo(wa[e]) + bfhi(xa[e]) * bfhi(wa[e]); s += bflo(xb[e]) * bflo(wb[e]) + bfhi(xb[e]) * bfhi(wb[e]); }
            s = wave_sum(s);
            const float dt = softplus_f(s * rstd_row(X.SSP, row0 + t) + X.in[I_DTB][l * 16 + h]);
            if (lane == 0) DTS[t * 8 + wid] = dt;
        }
    }
    __syncthreads();
    const int p = tid >> 3, nq = tid & 7, n0 = 16 * nq;
    f32x4 nx[4];
    {
        const size_t sidx0 = ((size_t)((l * 128 + b) * 16 + 8 * grp) * 64 + p) * 128 + n0;
#pragma unroll
        for (int e4 = 0; e4 < 4; ++e4) nx[e4] = *(const f32x4*)(X.in[I_SSSM] + sidx0 + 4 * e4);
    }
    for (int hh = 0; hh < 8; ++hh) {
        const int h = 8 * grp + hh; const size_t sidx = ((size_t)((l * 128 + b) * 16 + h) * 64 + p) * 128 + n0;
        float hst[16];
#pragma unroll
        for (int e4 = 0; e4 < 4; ++e4) { const f32x4 v = nx[e4]; hst[4 * e4] = v.x; hst[4 * e4 + 1] = v.y; hst[4 * e4 + 2] = v.z; hst[4 * e4 + 3] = v.w; }
        if (hh < 7) {
#pragma unroll
            for (int e4 = 0; e4 < 4; ++e4) nx[e4] = *(const f32x4*)(X.in[I_SSSM] + sidx + 8192 + 4 * e4);
        }
        const float A = -expf(X.in[I_ALOG][l * 16 + h]), Dh = X.in[I_DSK][l * 16 + h];
        float y[4];
#pragma unroll
        for (int t = 0; t < 4; ++t) {
            const float dt = DTS[t * 8 + hh], dA = __expf(dt * A), dx = dt * XS[t * 512 + hh * 64 + p]; float acc = 0.f;
#pragma unroll
            for (int e = 0; e < 16; ++e) { hst[e] = fmaf(hst[e], dA, dx * BS[t * 128 + n0 + e]); acc = fmaf(hst[e], CS[t * 128 + n0 + e], acc); }
            y[t] = acc;
        }
#pragma unroll
        for (int e4 = 0; e4 < 4; ++e4) { f32x4 v; v.x = hst[4 * e4]; v.y = hst[4 * e4 + 1]; v.z = hst[4 * e4 + 2]; v.w = hst[4 * e4 + 3]; *(f32x4*)(X.out + O_HS + sidx + 4 * e4) = v; }
#pragma unroll
        for (int t = 0; t < 4; ++t) {
            float yy = y[t]; yy += __shfl_xor(yy, 1); yy += __shfl_xor(yy, 2); yy += __shfl_xor(yy, 4);
            if (nq == 0) { const float yv = yy + Dh * XS[t * 512 + hh * 64 + p]; const float z = bf2f(X.PROJ[(size_t)(row0 + t) * NPROJ + C_Z + 64 * h + p]); YG[t * 512 + hh * 64 + p] = yv * silu_f(z); }
        }
    }
    __syncthreads();
    if (wid < 4) {
        const int t = wid; float ss = 0.f;
#pragma unroll
        for (int k = 0; k < 8; ++k) { const float v = YG[t * 512 + lane + 64 * k]; ss += v * v; }
        ss = wave_sum(ss); const float rs = rsqrtf(ss * (1.f / 512.f) + EPS);
#pragma unroll
        for (int k = 0; k < 8; ++k) { const int col = lane + 64 * k; X.YMIX[(size_t)(row0 + t) * NMIX + 512 * grp + col] = (u16)f2bf(YG[t * 512 + col] * rs); }
    }
}
constexpr int KNP = 72;
constexpr int VTP = 264;
__device__ __forceinline__ void attn_prompt_unit(const Ctx& X, int l, int b, int nb, ldsp L, int tid, int wid, int lane) {
    LAS u16* Kn = (LAS u16*)L;
    LAS u16* Vt = (LAS u16*)(L + 73728);
    const int i = lane & 15, g = lane >> 4;
    {
        const int key = tid >> 1, part = tid & 1, tk = nb * 128 - 128 + key; const bool last = (nb == 63) && key >= 128;
        if (tk < 0) {
#pragma unroll
            for (int kvh = 0; kvh < 2; ++kvh) {
                LAS u16* kd = Kn + (kvh * 256 + key) * KNP + 16 * part; LAS u16* vd = Vt + (kvh * 64 + 16 * part) * VTP + key;
                *(LAS u32x4*)(kd) = (u32x4){0u, 0u, 0u, 0u}; *(LAS u32x4*)(kd + 8) = (u32x4){0u, 0u, 0u, 0u}; *(LAS u32x4*)(kd + 32) = (u32x4){0u, 0u, 0u, 0u}; *(LAS u32x4*)(kd + 40) = (u32x4){0u, 0u, 0u, 0u};
#pragma unroll
                for (int d = 0; d < 16; ++d) { vd[d * VTP] = 0; vd[(32 + d) * VTP] = 0; }
            }
        } else {
            const u16* src0 = X.PROJ + (size_t)(b * 8192 + tk) * NPROJ + 16 * part;
            u32x4 kw[2][4], vw[2][4];
#pragma unroll
            for (int kvh = 0; kvh < 2; ++kvh) {
                const u16* src = src0 + 64 * kvh;
                kw[kvh][0] = *(const u32x4*)(src + C_K); kw[kvh][1] = *(const u32x4*)(src + C_K + 8); kw[kvh][2] = *(const u32x4*)(src + C_K + 32); kw[kvh][3] = *(const u32x4*)(src + C_K + 40);
                vw[kvh][0] = *(const u32x4*)(src + C_V); vw[kvh][1] = *(const u32x4*)(src + C_V + 8); vw[kvh][2] = *(const u32x4*)(src + C_V + 32); vw[kvh][3] = *(const u32x4*)(src + C_V + 40);
            }
            float cs[16], sn[16];
            {
                const f32x4* cp = (const f32x4*)(X.COS + (size_t)tk * 32 + 16 * part); const f32x4* sp = (const f32x4*)(X.SIN + (size_t)tk * 32 + 16 * part);
#pragma unroll
                for (int e = 0; e < 4; ++e) { const f32x4 c4 = cp[e], s4 = sp[e]; cs[4 * e] = c4.x; cs[4 * e + 1] = c4.y; cs[4 * e + 2] = c4.z; cs[4 * e + 3] = c4.w; sn[4 * e] = s4.x; sn[4 * e + 1] = s4.y; sn[4 * e + 2] = s4.z; sn[4 * e + 3] = s4.w; }
            }
            const float* kn = X.in[I_KN] + l * 64 + 16 * part;
#pragma unroll
            for (int kvh = 0; kvh < 2; ++kvh) {
                LAS u16* kd = Kn + (kvh * 256 + key) * KNP + 16 * part; LAS u16* vd = Vt + (kvh * 64 + 16 * part) * VTP + key;
                float x1[16], x2[16]; float ss = 0.f;
#pragma unroll
                for (int q = 0; q < 4; ++q) { x1[2 * q] = bflo(kw[kvh][0][q]); x1[2 * q + 1] = bfhi(kw[kvh][0][q]); x1[8 + 2 * q] = bflo(kw[kvh][1][q]); x1[8 + 2 * q + 1] = bfhi(kw[kvh][1][q]);
                    x2[2 * q] = bflo(kw[kvh][2][q]); x2[2 * q + 1] = bfhi(kw[kvh][2][q]); x2[8 + 2 * q] = bflo(kw[kvh][3][q]); x2[8 + 2 * q + 1] = bfhi(kw[kvh][3][q]); }
#pragma unroll
                for (int d = 0; d < 16; ++d) ss += x1[d] * x1[d] + x2[d] * x2[d];
                ss += __shfl_xor(ss, 1);
                const float rs = rsqrtf(ss * (1.f / 64.f) + EPS);
#pragma unroll
                for (int d = 0; d < 16; ++d) { const float u1 = x1[d] * rs * kn[d], u2 = x2[d] * rs * kn[d + 32], c = cs[d], sv = sn[d]; x1[d] = u1 * c - u2 * sv; x2[d] = u2 * c + u1 * sv; }
#pragma unroll
                for (int e = 0; e < 2; ++e) { u32x4 w; w.x = pk2(x1[8 * e], x1[8 * e + 1]); w.y = pk2(x1[8 * e + 2], x1[8 * e + 3]); w.z = pk2(x1[8 * e + 4], x1[8 * e + 5]); w.w = pk2(x1[8 * e + 6], x1[8 * e + 7]); *(LAS u32x4*)(kd + 8 * e) = w;
                    u32x4 v; v.x = pk2(x2[8 * e], x2[8 * e + 1]); v.y = pk2(x2[8 * e + 2], x2[8 * e + 3]); v.z = pk2(x2[8 * e + 4], x2[8 * e + 5]); v.w = pk2(x2[8 * e + 6], x2[8 * e + 7]); *(LAS u32x4*)(kd + 32 + 8 * e) = v; }
                const size_t oidx = (((size_t)(l * 4 + b) * 128 + (key - 128)) * 2 + kvh) * 64 + 16 * part;
                if (last) { float* o = X.out + O_KP + oidx;
#pragma unroll
                    for (int e = 0; e < 4; ++e) { *(f32x4*)(o + 4 * e) = (f32x4){x1[4 * e], x1[4 * e + 1], x1[4 * e + 2], x1[4 * e + 3]}; *(f32x4*)(o + 32 + 4 * e) = (f32x4){x2[4 * e], x2[4 * e + 1], x2[4 * e + 2], x2[4 * e + 3]}; } }
#pragma unroll
                for (int hf = 0; hf < 2; ++hf)
#pragma unroll
                    for (int e = 0; e < 2; ++e) { const u32x4 w = vw[kvh][2 * hf + e];
#pragma unroll
                        for (int q = 0; q < 4; ++q) { vd[(32 * hf + 8 * e + 2 * q) * VTP] = (u16)(w[q] & 0xffffu); vd[(32 * hf + 8 * e + 2 * q + 1) * VTP] = (u16)(w[q] >> 16); }
                        if (last) { float* ov = X.out + O_VP + oidx + 32 * hf + 8 * e; *(f32x4*)(ov) = (f32x4){bflo(w[0]), bfhi(w[0]), bflo(w[1]), bfhi(w[1])}; *(f32x4*)(ov + 4) = (f32x4){bflo(w[2]), bfhi(w[2]), bflo(w[3]), bfhi(w[3])}; } }
            }
        }
    }
    __syncthreads();
    const int kvh = wid >> 2; const float sink = X.in[I_SINK][l * 8 + wid];
    const float* qn = X.in[I_QN] + l * 64;
    u32x4 nqa, nqb; f32x4 ncs0, ncs1, nsn0, nsn1;
    {
        const int tq0 = nb * 128 + i; const size_t row0q = (size_t)b * 8192 + tq0;
        nqa = *(const u32x4*)(X.PROJ + row0q * NPROJ + 64 * wid + 8 * g); nqb = *(const u32x4*)(X.PROJ + row0q * NPROJ + 64 * wid + 32 + 8 * g);
        ncs0 = *(const f32x4*)(X.COS + (size_t)tq0 * 32 + 8 * g); ncs1 = *(const f32x4*)(X.COS + (size_t)tq0 * 32 + 8 * g + 4);
        nsn0 = *(const f32x4*)(X.SIN + (size_t)tq0 * 32 + 8 * g); nsn1 = *(const f32x4*)(X.SIN + (size_t)tq0 * 32 + 8 * g + 4);
    }
    for (int qt = 0; qt < 8; ++qt) {
        const int qi = 16 * qt + i, tq = nb * 128 + qi; const size_t row = (size_t)b * 8192 + tq;
        bf16x8 qf0, qf1;
        {
            const u32x4 wa = nqa, wb = nqb; const f32x4 c0 = ncs0, c1 = ncs1, s0v = nsn0, s1v = nsn1;
            {
                const int qn_ = qt < 7 ? qt + 1 : 7; const int tqn = nb * 128 + 16 * qn_ + i; const size_t rown = (size_t)b * 8192 + tqn;
                nqa = *(const u32x4*)(X.PROJ + rown * NPROJ + 64 * wid + 8 * g); nqb = *(const u32x4*)(X.PROJ + rown * NPROJ + 64 * wid + 32 + 8 * g);
                ncs0 = *(const f32x4*)(X.COS + (size_t)tqn * 32 + 8 * g); ncs1 = *(const f32x4*)(X.COS + (size_t)tqn * 32 + 8 * g + 4);
                nsn0 = *(const f32x4*)(X.SIN + (size_t)tqn * 32 + 8 * g); nsn1 = *(const f32x4*)(X.SIN + (size_t)tqn * 32 + 8 * g + 4);
            }
            float x1[8], x2[8]; float ss = 0.f;
#pragma unroll
            for (int q = 0; q < 4; ++q) { x1[2 * q] = bflo(wa[q]); x1[2 * q + 1] = bfhi(wa[q]); x2[2 * q] = bflo(wb[q]); x2[2 * q + 1] = bfhi(wb[q]); }
#pragma unroll
            for (int e = 0; e < 8; ++e) ss += x1[e] * x1[e] + x2[e] * x2[e];
            ss += __shfl_xor(ss, 16); ss += __shfl_xor(ss, 32);
            const float rs = rsqrtf(ss * (1.f / 64.f) + EPS) * 0.125f;
            const float cs[8] = {c0.x, c0.y, c0.z, c0.w, c1.x, c1.y, c1.z, c1.w}, sn[8] = {s0v.x, s0v.y, s0v.z, s0v.w, s1v.x, s1v.y, s1v.z, s1v.w};
            float o1[8], o2[8];
#pragma unroll
            for (int e = 0; e < 8; ++e) { const float a = x1[e] * rs * qn[8 * g + e], bb = x2[e] * rs * qn[32 + 8 * g + e], c = cs[e], s = sn[e]; o1[e] = a * c - bb * s; o2[e] = bb * c + a * s; }
            u32x4 w0, w1; w0.x = pk2(o1[0], o1[1]); w0.y = pk2(o1[2], o1[3]); w0.z = pk2(o1[4], o1[5]); w0.w = pk2(o1[6], o1[7]);
            w1.x = pk2(o2[0], o2[1]); w1.y = pk2(o2[2], o2[3]); w1.z = pk2(o2[4], o2[5]); w1.w = pk2(o2[6], o2[7]);
            qf0 = __builtin_bit_cast(bf16x8, w0); qf1 = __builtin_bit_cast(bf16x8, w1);
        }
        f32x4 s[9]; float mx = -INFINITY;
#pragma unroll
        for (int kk = 0; kk < 9; ++kk) {
            const int kt = qt + kk; ldsp kp = (ldsp)(Kn + (kvh * 256 + 16 * kt + i) * KNP + 8 * g);
            f32x4 a = {0.f, 0.f, 0.f, 0.f}; a = mfma16(lds16(kp), qf0, a); a = mfma16(lds16(kp + 64), qf1, a);
#pragma unroll
            for (int j = 0; j < 4; ++j) { const int kj = 16 * kt + 4 * g + j; const bool ok = (kj > qi) && (kj <= qi + 128) && (nb > 0 || kj >= 128); a[j] = ok ? a[j] : -INFINITY; mx = fmaxf(mx, a[j]); }
            s[kk] = a;
        }
        mx = fmaxf(mx, __shfl_xor(mx, 16)); mx = fmaxf(mx, __shfl_xor(mx, 32)); mx = fmaxf(mx, sink);
        float sum = 0.f;
#pragma unroll
        for (int kk = 0; kk < 9; ++kk)
#pragma unroll
            for (int j = 0; j < 4; ++j) { const float p = __expf(s[kk][j] - mx); s[kk][j] = p; sum += p; }
        sum += __shfl_xor(sum, 16); sum += __shfl_xor(sum, 32);
        const float inv = 1.f / (sum + __expf(sink - mx));
        f32x4 o[4];
#pragma unroll
        for (int dt = 0; dt < 4; ++dt) o[dt] = (f32x4){0.f, 0.f, 0.f, 0.f};
#pragma unroll
        for (int pi = 0; pi < 5; ++pi) {
            const int k0 = 2 * pi, k1 = (2 * pi + 1 < 9) ? 2 * pi + 1 : 2 * pi;
            u32x4 pw; pw.x = pk2(s[k0][0], s[k0][1]); pw.y = pk2(s[k0][2], s[k0][3]);
            if (2 * pi + 1 < 9) { pw.z = pk2(s[k1][0], s[k1][1]); pw.w = pk2(s[k1][2], s[k1][3]); } else { pw.z = 0u; pw.w = 0u; }
            const bf16x8 pf = __builtin_bit_cast(bf16x8, pw);
#pragma unroll
            for (int dt = 0; dt < 4; ++dt) {
                LAS u16* vr = Vt + (kvh * 64 + 16 * dt + i) * VTP + 4 * g;
                const bf16x8 vf = lds8x2((ldsp)(vr + 16 * (qt + k0)), (ldsp)(vr + 16 * (qt + k1)));
                o[dt] = mfma16(vf, pf, o[dt]);
            }
        }
#pragma unroll
        for (int dt = 0; dt < 4; ++dt) { u32x2 w; w.x = pk2(o[dt][0] * inv, o[dt][1] * inv); w.y = pk2(o[dt][2] * inv, o[dt][3] * inv);
            *(u32x2*)(X.YMIX + row * NMIX + 1024 + 64 * wid + 16 * dt + 4 * g) = w; }
    }
}

__device__ __forceinline__ void scan_unit(const Ctx& X, int l, int hs, int tid) {
    const int b = hs >> 7, h = (hs >> 3) & 15, pq = hs & 7;
    const int p = 8 * pq + (tid >> 6), n = (tid & 63) * 2;
    u16* base = X.ST + ((size_t)(b * 64) * 16 + h) * 8192 + p * 128 + n;
    const float* cd = X.CD + (b * 64) * 16 + h;
    float h0 = 0.f, h1 = 0.f;
    for (int c0 = 0; c0 < 64; c0 += 32) {
        unsigned st[32]; float dc[32];
#pragma unroll
        for (int e = 0; e < 32; ++e) { st[e] = *(const unsigned*)(base + (size_t)(c0 + e) * 16 * 8192); dc[e] = cd[(c0 + e) * 16]; }
#pragma unroll
        for (int e = 0; e < 32; ++e) {
            *(unsigned*)(base + (size_t)(c0 + e) * 16 * 8192) = pk2(h0, h1);
            h0 = fmaf(h0, dc[e], bflo(st[e])); h1 = fmaf(h1, dc[e], bfhi(st[e]));
        }
    }
    float* o = X.out + O_HP + ((size_t)((l * 4 + b) * 16 + h) * 64 + p) * 128 + n; o[0] = h0; o[1] = h1;
}

constexpr int KCP = 132;
__device__ __forceinline__ void attn_sample_unit(const Ctx& X, int l, int b, ldsp L, int tid, int wid, int lane) {
    LAS u16* KC = (LAS u16*)L;
    LAS u16* VC = (LAS u16*)(L + 34848);
    LAS float* QS = (LAS float*)(L + 69696);
    LAS float* SS = (LAS float*)(L + 77888);
    const int row0 = MP + b * 4;
#pragma unroll
    for (int k = 0; k < 8; ++k) {
        const int idx = tid + 512 * k, j = idx >> 5, c4 = (idx & 31) * 4; const size_t off = ((size_t)(l * 128 + b) * 128 + j) * 128 + c4;
        const f32x4 kv = *(const f32x4*)(X.in[I_CK] + off), vv = *(const f32x4*)(X.in[I_CV] + off);
        { u32x2 kw2; kw2.x = pk2(kv.x, kv.y); kw2.y = pk2(kv.z, kv.w); *(LAS u32x2*)(KC + j * KCP + c4) = kw2; u32x2 vw2; vw2.x = pk2(vv.x, vv.y); vw2.y = pk2(vv.z, vv.w); *(LAS u32x2*)(VC + j * KCP + c4) = vw2; }
        if (j >= 4) { const size_t oo = ((size_t)(l * 128 + b) * 128 + (j - 4)) * 128 + c4; *(f32x4*)(X.out + O_KS + oo) = kv; *(f32x4*)(X.out + O_VS + oo) = vv; }
    }
    {
        const int t = wid >> 1, kvh = wid & 1; const u16* src = X.PROJ + (size_t)(row0 + t) * NPROJ;
        const float x = bf2f(src[C_K + 64 * kvh + lane]); const float ss = wave_sum(x * x);
        const float xn = x * rsqrtf(ss * (1.f / 64.f) + EPS) * X.in[I_KN][l * 64 + lane]; const float pr = __shfl_xor(xn, 32);
        const float c = X.COS[(size_t)(8192 + t) * 32 + (lane & 31)], s = X.SIN[(size_t)(8192 + t) * 32 + (lane & 31)];
        const float o = lane < 32 ? xn * c - pr * s : xn * c + pr * s;
        KC[(128 + t) * KCP + kvh * 64 + lane] = (u16)f2bf(o);
        const size_t oo = ((size_t)(l * 128 + b) * 128 + 124 + t) * 128 + kvh * 64 + lane;
        X.out[O_KS + oo] = o;
        const unsigned vraw = src[C_V + 64 * kvh + lane]; VC[(128 + t) * KCP + kvh * 64 + lane] = (u16)vraw; X.out[O_VS + oo] = bf2f(vraw);
    }
#pragma unroll
    for (int k = 0; k < 4; ++k) {
        const int pair = 4 * wid + k, t = pair >> 3, head = pair & 7;
        const float x = bf2f(X.PROJ[(size_t)(row0 + t) * NPROJ + 64 * head + lane]); const float ss = wave_sum(x * x);
        const float xn = x * rsqrtf(ss * (1.f / 64.f) + EPS) * X.in[I_QN][l * 64 + lane]; const float pr = __shfl_xor(xn, 32);
        const float c = X.COS[(size_t)(8192 + t) * 32 + (lane & 31)], s = X.SIN[(size_t)(8192 + t) * 32 + (lane & 31)];
        QS[pair * 64 + lane] = (lane < 32 ? xn * c - pr * s : xn * c + pr * s) * 0.125f;
    }
    __syncthreads();
    for (int it = 0; it < 9; ++it) {
        const int idx = tid + 512 * it;
        if (idx < 32 * 132) {
            const int pair = idx / 132, key = idx - pair * 132, t = pair >> 3, head = pair & 7, kvh = head >> 2;
            const bool ok = key < 128 ? key > t : (key - 128) <= t;
            float s = 0.f;
#pragma unroll
            for (int d = 0; d < 64; d += 4) { const u32x2 kw2 = *(LAS u32x2*)(KC + key * KCP + kvh * 64 + d); const f32x4 q4 = *(LAS f32x4*)(QS + pair * 64 + d);
                s = fmaf(q4.x, bflo(kw2.x), s); s = fmaf(q4.y, bfhi(kw2.x), s); s = fmaf(q4.z, bflo(kw2.y), s); s = fmaf(q4.w, bfhi(kw2.y), s); }
            SS[pair * 136 + key] = ok ? s : -INFINITY;
        }
    }
    __syncthreads();
#pragma unroll
    for (int k = 0; k < 4; ++k) {
        const int pair = 4 * wid + k, head = pair & 7; const float sink = X.in[I_SINK][l * 8 + head];
        const float v0 = SS[pair * 136 + lane], v1 = SS[pair * 136 + 64 + lane], v2 = lane < 4 ? SS[pair * 136 + 128 + lane] : -INFINITY;
        const float mx = fmaxf(wave_max(fmaxf(fmaxf(v0, v1), v2)), sink);
        const float e0 = __expf(v0 - mx), e1 = __expf(v1 - mx), e2 = __expf(v2 - mx);
        const float inv = 1.f / (wave_sum(e0 + e1 + e2) + __expf(sink - mx));
        SS[pair * 136 + lane] = e0 * inv; SS[pair * 136 + 64 + lane] = e1 * inv; if (lane < 4) SS[pair * 136 + 128 + lane] = e2 * inv;
    }
    __syncthreads();
    {
        const int pair = tid >> 4, d4 = (tid & 15) * 4, head = pair & 7, kvh = head >> 2, t = pair >> 3;
        float a0 = 0.f, a1 = 0.f, a2 = 0.f, a3 = 0.f;
        for (int key = 0; key < 132; ++key) {
            const float p = SS[pair * 136 + key]; const u32x2 vw2 = *(LAS u32x2*)(VC + key * KCP + kvh * 64 + d4); const unsigned w0 = vw2.x, w1 = vw2.y;
            a0 = fmaf(p, bflo(w0), a0); a1 = fmaf(p, bfhi(w0), a1); a2 = fmaf(p, bflo(w1), a2); a3 = fmaf(p, bfhi(w1), a3);
        }
        u32x2 w; w.x = pk2(a0, a1); w.y = pk2(a2, a3); *(u32x2*)(X.YMIX + (size_t)(row0 + t) * NMIX + 1024 + 64 * head + d4) = w;
    }
}

constexpr int CNP = 136;
template <int MODE> __device__ __forceinline__ void ssd_out_unit(const Ctx& X, int l, int b, int c, ldsp L, int tid, int wid, int lane) {
    LAS float* DTL = (LAS float*)L; LAS float* ACL = (LAS float*)(L + 8192);
    LAS u16* CcL = (LAS u16*)(L + 16384);
    LAS u16* CBL = (LAS u16*)(L + 16384 + 34816);
    LAS float* SSQ = (LAS float*)(L + 16384 + 34816 + 18432);
    LAS u16* XT = (LAS u16*)(L + 73728);
    LAS u16* BcL = XT;
    const int i = lane & 15, g = lane >> 4, r0 = b * 8192 + c * 128;
    const float* cw = X.in[I_CW] + (size_t)l * 4 * 1536; const float* cb = X.in[I_CB] + (size_t)l * 1536;
    { const f32x4 d4 = *(const f32x4*)(X.DT + (size_t)r0 * 16 + tid * 4); const int s_ = tid >> 2, h0 = (tid & 3) * 4;
      DTL[(h0 + 0) * 128 + s_] = d4.x; DTL[(h0 + 1) * 128 + s_] = d4.y; DTL[(h0 + 2) * 128 + s_] = d4.z; DTL[(h0 + 3) * 128 + s_] = d4.w; }
    __syncthreads();
    acum_scan(DTL, ACL, X.in[I_ALOG] + l * 16, wid, lane);
    if (c == 63) for (int idx = tid; idx < 3 * 1536; idx += 512) { const int j = idx / 1536, col = idx - j * 1536;
        X.out[O_CP + ((size_t)(l * 4 + b) * 3 + j) * 1536 + col] = bf2f(X.PROJ[(size_t)(b * 8192 + 8189 + j) * NPROJ + C_X + col]); }
    __syncthreads();
    for (int grp = 0; grp < 2; ++grp) {
        {
            const int cg = lane, tok0 = 16 * wid, isC = cg >> 5, n0 = 4 * (cg & 31), xcol0 = 1024 + 256 * isC + 128 * grp + n0; const ConvW4 w = conv4_w(cw, cb, xcol0);
            float raw[19][4]; conv4_load<16>(raw, X.PROJ, r0 + tok0, !(c == 0 && tok0 == 0), xcol0);
            LAS u16* dst = (isC ? CcL : BcL) + tok0 * CNP + n0;
#pragma unroll
            for (int k = 0; k < 16; ++k) { u32x2 pw; pw.x = pk2(CONV4_TAP(w, raw, k, 0), CONV4_TAP(w, raw, k, 1)); pw.y = pk2(CONV4_TAP(w, raw, k, 2), CONV4_TAP(w, raw, k, 3)); *(LAS u32x2*)(dst + k * CNP) = pw; }
        }
        __syncthreads();
        if (MODE != 1) for (int tix = wid; tix < 36; tix += 8) {
            int qt = 0; while ((qt + 1) * (qt + 2) / 2 <= tix) ++qt; const int st = tix - qt * (qt + 1) / 2;
            f32x4 a = {0.f, 0.f, 0.f, 0.f};
#pragma unroll
            for (int kk = 0; kk < 4; ++kk) a = mfma16(lds16((ldsp)(BcL + (16 * st + i) * CNP + 32 * kk + 8 * g)), lds16((ldsp)(CcL + (16 * qt + i) * CNP + 32 * kk + 8 * g)), a);
            { u32x2 cw; cw.x = pk2(a[0], a[1]); cw.y = pk2(a[2], a[3]); *(LAS u32x2*)(CBL + (tix * 64 + lane) * 4) = cw; }
        }
        __syncthreads();
        for (int quad = 0; quad < 2; ++quad) {
            const int hq = 2 * grp + quad;
            bf16x8 hsf[4][4];
            {
                const int cg = lane, tok0 = 16 * wid, xcol0 = 256 * hq + 4 * cg; const ConvW4 w = conv4_w(cw, cb, xcol0);
                float raw[19][4]; conv4_load<16>(raw, X.PROJ, r0 + tok0, !(c == 0 && tok0 == 0), xcol0);
                {
                    const u16* hsb = X.ST + ((size_t)((b * 64 + c) * 16 + 4 * hq + (wid >> 1))) * 8192;
#pragma unroll
                    for (int pt = 0; pt < 4; ++pt)
#pragma unroll
                        for (int kk = 0; kk < 4; ++kk) hsf[pt][kk] = *(const bf16x8*)(hsb + (16 * pt + i) * 128 + 32 * kk + 8 * g);
                }
#pragma unroll
                for (int e = 0; e < 4; ++e)
#pragma unroll
                    for (int kq = 0; kq < 4; ++kq) { u32x2 pw; pw.x = pk2(CONV4_TAP(w, raw, 4 * kq, e), CONV4_TAP(w, raw, 4 * kq + 1, e)); pw.y = pk2(CONV4_TAP(w, raw, 4 * kq + 2, e), CONV4_TAP(w, raw, 4 * kq + 3, e));
                        *(LAS u32x2*)(XT + (4 * cg + e) * XTP + tok0 + 4 * kq) = pw; }
            }
            __syncthreads();
            if (MODE != 1) {
                const int hl = wid >> 1, half = wid & 1, h = 4 * hq + hl, hh = quad * 4 + hl;
                const float Dh = X.in[I_DSK][l * 16 + h];
                for (int qx = 0; qx < 4; ++qx) {
                    const int qt = qx == 0 ? half : (qx == 1 ? 3 - half : (qx == 2 ? 4 + half : 7 - half));
                    const int q = 16 * qt + i; const float aq = ACL[h * 128 + q], eaq = __expf(aq);
                    const size_t row = (size_t)r0 + q; u32x2 zw[4];
#pragma unroll
                    for (int pt = 0; pt < 4; ++pt) zw[pt] = *(const u32x2*)(X.PROJ + row * NPROJ + C_Z + 64 * h + 16 * pt + 4 * g);
                    f32x4 accy[4], acci[4];
#pragma unroll
                    for (int pt = 0; pt < 4; ++pt) { accy[pt] = (f32x4){0.f, 0.f, 0.f, 0.f}; acci[pt] = (f32x4){0.f, 0.f, 0.f, 0.f}; }
#pragma unroll
                    for (int kk = 0; kk < 4; ++kk) { const bf16x8 cf = lds16((ldsp)(CcL + q * CNP + 32 * kk + 8 * g));
#pragma unroll
                        for (int pt = 0; pt < 4; ++pt) accy[pt] = mfma16(hsf[pt][kk], cf, accy[pt]); }
                    const int tb = qt * (qt + 1) / 2, npair = qt / 2 + 1;
                    for (int pi = 0; pi < npair; ++pi) {
                        const int st0 = 2 * pi; const bool has1 = (st0 + 1) <= qt; const int st1 = has1 ? st0 + 1 : st0;
                        float m0[4], m1[4];
                        {
                            const int sa0 = 16 * st0 + 4 * g, sb0 = 16 * st1 + 4 * g;
                            const u32x2 cwa = *(LAS u32x2*)(CBL + ((tb + st0) * 64 + lane) * 4), cwb = *(LAS u32x2*)(CBL + ((tb + st1) * 64 + lane) * 4);
                            const f32x4 aca = *(LAS f32x4*)(ACL + h * 128 + sa0), acb = *(LAS f32x4*)(ACL + h * 128 + sb0);
                            const f32x4 dta = *(LAS f32x4*)(DTL + h * 128 + sa0), dtb = *(LAS f32x4*)(DTL + h * 128 + sb0);
                            const float ca[4] = {bflo(cwa.x), bfhi(cwa.x), bflo(cwa.y), bfhi(cwa.y)}, cb4[4] = {bflo(cwb.x), bfhi(cwb.x), bflo(cwb.y), bfhi(cwb.y)};
#pragma unroll
                            for (int j = 0; j < 4; ++j) {
                                const float va = ca[j] * __expf(fminf(aq - aca[j], 0.f)) * dta[j], vb = cb4[j] * __expf(fminf(aq - acb[j], 0.f)) * dtb[j];
                                m0[j] = (sa0 + j) <= q ? va : 0.f; m1[j] = (has1 && (sb0 + j) <= q) ? vb : 0.f;
                            }
                        }
                        u32x4 mw; mw.x = pk2(m0[0], m0[1]); mw.y = pk2(m0[2], m0[3]); mw.z = pk2(m1[0], m1[1]); mw.w = pk2(m1[2], m1[3]);
                        const bf16x8 mf = __builtin_bit_cast(bf16x8, mw);
#pragma unroll
                        for (int pt = 0; pt < 4; ++pt) { LAS u16* xr = XT + (hl * 64 + 16 * pt + i) * XTP + 4 * g;
                            acci[pt] = mfma16(lds8x2((ldsp)(xr + 16 * st0), (ldsp)(xr + 16 * st1)), mf, acci[pt]); }
                    }
                    float ss = 0.f;
#pragma unroll
                    for (int pt = 0; pt < 4; ++pt) {
                        const int p0 = 16 * pt + 4 * g;
                        const float z[4] = {bflo(zw[pt].x), bfhi(zw[pt].x), bflo(zw[pt].y), bfhi(zw[pt].y)}; float o[4];
#pragma unroll
                        for (int j = 0; j < 4; ++j) { const float xv = bf2f(XT[(hl * 64 + p0 + j) * XTP + q]); const float y = acci[pt][j] + eaq * accy[pt][j] + Dh * xv; o[j] = y * silu_f(z[j]); ss += o[j] * o[j]; }
                        u32x2 w; w.x = pk2(o[0], o[1]); w.y = pk2(o[2], o[3]); *(u32x2*)(X.YMIX + row * NMIX + 64 * h + p0) = w;
                    }
                    ss += __shfl_xor(ss, 16); ss += __shfl_xor(ss, 32);
                    if (g == 0) SSQ[q * 8 + hh] = ss;
                }
            }
            __syncthreads();
        }
        if (MODE == 0 && tid < 128) {
            const f32x4 s0 = *(LAS f32x4*)(SSQ + tid * 8), s1 = *(LAS f32x4*)(SSQ + tid * 8 + 4);
            X.RS[((size_t)r0 + tid) * 2 + grp] = rsqrtf((((s0.x + s0.y) + (s0.z + s0.w)) + ((s1.x + s1.y) + (s1.z + s1.w))) * (1.f / 512.f) + EPS);
        }
        __syncthreads();
    }
}
constexpr int N_PHASES = 1 + 7 * NL;

__device__ __forceinline__ void small_res_unit(const u16* A, const u16* WT, int K, float* outf, u16* xb, float* ssp, int u, ldsp L, int tid, int wid, int lane) {
    const int rt = u >> 4, ct = u & 15, i = lane & 15, g = lane >> 4;
    const int trow = 32 * rt + 16 * (wid >> 2) + i, col0 = 64 * ct + 16 * (wid & 3);
    const u16* ap = A + (size_t)(MP + trow) * K + 8 * g; const u16* wp = WT + (size_t)(col0 + i) * K + 8 * g;
    f32x4 acc = {0.f, 0.f, 0.f, 0.f};
    if (K == NMIX) {
#pragma unroll 24
        for (int kk = 0; kk < NMIX / 32; ++kk) acc = mfma16(*(const bf16x8*)(wp + 32 * kk), *(const bf16x8*)(ap + 32 * kk), acc);
    } else {
#pragma unroll 22
        for (int kk = 0; kk < DFF / 32; ++kk) acc = mfma16(*(const bf16x8*)(wp + 32 * kk), *(const bf16x8*)(ap + 32 * kk), acc);
    }
    const size_t o = (size_t)(MP + trow) * DM + col0 + 4 * g;
    const u32x2 rw = *(const u32x2*)(xb + o); const f32x4 r = {bflo(rw.x), bfhi(rw.x), bflo(rw.y), bfhi(rw.y)};
    const f32x4 v = acc + r;
    if (outf) *(f32x4*)(outf + o) = v;
    u32x2 w; w.x = pk2(v[0], v[1]); w.y = pk2(v[2], v[3]); *(u32x2*)(xb + o) = w;
    float ss = (v[0] * v[0] + v[1] * v[1]) + (v[2] * v[2] + v[3] * v[3]); ss += __shfl_xor(ss, 16); ss += __shfl_xor(ss, 32);
    LAS float* red = (LAS float*)L;
    if (g == 0) red[wid * 16 + i] = ss;
    __syncthreads();
    if (tid < 32) { const int hw = tid >> 4, t = tid & 15; ssp[(size_t)(MP + 32 * rt + 16 * hw + t) * 16 + ct] = (red[(4 * hw) * 16 + t] + red[(4 * hw + 1) * 16 + t]) + (red[(4 * hw + 2) * 16 + t] + red[(4 * hw + 3) * 16 + t]); }
    __syncthreads();
}

__device__ __forceinline__ void small_swiglu_unit(const u16* A, const u16* WT, const float* ssp, u16* H, int u, int wid, int lane) {
    const int rt = u / 44, ct = u - rt * 44, i = lane & 15, g = lane >> 4;
    const int trow = MP + 32 * rt + 16 * (wid >> 2) + i, f0 = 64 * ct + 16 * (wid & 3);
    const int wrow = (f0 >> 7) * 256 + (f0 & 127) + i;
    const u16* ap = A + (size_t)trow * DM + 8 * g; const u16* gp = WT + (size_t)wrow * DM + 8 * g; const u16* up = gp + (size_t)128 * DM;
    f32x4 ag = {0.f, 0.f, 0.f, 0.f}, au = {0.f, 0.f, 0.f, 0.f};
#pragma unroll 8
    for (int kk = 0; kk < DM / 32; ++kk) { const bf16x8 a = *(const bf16x8*)(ap + 32 * kk); ag = mfma16(*(const bf16x8*)(gp + 32 * kk), a, ag); au = mfma16(*(const bf16x8*)(up + 32 * kk), a, au); }
    const float rs = rstd_row(ssp, trow);
    u32x2 w; w.x = pk2(silu_f(ag[0] * rs) * (au[0] * rs), silu_f(ag[1] * rs) * (au[1] * rs)); w.y = pk2(silu_f(ag[2] * rs) * (au[2] * rs), silu_f(ag[3] * rs) * (au[3] * rs));
    *(u32x2*)(H + (size_t)trow * DFF + f0 + 4 * g) = w;
}
#define XB_TMO      128
#define XB_XCNT(j)  (256  + 64 * (j))
#define XB_XSUB(j)  (1280 + 64 * (j))
#define XB_XGEN(j)  (2304 + 64 * (j))
#define XB_TOP      3328
#define XB_TOPGEN   3392
#define XCD_BAR_WORDS 3456
#define XB_SPIN_CAP (1u << 18)

__device__ __forceinline__ unsigned xb_ld(unsigned* p)              { return __hip_atomic_load(p, __ATOMIC_RELAXED, __HIP_MEMORY_SCOPE_AGENT); }
__device__ __forceinline__ unsigned xb_add(unsigned* p, unsigned v) { return __hip_atomic_fetch_add(p, v, __ATOMIC_RELAXED, __HIP_MEMORY_SCOPE_AGENT); }
__device__ __forceinline__ unsigned xb_xcc_id() { return (unsigned)__builtin_amdgcn_s_getreg((3 << 11) | 20) & 0xFu; }
#define XB_SPIN(cond, bar) do { unsigned _sp = 0; while (cond) { __builtin_amdgcn_s_sleep(1); \
    if ((++_sp & 255u) == 0u) { if (xb_ld(&(bar)[XB_TMO])) break; if (_sp > XB_SPIN_CAP) { atomicAdd(&(bar)[XB_TMO], 1u); break; } } } } while (0)

struct XcdBarrier {
    unsigned* bar; unsigned x;
    volatile LAS unsigned* st;
};

__device__ __forceinline__ XcdBarrier xcd_barrier_post(unsigned* bar, volatile LAS unsigned* st) {
    XcdBarrier b; b.bar = bar; b.x = xb_xcc_id(); b.st = st;
    if (threadIdx.x == 0) (void)xb_add(&bar[XB_XCNT(b.x)], 1u);
    return b;
}
__device__ __forceinline__ void xcd_barrier_complete(unsigned* bar, unsigned x, unsigned& nloc, unsigned& nx) {
    const unsigned G = gridDim.x * gridDim.y * gridDim.z;
    unsigned sum, cnt, mine, sp = 0u;
    for (;;) {
        sum = 0u; cnt = 0u; mine = 0u;
#pragma unroll
        for (unsigned j = 0; j < 16; ++j) { const unsigned c = xb_ld(&bar[XB_XCNT(j)]); sum += c; cnt += (c > 0u) ? 1u : 0u; mine = (j == x) ? c : mine; }
        if (sum == G) break;
        __builtin_amdgcn_s_sleep(1);
        if ((++sp & 255u) == 0u) { if (xb_ld(&bar[XB_TMO])) break; if (sp > XB_SPIN_CAP) { atomicAdd(&bar[XB_TMO], 1u); break; } }
    }
    nloc = mine > 0u ? mine : 1u; nx = cnt > 0u ? cnt : 1u;
}

__device__ __forceinline__ void xcd_barrier(const XcdBarrier& b) {
    asm volatile("s_waitcnt vmcnt(0)" ::: "memory");
    __syncthreads();
    if (threadIdx.x == 0) {
        unsigned* bar = b.bar;
        __builtin_amdgcn_s_waitcnt(0);
        unsigned nloc = b.st[0], nx = b.st[1];
        if (nloc == 0u) { xcd_barrier_complete(bar, b.x, nloc, nx); b.st[0] = nloc; b.st[1] = nx; }
        const unsigned old = xb_add(&bar[XB_XSUB(b.x)], 1u);
        const unsigned gen = old / nloc;
        if (old + 1u == (gen + 1u) * nloc) {
            __builtin_amdgcn_fence(__ATOMIC_RELEASE, "agent");
            asm volatile("s_waitcnt vmcnt(0)" ::: "memory");
            const unsigned og = xb_add(&bar[XB_TOP], 1u);
            const unsigned tg = og / nx;
            if (og + 1u == (tg + 1u) * nx) xb_add(&bar[XB_TOPGEN], 1u);
            else XB_SPIN(xb_ld(&bar[XB_TOPGEN]) == tg, bar);
            __builtin_amdgcn_fence(__ATOMIC_ACQUIRE, "agent");
            xb_add(&bar[XB_XGEN(b.x)], 1u);
            asm volatile("s_waitcnt vmcnt(0)" ::: "memory");
        } else {
            XB_SPIN(xb_ld(&bar[XB_XGEN(b.x)]) == gen, bar);
            __builtin_amdgcn_fence(__ATOMIC_ACQUIRE, "agent");
            asm volatile("s_waitcnt vmcnt(0)" ::: "memory");
        }
    }
    __syncthreads();
}

#ifndef REP_SUB
#define REP_SUB 0
#endif
#ifndef REP_PH
#define REP_PH -1
#endif
#ifndef REP_MASK
#define REP_MASK 0
#endif
#ifndef UN_MASK
#define UN_MASK 31
#endif
#ifndef PH_MASK
#define PH_MASK 255
#endif
__global__ void __launch_bounds__(512, 2) hymba_mk(Params P) {
    extern __shared__ __attribute__((aligned(16))) unsigned char lds_raw[];
    ldsp L = (ldsp)lds_raw;
    u16* HB;
    volatile LAS unsigned* bst = (volatile LAS unsigned*)(L + LDS_BYTES - 64);
    if (threadIdx.x < 2) bst[threadIdx.x] = 0u;
    __syncthreads();
    const XcdBarrier xbar = xcd_barrier_post((unsigned*)(P.ws + WS_BAR), bst);
    if (P.ph_hi < 0) cg::this_grid().sync();
    for (int phi = P.ph_lo; phi < P.ph_hi + (REP_PH >= 0 ? 1 : 0); ++phi) {
        if (phi > P.ph_lo) xcd_barrier(xbar);
        const int ph = (REP_PH >= 0 && phi > REP_PH) ? phi - 1 : phi; const int rep = (REP_PH >= 0 && phi == REP_PH + 1) ? 1 : 0;
#ifdef EXTRA_SYNCS
        if (phi == 1) for (int es = 0; es < EXTRA_SYNCS; ++es) xcd_barrier(xbar);
#endif
        const __attribute__((address_space(4))) Params* pp = (const __attribute__((address_space(4))) Params*)__builtin_amdgcn_kernarg_segment_ptr();
        asm volatile("" : "+s"(pp));
        int tid = threadIdx.x; asm volatile("" : "+v"(tid));
        int bx = blockIdx.x, G = gridDim.x; asm volatile("" : "+s"(bx), "+s"(G));
        const int lane = tid & 63, wid = __builtin_amdgcn_readfirstlane(tid >> 6);
        Ctx X;
#pragma unroll
        for (int k = 0; k < 21; ++k) X.in[k] = pp->in[k];
        X.out = pp->out; X.ws = pp->ws;
        X.WinT = (u16*)(X.ws + WS_WIN); X.WoutT = (u16*)(X.ws + WS_WOUT); X.WguT = (u16*)(X.ws + WS_WGU); X.WdnT = (u16*)(X.ws + WS_WDN);
        X.COS = (float*)(X.ws + WS_ROPE); X.SIN = (float*)(X.ws + WS_ROPE + SZ_ROPE); X.XB = (u16*)(X.ws + WS_XB); X.SSP = (float*)(X.ws + WS_SSP);
        X.PROJ = (u16*)(X.ws + WS_PROJ); X.YMIX = (u16*)(X.ws + WS_YMIX); X.DT = (float*)(X.ws + WS_DT); X.CD = (float*)(X.ws + WS_CD); X.ST = (u16*)(X.ws + WS_ST); X.RS = (float*)(X.ws + WS_RS);
        HB = X.PROJ;
        if (ph == 0) { if (PH_MASK & 128) phase_prologue(X, L, tid, wid, lane); if (REP_MASK & 128) { __syncthreads(); phase_prologue(X, L, tid, wid, lane); } continue; }
        const int l = (ph - 1) / 7, k = (ph - 1) % 7;
        {
        if (k == 0 && (PH_MASK & 1)) {
            pg8::Gemm g{X.XB, X.WinT + (size_t)l * NIN * DM, M, NPROJ, DM}; pg8::StaticOrder S; S.init(M, NPROJ, G, bx);
            EpiProj E{X.PROJ, X.SSP, L + 131072};
            pg8::gemm_phase<EpiProj, pg8::StaticOrder, true, true>(L, g, S, E, tid);
            if (l == 0 && rep == 0) idle_weight_items(X, L, 0, 130 * 13, G, bx, wid, lane);
        } else if (k == 1 && (PH_MASK & 2)) {
            for (int u = bx; u < 512; u += G) {
                __syncthreads(); asm volatile("" : "+v"(tid)); const int lane = tid & 63, wid = __builtin_amdgcn_readfirstlane(tid >> 6);
                if (rep && REP_SUB == 1 && u >= 256) continue; if (rep && REP_SUB == 2 && u < 256) continue;
                if (u < 256) { if (UN_MASK & 8) ssd_states_unit(X, l, u >> 6, u & 63, L, tid, wid, lane); }
                else { if (UN_MASK & 16) ssd_sample_unit(X, l, (u - 256) >> 1, (u - 256) & 1, L, tid, wid, lane); }
            }
        } else if (k == 2 && (PH_MASK & 4)) {
#define PHB_SYNC() do { __syncthreads(); asm volatile("" : "+v"(tid)); } while (0)
            for (int u = bx; u < 256; u += G) { PHB_SYNC(); const int lane = tid & 63, wid = __builtin_amdgcn_readfirstlane(tid >> 6); attn_prompt_unit(X, l, u >> 6, u & 63, L, tid, wid, lane); }
            for (int u = bx; u < 128; u += G) { PHB_SYNC(); const int lane = tid & 63, wid = __builtin_amdgcn_readfirstlane(tid >> 6); attn_sample_unit(X, l, u, L, tid, wid, lane); }
            {
                int s0 = bx, sn = bx < 512 ? (512 - bx + G - 1) / G : 0, ss = G;
                if (G == 256) { if (bx < 128) { s0 = bx; sn = 1; ss = 1; } else { s0 = 128 + 3 * (bx - 128); sn = 3; ss = 1; } }
                if (rep == 0) for (int i2 = 0; i2 < sn; ++i2) scan_unit(X, l, s0 + i2 * ss, tid);
            }
        } else if (k == 3 && (PH_MASK & 8)) {
            for (int u = bx; u < 256; u += G) { __syncthreads(); asm volatile("" : "+v"(tid)); const int lane = tid & 63, wid = __builtin_amdgcn_readfirstlane(tid >> 6); if (rep && REP_SUB != 0) ssd_out_unit<REP_SUB>(X, l, u >> 6, u & 63, L, tid, wid, lane); else ssd_out_unit<0>(X, l, u >> 6, u & 63, L, tid, wid, lane); }
        } else if (k == 4 && (PH_MASK & 16)) {
            pg8::Gemm g{X.YMIX, X.WoutT + (size_t)l * DM * NMIX, MP, DM, NMIX}; pg8::StaticOrder S; S.init(MP, DM, G, bx);
            EpiResT<true> E{X.XB, nullptr, X.SSP, X.RS};
            pg8::gemm_phase<EpiResT<true>, pg8::StaticOrder, true, true>(L, g, S, E, tid);
            for (int u = bx; u < 256; u += G) small_res_unit(X.YMIX, X.WoutT + (size_t)l * DM * NMIX, NMIX, nullptr, X.XB, X.SSP, u, L, tid, wid, lane);
#if (REP_MASK & 256)
            if (l == 0) for (int rr = 0; rr < 4; ++rr) for (int u = bx; u < 256; u += G) small_res_unit(X.YMIX, X.WoutT + (size_t)l * DM * NMIX, NMIX, nullptr, X.XB, X.SSP, u, L, tid, wid, lane);
#endif
        } else if (k == 5 && (PH_MASK & 32)) {
            pg8::Gemm g{X.XB, X.WguT + (size_t)l * NGU * DM, M, NGU, DM}; pg8::StaticOrder S; S.init(M, NGU, G, bx);
            EpiSwiglu E{HB, X.SSP, L + 131072};
            pg8::gemm_phase<EpiSwiglu, pg8::StaticOrder, true, true>(L, g, S, E, tid);
            if (l == 0 && rep == 0) idle_weight_items(X, L, 1, 130 * 22, G, bx, wid, lane);
        } else if (PH_MASK & 64) {
            pg8::Gemm g{HB, X.WdnT + (size_t)l * DM * DFF, MP, DM, DFF}; pg8::StaticOrder S; S.init(MP, DM, G, bx);
            EpiResT<false> E{X.XB, l == NL - 1 ? X.out : nullptr, X.SSP, nullptr};
            pg8::gemm_phase<EpiResT<false>, pg8::StaticOrder, true, true>(L, g, S, E, tid);
            for (int u = bx; u < 256; u += G) small_res_unit(HB, X.WdnT + (size_t)l * DM * DFF, DFF, l == NL - 1 ? X.out : nullptr, X.XB, X.SSP, u, L, tid, wid, lane);
        }
        }
    }
}

#ifndef MK_ONE_LAUNCH
#define MK_ONE_LAUNCH 1
#endif
extern "C" void kernel_launch(void* const* d_in, const int* in_sizes, int n_in, void* d_out, int out_size, void* d_ws, size_t ws_size, hipStream_t stream) {
    static int grid = 0;
    if (grid == 0) {
        if (n_in != 21 || (size_t)out_size != O_END || ws_size < WS_BAR + SZ_BAR) { fprintf(stderr, "kernel_launch: unexpected shapes (n_in %d out %d ws %zu)\n", n_in, out_size, ws_size); grid = -1; return; }
        int dev = 0, cus = 0, per_cu = 0;
        (void)hipGetDevice(&dev); (void)hipDeviceGetAttribute(&cus, hipDeviceAttributeMultiprocessorCount, dev);
        if (hipFuncSetAttribute((const void*)hymba_mk, hipFuncAttributeMaxDynamicSharedMemorySize, LDS_BYTES) != hipSuccess) { fprintf(stderr, "kernel_launch: hipFuncSetAttribute failed\n"); grid = -1; return; }
        if (hipOccupancyMaxActiveBlocksPerMultiprocessor(&per_cu, (const void*)hymba_mk, 512, LDS_BYTES) != hipSuccess || per_cu < 1) { fprintf(stderr, "kernel_launch: occupancy query gave %d\n", per_cu); per_cu = 1; }
        (void)hipGetLastError();
        grid = cus * per_cu;
    }
    if (grid < 0) return;
    Params p{};
    for (int i = 0; i < 21; ++i) p.in[i] = (const float*)d_in[i];
    p.out = (float*)d_out; p.ws = (unsigned char*)d_ws;
#if MK_ONE_LAUNCH
    p.ph_lo = 0; p.ph_hi = N_PHASES;
    (void)hipMemsetAsync((unsigned char*)d_ws + WS_BAR, 0, SZ_BAR, stream);
    void* args[] = {&p};
    hipError_t e = hipLaunchCooperativeKernel((const void*)hymba_mk, dim3(grid), dim3(512), args, LDS_BYTES, stream);
    if (e != hipSuccess) fprintf(stderr, "cooperative launch failed: %s (grid %d)\n", hipGetErrorString(e), grid);
#else
    for (int ph = 0; ph < N_PHASES; ++ph) { p.ph_lo = ph; p.ph_hi = ph + 1; hipLaunchKernelGGL(hymba_mk, dim3(grid), dim3(512), LDS_BYTES, stream, p); }
#endif
}
```

```cpp
#include <hip/hip_runtime.h>
#include <hip/hip_cooperative_groups.h>
#include <cstdio>
#include <cstdint>
#include <cmath>
namespace cg = cooperative_groups;
namespace pg8 {
#define PG8_LAS __attribute__((address_space(3)))
typedef unsigned short bf16_t;
typedef short bf16x8 __attribute__((ext_vector_type(8)));
typedef float f32x4 __attribute__((ext_vector_type(4)));
typedef unsigned u32x4 __attribute__((ext_vector_type(4)));
constexpr int BM = 256, BK = 64, HALF = 128, HTB = HALF * BK * 2  , STAGE_BYTES = 8 * HTB, NXCD = 8, WGM = 8;

__host__ __device__ __forceinline__ int lds_byte(int r, int c) { const int st = (r >> 4) * 2 + (c >> 5), rr = r & 15, cc = c & 31, ob = rr * 64 + cc * 2; return st * 1024 + (ob ^ (((ob >> 9) & 1) << 5)); }
__host__ __device__ __forceinline__ void stage_rc(int b, int& R, int& C) { const int st = b / 1024, sb = b % 1024, swz = sb ^ (((sb >> 9) & 1) << 5); R = (st >> 1) * 16 + swz / 64; C = (st & 1) * 32 + (swz % 64) / 2; }
__host__ __device__ __forceinline__ int perm32(int rho) { const int n = rho >> 4, i = rho & 15; return 8 * (i >> 2) + 4 * n + (i & 3); }

struct Unit { int pm, pn; };
struct Gemm { const bf16_t* A; const bf16_t* Bt; int M, N, K; };

struct StaticOrder {
    int nM, nN, nwg, G, c;
    __host__ __device__ void init(int M, int N, int G_, int c_) { nM = M / BM; nN = N / BM; nwg = nM * nN; G = G_; c = c_; }
    __host__ __device__ bool next(int i, Unit& u) const {
        const long L = (long)i * G + c; if (L >= nwg) return false;
        int wgid = (int)L; { const int q = nwg / NXCD, r = nwg % NXCD, xcd = wgid % NXCD, off = wgid / NXCD; wgid = (xcd < r ? xcd * (q + 1) : r * (q + 1) + (xcd - r) * q) + off; }
        const int nig = WGM * nN, gid = wgid / nig, fm = gid * WGM, gsz = (nM - fm) < WGM ? (nM - fm) : WGM;
        u.pm = fm + ((wgid % nig) % gsz); u.pn = (wgid % nig) / gsz; return true;
    }
    __device__ __forceinline__ void a_ready(const Unit&) const {}
    __device__ __forceinline__ void done(const Unit&) const {}
};
__device__ __forceinline__ unsigned cvt_pk_bf16(float lo, float hi) { unsigned r; asm volatile("v_cvt_pk_bf16_f32 %0, %1, %2" : "=v"(r) : "v"(lo), "v"(hi)); return r; }
typedef float f32x2 __attribute__((ext_vector_type(2)));
template <class Epi, class Sched, bool ALIGN_EPI = false, bool SP2 = false>
__device__ __forceinline__ void gemm_phase(PG8_LAS unsigned char* lds, const Gemm g, const Sched& S, const Epi& E, const int tid) {
    const int wid = __builtin_amdgcn_readfirstlane(tid >> 6), lane = tid & 63, wr = wid >> 2, wc = wid & 3, fr = lane & 15, fq = lane >> 4;
    const int K = g.K, nt = K / BK;
    unsigned voffA[2], voffB[2];
#pragma unroll
    for (int i = 0; i < 2; ++i) { int R, C; stage_rc(tid * 16 + i * 8192, R, C); const int Rb = Epi::PERM ? ((R & ~31) + perm32(R & 31)) : R;
        voffA[i] = (unsigned)(R * K + C) * 2u; voffB[i] = (unsigned)(Rb * K + C) * 2u; }
    const size_t kstep = (size_t)(BK * 2);
    const size_t hstep = (size_t)HALF * K * 2;
    const size_t tstep = 2 * hstep;
    const unsigned ldsw = (unsigned)wid * 1024u;
    const int aoff = lds_byte(wr * 64 + fr, fq * 8), boff = lds_byte(wc * 32 + fr, fq * 8);
#define PG8_SA(b, h) (((b) * 2 + (h)) * HTB)
#define PG8_SB(b, h) ((4 + (b) * 2 + (h)) * HTB)
#define PG8_STAGE(bufoff, gbase, voff) do { _Pragma("unroll") for (int _i = 0; _i < 2; ++_i) \
        __builtin_amdgcn_global_load_lds((const unsigned*)((const char*)(gbase) + (voff)[_i]), (PG8_LAS unsigned*)(lds + (bufoff) + ldsw + _i * 8192), 16, 0, 0); } while (0)
#define PG8_LDA(dst, b, h) do { _Pragma("unroll") for (int m = 0; m < 4; ++m) _Pragma("unroll") for (int k = 0; k < 2; ++k) dst[m][k] = *(const PG8_LAS bf16x8*)(lds + PG8_SA(b, h) + aoff + m * 2048 + k * 1024); } while (0)
#define PG8_LDB(dst, b, h) do { _Pragma("unroll") for (int n = 0; n < 2; ++n) _Pragma("unroll") for (int k = 0; k < 2; ++k) dst[n][k] = *(const PG8_LAS bf16x8*)(lds + PG8_SB(b, h) + boff + n * 2048 + k * 1024); } while (0)
#define PG8_MMA(ai, bj, At, Bt) do { __builtin_amdgcn_s_setprio(1); _Pragma("unroll") for (int m = 0; m < 4; ++m) _Pragma("unroll") for (int n = 0; n < 2; ++n) _Pragma("unroll") for (int k = 0; k < 2; ++k) \
        acc[ai][bj][m][n] = __builtin_amdgcn_mfma_f32_16x16x32_bf16(Bt[n][k], At[m][k], acc[ai][bj][m][n], 0, 0, 0); __builtin_amdgcn_s_setprio(0); } while (0)
#define PG8_WAIT_V(n) asm volatile("s_waitcnt vmcnt(" #n ")" ::: "memory")
#define PG8_WAIT_L(n) asm volatile("s_waitcnt lgkmcnt(" #n ")" ::: "memory")
#define PG8_BAR __builtin_amdgcn_s_barrier()
#define PG8_SCHED __builtin_amdgcn_sched_barrier(0)
    Unit cur, nxt; int ui = 0;
    if (!S.next(0, cur)) return;
    f32x4 acc[2][2][4][2];
#pragma unroll
    for (int a = 0; a < 2; ++a)
#pragma unroll
        for (int b = 0; b < 2; ++b)
#pragma unroll
            for (int m = 0; m < 4; ++m)
#pragma unroll
                for (int n = 0; n < 2; ++n) acc[a][b][m][n] = (f32x4){0.f, 0.f, 0.f, 0.f};
    bf16x8 At[4][2], B0[2][2], B1[2][2];
    const char* cA = (const char*)g.A + (size_t)cur.pm * tstep; const char* cB = (const char*)g.Bt + (size_t)cur.pn * tstep;
    S.a_ready(cur);
    if constexpr (SP2) {
        PG8_STAGE(PG8_SB(0, 0), cB, voffB); PG8_STAGE(PG8_SB(0, 1), cB + hstep, voffB); PG8_STAGE(PG8_SA(0, 0), cA, voffA); PG8_STAGE(PG8_SA(0, 1), cA + hstep, voffA);
        if (wr == 1) PG8_BAR;
        PG8_WAIT_V(2); PG8_BAR;
        PG8_STAGE(PG8_SB(1, 0), cB + kstep, voffB); PG8_STAGE(PG8_SA(1, 0), cA + kstep, voffA); PG8_STAGE(PG8_SB(1, 1), cB + hstep + kstep, voffB);
        PG8_WAIT_V(6); PG8_BAR;
    } else {
        PG8_STAGE(PG8_SB(0, 0), cB, voffB); PG8_STAGE(PG8_SA(0, 0), cA, voffA); PG8_STAGE(PG8_SB(0, 1), cB + hstep, voffB); PG8_STAGE(PG8_SA(0, 1), cA + hstep, voffA);
        if (wr == 1) PG8_BAR;
        PG8_WAIT_V(4); PG8_BAR;
        PG8_STAGE(PG8_SB(1, 0), cB + kstep, voffB); PG8_STAGE(PG8_SA(1, 0), cA + kstep, voffA); PG8_STAGE(PG8_SB(1, 1), cB + hstep + kstep, voffB);
        PG8_WAIT_V(6); PG8_BAR;
    }
    for (;;) {
        const bool has_next = S.next(ui + 1, nxt);
        const char* nA = has_next ? (const char*)g.A + (size_t)nxt.pm * tstep : cA; const char* nB = has_next ? (const char*)g.Bt + (size_t)nxt.pn * tstep : cB;
        for (int t = 0; t < nt; t += 2) {
            const bool last = (t == nt - 2);
            const char* a1 = cA + (size_t)(t + 1) * kstep;
            const char* a2 = last ? nA : cA + (size_t)(t + 2) * kstep; const char* b2 = last ? nB : cB + (size_t)(t + 2) * kstep;
            const char* a3 = a2 + kstep; const char* b3 = b2 + kstep;
            if (last && has_next) S.a_ready(nxt);
            if constexpr (Epi::KSCALE) E.kscale(acc, t, cur, wr, fr);
            if constexpr (SP2) {
            PG8_LDB(B0, 0, 0); PG8_LDB(B1, 0, 1); PG8_SCHED; PG8_LDA(At, 0, 0); PG8_STAGE(PG8_SA(1, 1), a1 + hstep, voffA);
            PG8_WAIT_V(8); PG8_WAIT_L(0); PG8_BAR; PG8_MMA(0, 0, At, B0); PG8_MMA(0, 1, At, B1); PG8_BAR; PG8_SCHED;
            PG8_LDA(At, 0, 1); PG8_STAGE(PG8_SB(0, 0), b2, voffB); PG8_STAGE(PG8_SB(0, 1), b2 + hstep, voffB); PG8_STAGE(PG8_SA(0, 0), a2, voffA);
            PG8_WAIT_V(8); PG8_WAIT_L(0); PG8_BAR; PG8_MMA(1, 0, At, B0); PG8_MMA(1, 1, At, B1); PG8_BAR; PG8_SCHED;
            PG8_LDB(B0, 1, 0); PG8_LDB(B1, 1, 1); PG8_SCHED; PG8_LDA(At, 1, 0); PG8_STAGE(PG8_SA(0, 1), a2 + hstep, voffA);
            PG8_WAIT_V(8); PG8_WAIT_L(0); PG8_BAR; PG8_MMA(0, 0, At, B0); PG8_MMA(0, 1, At, B1); PG8_BAR; PG8_SCHED;
            PG8_LDA(At, 1, 1); PG8_STAGE(PG8_SB(1, 0), b3, voffB); PG8_STAGE(PG8_SB(1, 1), b3 + hstep, voffB); PG8_STAGE(PG8_SA(1, 0), a3, voffA);
            PG8_WAIT_V(8); PG8_WAIT_L(0); PG8_BAR; PG8_MMA(1, 0, At, B0); PG8_MMA(1, 1, At, B1); PG8_BAR; PG8_SCHED;
            } else {
            PG8_LDB(B0, 0, 0); PG8_SCHED; PG8_LDA(At, 0, 0); PG8_STAGE(PG8_SA(1, 1), a1 + hstep, voffA);
            PG8_WAIT_L(8); PG8_BAR; PG8_WAIT_L(0); PG8_MMA(0, 0, At, B0); PG8_BAR; PG8_SCHED;
            PG8_LDB(B1, 0, 1); PG8_STAGE(PG8_SB(0, 0), b2, voffB);
            PG8_BAR; PG8_WAIT_L(0); PG8_MMA(0, 1, At, B1); PG8_BAR;
            PG8_LDA(At, 0, 1); PG8_STAGE(PG8_SA(0, 0), a2, voffA);
            PG8_BAR; PG8_WAIT_L(0); PG8_MMA(1, 0, At, B0); PG8_BAR; PG8_SCHED;
            PG8_STAGE(PG8_SB(0, 1), b2 + hstep, voffB);
            PG8_WAIT_V(6); PG8_BAR; PG8_MMA(1, 1, At, B1); PG8_BAR;
            PG8_LDB(B0, 1, 0); PG8_SCHED; PG8_LDA(At, 1, 0); PG8_STAGE(PG8_SA(0, 1), a2 + hstep, voffA);
            PG8_WAIT_L(8); PG8_BAR; PG8_WAIT_L(0); PG8_MMA(0, 0, At, B0); PG8_BAR; PG8_SCHED;
            PG8_LDB(B1, 1, 1); PG8_STAGE(PG8_SB(1, 0), b3, voffB);
            PG8_BAR; PG8_WAIT_L(0); PG8_MMA(0, 1, At, B1); PG8_BAR;
            PG8_LDA(At, 1, 1); PG8_STAGE(PG8_SA(1, 0), a3, voffA);
            PG8_BAR; PG8_WAIT_L(0); PG8_MMA(1, 0, At, B0); PG8_BAR; PG8_SCHED;
            PG8_STAGE(PG8_SB(1, 1), b3 + hstep, voffB);
            PG8_WAIT_V(6); PG8_BAR; PG8_MMA(1, 1, At, B1); PG8_BAR;
            }
        }
        if constexpr (ALIGN_EPI) { if (wr == 0) PG8_BAR; }
        if constexpr (!Epi::AFTER_DRAIN) { E(acc, cur, wr, wc, fr, fq); S.done(cur); }
        if (!has_next) break;
#pragma unroll
        for (int a = 0; a < 2; ++a)
#pragma unroll
            for (int b = 0; b < 2; ++b)
#pragma unroll
                for (int m = 0; m < 4; ++m)
#pragma unroll
                    for (int n = 0; n < 2; ++n) acc[a][b][m][n] = (f32x4){0.f, 0.f, 0.f, 0.f};
        cur = nxt; cA = nA; cB = nB; ++ui;
        if constexpr (ALIGN_EPI) { if (wr == 1) PG8_BAR; }
    }
    PG8_WAIT_V(0);
    if constexpr (!ALIGN_EPI) { if (wr == 0) PG8_BAR; }
    PG8_BAR;
    if constexpr (Epi::AFTER_DRAIN) { E.fused(acc, cur, wr, wc, fr, fq, lds, wid, lane); S.done(cur); }
#undef PG8_SA
#undef PG8_SB
#undef PG8_STAGE
#undef PG8_LDA
#undef PG8_LDB
#undef PG8_MMA
#undef PG8_WAIT_V
#undef PG8_WAIT_L
#undef PG8_BAR
#undef PG8_SCHED
}
}
#define LAS __attribute__((address_space(3)))
typedef unsigned short u16;
typedef short bf16x8 __attribute__((ext_vector_type(8)));
typedef float f32x4 __attribute__((ext_vector_type(4)));
typedef unsigned u32x4 __attribute__((ext_vector_type(4)));
typedef unsigned u32x2 __attribute__((ext_vector_type(2)));
typedef LAS unsigned char* ldsp;

constexpr int DM = 1024, NL = 2;
constexpr int MP = 4 * 8192, MS = 128 * 4, M = MP + MS;
constexpr int NPROJ = 3328, NIN = 3344, NMIX = 1536, DFF = 2816, NGU = 5632;
constexpr int C_K = 512, C_V = 640, C_Z = 768, C_X = 1792, C_B = 2816, C_C = 3072;
constexpr float EPS = 1e-6f;
constexpr int NPOS = 8196;

constexpr size_t WS_WIN = 0;
constexpr size_t SZ_WIN = (size_t)NIN * DM * 2;
constexpr size_t WS_WOUT = WS_WIN + NL * SZ_WIN;
constexpr size_t SZ_WOUT = (size_t)DM * NMIX * 2;
constexpr size_t WS_WGU = WS_WOUT + NL * SZ_WOUT;
constexpr size_t SZ_WGU = (size_t)NGU * DM * 2;
constexpr size_t WS_WDN = WS_WGU + NL * SZ_WGU;
constexpr size_t SZ_WDN = (size_t)DM * DFF * 2;
constexpr size_t WS_ROPE = WS_WDN + NL * SZ_WDN;
constexpr size_t SZ_ROPE = (size_t)NPOS * 32 * 4;
constexpr size_t WS_XB = WS_ROPE + 2 * SZ_ROPE;
constexpr size_t WS_SSP = WS_XB + (size_t)M * DM * 2;
constexpr size_t WS_PROJ = WS_SSP + (size_t)M * 16 * 4;
constexpr size_t WS_YMIX = WS_PROJ + (size_t)M * NPROJ * 2;
constexpr size_t WS_DT = WS_YMIX + (size_t)M * NMIX * 2;
constexpr size_t WS_CD = WS_DT + (size_t)MP * 16 * 4;
constexpr size_t WS_ST = WS_CD + (size_t)4 * 64 * 16 * 4;
constexpr size_t WS_END = WS_ST + (size_t)4 * 64 * 16 * 64 * 128 * 2;
constexpr size_t WS_RS = WS_END;
constexpr size_t WS_BAR = WS_RS + (size_t)MP * 2 * 4, SZ_BAR = 16384;
static_assert(WS_BAR + SZ_BAR <= (size_t)4 * MP * DM * 4 && WS_BAR % 256 == 0, "workspace");
static_assert(WS_XB % 256 == 0 && WS_SSP % 256 == 0 && WS_PROJ % 256 == 0 && WS_YMIX % 256 == 0 && WS_DT % 256 == 0 && WS_ST % 256 == 0 && WS_ROPE % 256 == 0, "align");

constexpr size_t O_Y = 0;
constexpr size_t O_KP = (size_t)M * DM;
constexpr size_t O_VP = O_KP + (size_t)2 * 4 * 128 * 128;
constexpr size_t O_CP = O_VP + (size_t)2 * 4 * 128 * 128;
constexpr size_t O_HP = O_CP + (size_t)2 * 4 * 3 * 1536;
constexpr size_t O_KS = O_HP + (size_t)2 * 4 * 16 * 64 * 128;
constexpr size_t O_VS = O_KS + (size_t)2 * 128 * 128 * 128;
constexpr size_t O_CS = O_VS + (size_t)2 * 128 * 128 * 128;
constexpr size_t O_HS = O_CS + (size_t)2 * 128 * 3 * 1536;
constexpr size_t O_END = O_HS + (size_t)2 * 128 * 16 * 64 * 128;

constexpr int LDS_BYTES = 147456;

enum { I_XP = 0, I_XS, I_CK, I_CV, I_SCONV, I_SSSM, I_NMIX, I_WIN, I_QN, I_KN, I_SINK, I_CW, I_CB, I_DTB, I_ALOG, I_DSK, I_SNORM, I_WOUT, I_NFFN, I_WGU, I_WDN };

struct Params { const float* in[21]; float* out; unsigned char* ws; int ph_lo, ph_hi; };

typedef float f32x2_t __attribute__((ext_vector_type(2))); typedef __bf16 bf16x2_t __attribute__((ext_vector_type(2)));
__device__ __forceinline__ unsigned pk2(float lo, float hi) { f32x2_t v = {lo, hi}; bf16x2_t b = __builtin_convertvector(v, bf16x2_t); return __builtin_bit_cast(unsigned, b); }
__device__ __forceinline__ unsigned f2bf(float f) { return pk2(f, 0.f) & 0xffffu; }
__device__ __forceinline__ float bf2f(unsigned h) { return __builtin_bit_cast(float, h << 16); }
__device__ __forceinline__ float bflo(unsigned w) { return __builtin_bit_cast(float, w << 16); }
__device__ __forceinline__ float bfhi(unsigned w) { return __builtin_bit_cast(float, w & 0xffff0000u); }
__device__ __forceinline__ float silu_f(float x) { return x * __builtin_amdgcn_rcpf(1.f + __expf(-x)); }
__device__ __forceinline__ float softplus_f(float x) { return x > 15.f ? x : log1pf(__expf(x)); }
__device__ __forceinline__ float wave_sum(float v) {
#pragma unroll
    for (int o = 1; o < 64; o <<= 1) v += __shfl_xor(v, o);
    return v;
}
__device__ __forceinline__ float wave_max(float v) {
#pragma unroll
    for (int o = 1; o < 64; o <<= 1) v = fmaxf(v, __shfl_xor(v, o));
    return v;
}
__device__ __forceinline__ float wave_incl_scan(float v, int lane) {
#pragma unroll
    for (int off = 1; off < 64; off <<= 1) { const float t = __shfl_up(v, off); if (lane >= off) v += t; }
    return v;
}
__device__ __forceinline__ bf16x8 mk8(u32x2 lo, u32x2 hi) { u32x4 w; w.x = lo.x; w.y = lo.y; w.z = hi.x; w.w = hi.y; return __builtin_bit_cast(bf16x8, w); }
__device__ __forceinline__ bf16x8 lds16(ldsp p) { return __builtin_bit_cast(bf16x8, *(LAS u32x4*)p); }
__device__ __forceinline__ bf16x8 lds8x2(ldsp p0, ldsp p1) { return mk8(*(LAS u32x2*)p0, *(LAS u32x2*)p1); }
__device__ __forceinline__ f32x4 mfma16(bf16x8 a, bf16x8 b, f32x4 c) { return __builtin_amdgcn_mfma_f32_16x16x32_bf16(a, b, c, 0, 0, 0); }
#define LDS_WAIT() asm volatile("s_waitcnt lgkmcnt(0)" ::: "memory")

__device__ __forceinline__ float rstd_row(const float* ssp, int row) {
    const f32x4* p = (const f32x4*)(ssp + (size_t)row * 16);
    const f32x4 a = p[0], b = p[1], c = p[2], d = p[3];
    const float s = (((a.x + a.y) + (a.z + a.w)) + ((b.x + b.y) + (b.z + b.w))) + (((c.x + c.y) + (c.z + c.w)) + ((d.x + d.y) + (d.z + d.w)));
    return rsqrtf(s * (1.f / 1024.f) + EPS);
}

struct EpiProj {
    static constexpr bool PERM = true, AFTER_DRAIN = false, KSCALE = false;
    u16* O; const float* ssp; ldsp rsl;
    __device__ __forceinline__ void operator()(const pg8::f32x4 (&acc)[2][2][4][2], const pg8::Unit& u, int wr, int wc, int fr, int fq) const {
        const int row0 = u.pm * 256 + wr * 64 + fr, col0 = u.pn * 256 + wc * 32 + 8 * fq;
        { const int t = wc * 64 + fq * 16 + fr; if (wr == 0) ((LAS float*)rsl)[t] = rstd_row(ssp, u.pm * 256 + t);
          asm volatile("s_waitcnt lgkmcnt(0)" ::: "memory"); __builtin_amdgcn_s_barrier(); asm volatile("" ::: "memory"); }
#pragma unroll
        for (int ai = 0; ai < 2; ++ai)
#pragma unroll
            for (int m = 0; m < 4; ++m) {
                const int row = row0 + ai * 128 + m * 16; const float rs = ((LAS float*)rsl)[wr * 64 + fr + ai * 128 + m * 16]; u16* rowp = O + (size_t)row * NPROJ + col0;
#pragma unroll
                for (int bj = 0; bj < 2; ++bj) {
                    const f32x4 v0 = acc[ai][bj][m][0] * rs, v1 = acc[ai][bj][m][1] * rs; u32x4 w;
                    w.x = pg8::cvt_pk_bf16(v0[0], v0[1]); w.y = pg8::cvt_pk_bf16(v0[2], v0[3]); w.z = pg8::cvt_pk_bf16(v1[0], v1[1]); w.w = pg8::cvt_pk_bf16(v1[2], v1[3]);
                    *(u32x4*)(rowp + bj * 128) = w; }
            }
    }
};
struct EpiSwiglu {
    static constexpr bool PERM = true, AFTER_DRAIN = false, KSCALE = false;
    u16* O; const float* ssp; ldsp rsl;
    __device__ __forceinline__ void operator()(const pg8::f32x4 (&acc)[2][2][4][2], const pg8::Unit& u, int wr, int wc, int fr, int fq) const {
        const int row0 = u.pm * 256 + wr * 64 + fr, col0 = u.pn * 128 + wc * 32 + 8 * fq;
        { const int t = wc * 64 + fq * 16 + fr; if (wr == 0) ((LAS float*)rsl)[t] = rstd_row(ssp, u.pm * 256 + t);
          asm volatile("s_waitcnt lgkmcnt(0)" ::: "memory"); __builtin_amdgcn_s_barrier(); asm volatile("" ::: "memory"); }
#pragma unroll
        for (int ai = 0; ai < 2; ++ai)
#pragma unroll
            for (int m = 0; m < 4; ++m) {
                const int row = row0 + ai * 128 + m * 16; const float rs = ((LAS float*)rsl)[wr * 64 + fr + ai * 128 + m * 16];
                float h[8];
#pragma unroll
                for (int n = 0; n < 2; ++n)
#pragma unroll
                    for (int j = 0; j < 4; ++j) { const float g = acc[ai][0][m][n][j] * rs, up = acc[ai][1][m][n][j] * rs; h[n * 4 + j] = silu_f(g) * up; }
                u32x4 w; w.x = pg8::cvt_pk_bf16(h[0], h[1]); w.y = pg8::cvt_pk_bf16(h[2], h[3]); w.z = pg8::cvt_pk_bf16(h[4], h[5]); w.w = pg8::cvt_pk_bf16(h[6], h[7]);
                *(u32x4*)(O + (size_t)row * DFF + col0) = w;
            }
    }
};
template <bool KS> struct EpiResT {
    static constexpr bool PERM = false, AFTER_DRAIN = false, KSCALE = KS;
    u16* xb; float* outf; float* ssp; const float* rs;
    __device__ __forceinline__ void kscale(pg8::f32x4 (&acc)[2][2][4][2], int t, const pg8::Unit& u, int wr, int fr) const {
        if (t != 8 && t != 16) return;
#pragma unroll
        for (int ai = 0; ai < 2; ++ai)
#pragma unroll
            for (int m = 0; m < 4; ++m) {
                const int row = u.pm * 256 + wr * 64 + fr + ai * 128 + m * 16; const float s0 = rs[2 * row], s1 = rs[2 * row + 1];
                const float f = t == 8 ? s0 * __builtin_amdgcn_rcpf(s1) : s1;
#pragma unroll
                for (int bj = 0; bj < 2; ++bj)
#pragma unroll
                    for (int n = 0; n < 2; ++n) acc[ai][bj][m][n] = acc[ai][bj][m][n] * f;
            }
    }
    __device__ __forceinline__ void operator()(const pg8::f32x4 (&acc)[2][2][4][2], const pg8::Unit& u, int wr, int wc, int fr, int fq) const {
        const int row0 = u.pm * 256 + wr * 64 + fr, col0 = u.pn * 256 + wc * 32 + 4 * fq;
#pragma unroll
        for (int ai = 0; ai < 2; ++ai) {
            u32x2 rw[4][2][2];
#pragma unroll
            for (int m = 0; m < 4; ++m)
#pragma unroll
                for (int bj = 0; bj < 2; ++bj)
#pragma unroll
                    for (int n = 0; n < 2; ++n) rw[m][bj][n] = *(const u32x2*)(xb + (size_t)(row0 + ai * 128 + m * 16) * DM + col0 + bj * 128 + n * 16);
#pragma unroll
            for (int m = 0; m < 4; ++m) {
                const int row = row0 + ai * 128 + m * 16;
                u16* xp = xb + (size_t)row * DM + col0; float ss = 0.f;
#pragma unroll
                for (int bj = 0; bj < 2; ++bj)
#pragma unroll
                    for (int n = 0; n < 2; ++n) {
                        const u32x2 w0 = rw[m][bj][n]; const f32x4 r = {bflo(w0.x), bfhi(w0.x), bflo(w0.y), bfhi(w0.y)}; const f32x4 v = acc[ai][bj][m][n] + r;
                        if (outf) *(f32x4*)(outf + (size_t)row * DM + col0 + bj * 128 + n * 16) = v;
                        u32x2 w; w.x = pg8::cvt_pk_bf16(v[0], v[1]); w.y = pg8::cvt_pk_bf16(v[2], v[3]);
                        *(u32x2*)(xp + bj * 128 + n * 16) = w; ss += (v[0] * v[0] + v[1] * v[1]) + (v[2] * v[2] + v[3] * v[3]); }
                ss += __shfl_xor(ss, 16); ss += __shfl_xor(ss, 32);
                if (fq == 0) ssp[(size_t)row * 16 + u.pn * 4 + wc] = ss;
            }
        }
    }
};
struct Ctx {
    const float* in[21]; float* out; unsigned char* ws;
    u16 *WinT, *WoutT, *WguT, *WdnT; float *COS, *SIN; u16* XB; float* SSP; u16* PROJ; u16* YMIX; float* DT; float* CD; u16* ST; float* RS;
};

__device__ __forceinline__ void tr_item(const float* __restrict__ W, int K, int N, const float* __restrict__ gk, u16* WT, int perm, LAS float* scr, int item, int lane) {
    const int nblk = (N + 31) >> 5, kb = item / nblk, nb = item - kb * nblk, k0 = 64 * kb, n0 = 32 * nb;
    const int kd0 = perm == 2 ? (k0 < 512 ? k0 + 1024 : k0 - 512) : k0;
    const int nn = n0 + (lane & 31);
    float wv[32];
#pragma unroll
    for (int i = 0; i < 32; ++i) { const int kk = 2 * i + (lane >> 5); wv[i] = (nn < N) ? W[(size_t)(k0 + kk) * N + nn] : 0.f; }
#pragma unroll
    for (int i = 0; i < 32; ++i) { const int kk = 2 * i + (lane >> 5); float v = wv[i]; if (gk) { if (perm == 2) { if (k0 >= 512) v *= gk[k0 + kk - 512]; } else v *= gk[k0 + kk]; } scr[kk * 33 + (lane & 31)] = v; }
    LDS_WAIT(); asm volatile("" ::: "memory");
    const int c = lane & 7;
#pragma unroll
    for (int j = 0; j < 4; ++j) {
        const int nl = (lane >> 3) + 8 * j, n = n0 + nl;
        if (n < N) {
            int dr = n; if (perm == 1) { const int up = n >= DFF, f = up ? n - DFF : n; dr = (f >> 7) * 256 + up * 128 + (f & 127); }
            const LAS float* s = scr + (8 * c) * 33 + nl;
            u32x4 o; o.x = pk2(s[0 * 33], s[1 * 33]); o.y = pk2(s[2 * 33], s[3 * 33]); o.z = pk2(s[4 * 33], s[5 * 33]); o.w = pk2(s[6 * 33], s[7 * 33]);
            *(u32x4*)(WT + (size_t)dr * K + kd0 + 8 * c) = o; }
    }
    LDS_WAIT(); asm volatile("" ::: "memory");
}
constexpr int I_IN = (DM / 64) * ((NIN + 31) / 32), I_OUT = (NMIX / 64) * (DM / 32), I_GU = (DM / 64) * (NGU / 32), I_DN = (DFF / 64) * (DM / 32), I_L = I_IN + I_OUT + I_GU + I_DN;
__device__ __forceinline__ void tr_layer_item(const Ctx& X, int l, int r, LAS float* scr, int lane) {
    if (r < I_IN) { tr_item(X.in[I_WIN] + (size_t)l * DM * NIN, DM, NIN, X.in[I_NMIX] + l * DM, X.WinT + (size_t)l * NIN * DM, 0, scr, r, lane); return; } r -= I_IN;
    if (r < I_OUT) { tr_item(X.in[I_WOUT] + (size_t)l * NMIX * DM, NMIX, DM, X.in[I_SNORM] + l * 1024, X.WoutT + (size_t)l * DM * NMIX, 2, scr, r, lane); return; } r -= I_OUT;
    if (r < I_GU) { tr_item(X.in[I_WGU] + (size_t)l * DM * NGU, DM, NGU, X.in[I_NFFN] + l * DM, X.WguT + (size_t)l * NGU * DM, 1, scr, r, lane); return; } r -= I_GU;
    tr_item(X.in[I_WDN] + (size_t)l * DFF * DM, DFF, DM, nullptr, X.WdnT + (size_t)l * DM * DFF, 0, scr, r, lane);
}
__device__ __forceinline__ void idle_weight_items(const Ctx& X, ldsp L, int stage, int nwg, int G, int bx, int wid, int lane) {
    const int nround = (nwg + G - 1) / G, first_idle = nwg - (nround - 1) * G;
    LAS float* scr = (LAS float*)(L + wid * 16384);
    int nw = (G - first_idle) * 8, wi = (bx - first_idle) * 8 + wid;
    if (first_idle >= G) { nw = G * 8; wi = bx * 8 + wid; }
    else if (bx < first_idle) return;
    if (stage == 0) { for (int r = I_IN + wi; r < I_L; r += nw) tr_layer_item(X, 0, r, scr, lane); }
    else { for (int r = wi; r < I_L; r += nw) tr_layer_item(X, 1, r, scr, lane); }
}
__device__ __forceinline__ void phase_prologue(const Ctx& X, ldsp L, int tid, int wid, int lane) {
    LAS float* scr = (LAS float*)(L + wid * 16384);
    const int gw = blockIdx.x * 8 + wid, NGW = gridDim.x * 8;
    for (int it = gw; it < I_IN; it += NGW) tr_layer_item(X, 0, it, scr, lane);
    for (int rb = gw * 4; rb < M; rb += NGW * 4) {
        f32x4 v[4][4];
#pragma unroll
        for (int rr = 0; rr < 4; ++rr) { const int row = rb + rr; const float* xr = row < MP ? X.in[I_XP] + (size_t)row * DM : X.in[I_XS] + (size_t)(row - MP) * DM;
#pragma unroll
            for (int j = 0; j < 4; ++j) v[rr][j] = ((const f32x4*)xr)[lane + 64 * j]; }
#pragma unroll
        for (int rr = 0; rr < 4; ++rr) { const int row = rb + rr; float ss = 0.f;
#pragma unroll
            for (int j = 0; j < 4; ++j) { const f32x4 w4 = v[rr][j]; ss += (w4.x * w4.x + w4.y * w4.y) + (w4.z * w4.z + w4.w * w4.w);
                u32x2 w; w.x = pk2(w4.x, w4.y); w.y = pk2(w4.z, w4.w); ((u32x2*)(X.XB + (size_t)row * DM))[lane + 64 * j] = w; }
            ss = wave_sum(ss);
            if (lane < 16) X.SSP[(size_t)row * 16 + lane] = lane == 0 ? ss : 0.f; }
    }
    for (int idx = blockIdx.x * 512 + tid; idx < NPOS * 32; idx += gridDim.x * 512) {
        const int pi = idx >> 5, j = idx & 31; const float pos = pi < 8192 ? (float)pi : (float)(16384 + pi - 8192);
        const float inv = powf(10000.f, -(float)j * (1.f / 32.f));
        float sv, cv; sincosf(pos * inv, &sv, &cv); X.COS[idx] = cv; X.SIN[idx] = sv;
    }
}

struct ConvCol { float w0, w1, w2, w3, bias, a, b, c; const u16* p; };
__device__ __forceinline__ void conv_init(ConvCol& cc, const u16* proj, int row, bool havePrev, int xcol, const float* cw, const float* cb) {
    cc.w0 = cw[xcol]; cc.w1 = cw[1536 + xcol]; cc.w2 = cw[2 * 1536 + xcol]; cc.w3 = cw[3 * 1536 + xcol]; cc.bias = cb[xcol];
    cc.p = proj + (size_t)row * NPROJ + C_X + xcol;
    cc.a = havePrev ? bf2f(cc.p[-3 * NPROJ]) : 0.f; cc.b = havePrev ? bf2f(cc.p[-2 * NPROJ]) : 0.f; cc.c = havePrev ? bf2f(cc.p[-1 * NPROJ]) : 0.f;
}
__device__ __forceinline__ float conv_step(ConvCol& cc) {
    const float d = bf2f(*cc.p); cc.p += NPROJ;
    const float v = fmaf(cc.a, cc.w0, fmaf(cc.b, cc.w1, fmaf(cc.c, cc.w2, fmaf(d, cc.w3, cc.bias))));
    cc.a = cc.b; cc.b = cc.c; cc.c = d; return silu_f(v);
}

struct ConvW { float w0, w1, w2, w3, bias; };
__device__ __forceinline__ ConvW conv_w(const float* cw, const float* cb, int xcol) { ConvW w; w.w0 = cw[xcol]; w.w1 = cw[1536 + xcol]; w.w2 = cw[2 * 1536 + xcol]; w.w3 = cw[3 * 1536 + xcol]; w.bias = cb[xcol]; return w; }
template <int NS> __device__ __forceinline__ void conv_load(float (&raw)[NS + 3], const u16* proj, int row, bool havePrev, int xcol) {
    const u16* p = proj + (size_t)row * NPROJ + C_X + xcol;
#pragma unroll
    for (int k = 0; k < NS + 3; ++k) { unsigned v = 0u; if (k >= 3 || havePrev) v = p[(k - 3) * NPROJ]; raw[k] = bf2f(v); }
}
__device__ __forceinline__ float conv_tap(const ConvW& w, float a, float b, float c, float d) { return silu_f(fmaf(a, w.w0, fmaf(b, w.w1, fmaf(c, w.w2, fmaf(d, w.w3, w.bias))))); }

struct ConvW4 { f32x4 w0, w1, w2, w3, bias; };
__device__ __forceinline__ ConvW4 conv4_w(const float* cw, const float* cb, int xcol0) { ConvW4 w; w.w0 = *(const f32x4*)(cw + xcol0); w.w1 = *(const f32x4*)(cw + 1536 + xcol0); w.w2 = *(const f32x4*)(cw + 2 * 1536 + xcol0); w.w3 = *(const f32x4*)(cw + 3 * 1536 + xcol0); w.bias = *(const f32x4*)(cb + xcol0); return w; }
template <int NT> __device__ __forceinline__ void conv4_load(float (&raw)[NT + 3][4], const u16* proj, int row, bool havePrev, int xcol0) {
    const u16* p = proj + (size_t)row * NPROJ + C_X + xcol0;
#pragma unroll
    for (int k = 0; k < NT + 3; ++k) { u32x2 v = {0u, 0u}; if (k >= 3 || havePrev) v = *(const u32x2*)(p + (k - 3) * NPROJ); raw[k][0] = bflo(v.x); raw[k][1] = bfhi(v.x); raw[k][2] = bflo(v.y); raw[k][3] = bfhi(v.y); }
}
#define CONV4_TAP(w, raw, k, e) silu_f(fmaf(raw[(k)][e], w.w0[e], fmaf(raw[(k) + 1][e], w.w1[e], fmaf(raw[(k) + 2][e], w.w2[e], fmaf(raw[(k) + 3][e], w.w3[e], w.bias[e])))))
__device__ __forceinline__ void acum_scan(LAS float* DTL, LAS float* ACL, const float* alog, int wid, int lane) {
#pragma unroll
    for (int hh = 0; hh < 2; ++hh) {
        const int h = 2 * wid + hh; const float A = -expf(alog[h]);
        float v0 = DTL[h * 128 + lane] * A, v1 = DTL[h * 128 + 64 + lane] * A;
        v0 = wave_incl_scan(v0, lane); v1 = wave_incl_scan(v1, lane); v1 += __shfl(v0, 63);
        ACL[h * 128 + lane] = v0; ACL[h * 128 + 64 + lane] = v1;
    }
}

constexpr int XTP = 132;
__device__ __forceinline__ void ssd_states_unit(const Ctx& X, int l, int b, int c, ldsp L, int tid, int wid, int lane) {
    LAS float* DTL = (LAS float*)L; LAS float* ACL = (LAS float*)(L + 8192);
    LAS u16* BT = (LAS u16*)(L + 16384);
    LAS u16* XT = (LAS u16*)(L + 16384 + 33792);
    const int i = lane & 15, g = lane >> 4, r0 = b * 8192 + c * 128;
    const float* cw = X.in[I_CW] + (size_t)l * 4 * 1536; const float* cb = X.in[I_CB] + (size_t)l * 1536;
    {
        const u16* ap = X.XB + (size_t)(r0 + 16 * wid + i) * DM + 8 * g; const u16* bp = X.WinT + (size_t)l * NIN * DM + (size_t)(NPROJ + i) * DM + 8 * g;
        f32x4 acc = {0.f, 0.f, 0.f, 0.f};
#pragma unroll 16
        for (int kk = 0; kk < 32; ++kk) { const bf16x8 a = *(const bf16x8*)(ap + 32 * kk), w = *(const bf16x8*)(bp + 32 * kk); acc = mfma16(a, w, acc); }
        const float bias = X.in[I_DTB][l * 16 + i];
#pragma unroll
        for (int j = 0; j < 4; ++j) { const int tok = 16 * wid + 4 * g + j; const float dt = softplus_f(acc[j] * rstd_row(X.SSP, r0 + tok) + bias);
            DTL[i * 128 + tok] = dt; X.DT[(size_t)(r0 + tok) * 16 + i] = dt; }
    }
    __syncthreads();
    acum_scan(DTL, ACL, X.in[I_ALOG] + l * 16, wid, lane);
    __syncthreads();
    if (tid < 16) X.CD[(b * 64 + c) * 16 + tid] = __expf(ACL[tid * 128 + 127]);
    LAS float* WSL = (LAS float*)(L + 16384 + 33792 + 67584);
#pragma unroll
    for (int e = 0; e < 4; ++e) { const int idx = tid * 4 + e, h = idx >> 7; WSL[idx] = DTL[idx] * __expf(ACL[h * 128 + 127] - ACL[idx]); }
    __syncthreads();
    for (int hq = 0; hq < 4; ++hq) {
        const int grp = hq >> 1;
        if ((hq & 1) == 0) {
            const int cg = lane & 31, tok0 = 16 * wid + 8 * (lane >> 5), xcol0 = 1024 + 128 * grp + 4 * cg; const ConvW4 w = conv4_w(cw, cb, xcol0);
            float raw[11][4]; conv4_load<8>(raw, X.PROJ, r0 + tok0, !(c == 0 && tok0 == 0), xcol0);
#pragma unroll
            for (int e = 0; e < 4; ++e)
#pragma unroll
                for (int kq = 0; kq < 2; ++kq) { u32x2 pw; pw.x = pk2(CONV4_TAP(w, raw, 4 * kq, e), CONV4_TAP(w, raw, 4 * kq + 1, e)); pw.y = pk2(CONV4_TAP(w, raw, 4 * kq + 2, e), CONV4_TAP(w, raw, 4 * kq + 3, e));
                    *(LAS u32x2*)(BT + (4 * cg + e) * XTP + tok0 + 4 * kq) = pw; }
        }
        {
            const int cg = lane, tok0 = 16 * wid, xcol0 = 256 * hq + 4 * cg, h = 4 * hq + (cg >> 4); const ConvW4 w = conv4_w(cw, cb, xcol0);
            float raw[19][4]; conv4_load<16>(raw, X.PROJ, r0 + tok0, !(c == 0 && tok0 == 0), xcol0);
            float ws[16];
#pragma unroll
            for (int k4 = 0; k4 < 4; ++k4) { const f32x4 t4 = *(LAS f32x4*)(WSL + h * 128 + tok0 + 4 * k4); ws[4 * k4] = t4.x; ws[4 * k4 + 1] = t4.y; ws[4 * k4 + 2] = t4.z; ws[4 * k4 + 3] = t4.w; }
#pragma unroll
            for (int e = 0; e < 4; ++e)
#pragma unroll
                for (int kq = 0; kq < 4; ++kq) { u32x2 pw; pw.x = pk2(CONV4_TAP(w, raw, 4 * kq, e) * ws[4 * kq], CONV4_TAP(w, raw, 4 * kq + 1, e) * ws[4 * kq + 1]); pw.y = pk2(CONV4_TAP(w, raw, 4 * kq + 2, e) * ws[4 * kq + 2], CONV4_TAP(w, raw, 4 * kq + 3, e) * ws[4 * kq + 3]);
                    *(LAS u32x2*)(XT + (4 * cg + e) * XTP + tok0 + 4 * kq) = pw; }
        }
        __syncthreads();
        {
            const int hl = wid >> 1, ph = wid & 1, h = 4 * hq + hl;
            f32x4 acc[2][8];
#pragma unroll
            for (int pp = 0; pp < 2; ++pp)
#pragma unroll
                for (int nt = 0; nt < 8; ++nt) acc[pp][nt] = (f32x4){0.f, 0.f, 0.f, 0.f};
#pragma unroll 1
            for (int ks = 0; ks < 4; ++ks) {
                bf16x8 bfr[8], xfr[2];
#pragma unroll
                for (int nt = 0; nt < 8; ++nt) { ldsp p = (ldsp)(BT + (16 * nt + i) * XTP + 32 * ks + 8 * g); bfr[nt] = lds8x2(p, p + 8); }
#pragma unroll
                for (int pp = 0; pp < 2; ++pp) { ldsp p = (ldsp)(XT + (hl * 64 + 16 * (2 * ph + pp) + i) * XTP + 32 * ks + 8 * g); xfr[pp] = lds8x2(p, p + 8); }
#pragma unroll
                for (int pp = 0; pp < 2; ++pp)
#pragma unroll
                    for (int nt = 0; nt < 8; ++nt) acc[pp][nt] = mfma16(bfr[nt], xfr[pp], acc[pp][nt]);
            }
            u16* sb = X.ST + ((size_t)((b * 64 + c) * 16 + h)) * 8192;
#pragma unroll
            for (int pp = 0; pp < 2; ++pp)
#pragma unroll
                for (int nt = 0; nt < 8; ++nt) { const int p = 16 * (2 * ph + pp) + i, n = 16 * nt + 4 * g; u32x2 w; w.x = pk2(acc[pp][nt][0], acc[pp][nt][1]); w.y = pk2(acc[pp][nt][2], acc[pp][nt][3]);
                    *(u32x2*)(sb + p * 128 + n) = w; }
        }
        __syncthreads();
    }
}

__device__ __forceinline__ void ssd_sample_unit(const Ctx& X, int l, int b, int grp, ldsp L, int tid, int wid, int lane) {
    LAS float* XS = (LAS float*)L;
    LAS float* BS = (LAS float*)(L + 8192);
    LAS float* CS = (LAS float*)(L + 10240);
    LAS float* DTS = (LAS float*)(L + 12288);
    LAS float* YG = (LAS float*)(L + 12544);
    const float* cw = X.in[I_CW] + (size_t)l * 4 * 1536; const float* cb = X.in[I_CB] + (size_t)l * 1536;
    const int row0 = MP + b * 4;
    const int p = tid >> 3, nq = tid & 7, n0 = 16 * nq;
    const float* sbase = X.in[I_SSSM] + ((size_t)((l * 128 + b) * 16 + 8 * grp) * 64 + p) * 128 + n0;
    f32x4 nx[4], nx1[4], nx2[4];
#pragma unroll
    for (int e4 = 0; e4 < 4; ++e4) { nx[e4] = *(const f32x4*)(sbase + 4 * e4); nx1[e4] = *(const f32x4*)(sbase + 8192 + 4 * e4); nx2[e4] = *(const f32x4*)(sbase + 2 * 8192 + 4 * e4); }
    for (int ci = tid; ci < 768; ci += 512) {
        const int xcol = ci < 512 ? 512 * grp + ci : (ci < 640 ? 1024 + 128 * grp + (ci - 512) : 1280 + 128 * grp + (ci - 640));
        float xp[7];
#pragma unroll
        for (int j = 0; j < 3; ++j) xp[j] = X.in[I_SCONV][((size_t)(l * 128 + b) * 3 + j) * 1536 + xcol];
#pragma unroll
        for (int t = 0; t < 4; ++t) xp[3 + t] = bf2f(X.PROJ[(size_t)(row0 + t) * NPROJ + C_X + xcol]);
        const float w0 = cw[xcol], w1 = cw[1536 + xcol], w2 = cw[2 * 1536 + xcol], w3 = cw[3 * 1536 + xcol], bias = cb[xcol];
#pragma unroll
        for (int t = 0; t < 4; ++t) {
            const float v = silu_f(fmaf(xp[t], w0, fmaf(xp[t + 1], w1, fmaf(xp[t + 2], w2, fmaf(xp[t + 3], w3, bias)))));
            if (ci < 512) XS[t * 512 + ci] = v; else if (ci < 640) BS[t * 128 + ci - 512] = v; else CS[t * 128 + ci - 640] = v;
        }
#pragma unroll
        for (int j = 0; j < 3; ++j) X.out[O_CS + ((size_t)(l * 128 + b) * 3 + j) * 1536 + xcol] = xp[4 + j];
    }
    {
        const int h = 8 * grp + wid; const u16* wp = X.WinT + (size_t)l * NIN * DM + (size_t)(NPROJ + h) * DM + lane * 16;
        const u32x4 wa = *(const u32x4*)wp, wb = *(const u32x4*)(wp + 8);
#pragma unroll
        for (int t = 0; t < 4; ++t) {
            const u16* xp = X.XB + (size_t)(row0 + t) * DM + lane * 16; const u32x4 xa = *(const u32x4*)xp, xb = *(const u32x4*)(xp + 8);
            float s = 0.f;
#pragma unroll
            for (int e = 0; e < 4; ++e) { s += bflo(xa[e]) * bflo(wa[e]) + bfhi(xa[e]) * bfhi(wa[e]); s += bflo(xb[e]) * bflo(wb[e]) + bfhi(xb[e]) * bfhi(wb[e]); }
            s = wave_sum(s);
            const float dt = softplus_f(s * rstd_row(X.SSP, row0 + t) + X.in[I_DTB][l * 16 + h]);
            if (lane == 0) DTS[t * 8 + wid] = dt;
        }
    }
    __syncthreads();
#pragma unroll 1
    for (int hh = 0; hh < 8; ++hh) {
        const int h = 8 * grp + hh; const size_t sidx = ((size_t)((l * 128 + b) * 16 + h) * 64 + p) * 128 + n0;
        unsigned zr[4];
#pragma unroll
        for (int t = 0; t < 4; ++t) zr[t] = X.PROJ[(size_t)(row0 + t) * NPROJ + C_Z + 64 * h + p];
        float hst[16];
#pragma unroll
        for (int e4 = 0; e4 < 4; ++e4) { const f32x4 v = nx[e4]; hst[4 * e4] = v.x; hst[4 * e4 + 1] = v.y; hst[4 * e4 + 2] = v.z; hst[4 * e4 + 3] = v.w; nx[e4] = nx1[e4]; nx1[e4] = nx2[e4]; }
        if (hh < 5) {
#pragma unroll
            for (int e4 = 0; e4 < 4; ++e4) nx2[e4] = *(const f32x4*)(sbase + (size_t)(hh + 3) * 8192 + 4 * e4);
        }
        const float A = -expf(X.in[I_ALOG][l * 16 + h]), Dh = X.in[I_DSK][l * 16 + h];
        float y[4];
#pragma unroll
        for (int t = 0; t < 4; ++t) {
            const float dt = DTS[t * 8 + hh], dA = __expf(dt * A), dx = dt * XS[t * 512 + hh * 64 + p]; float acc = 0.f;
#pragma unroll
            for (int e = 0; e < 16; ++e) { hst[e] = fmaf(hst[e], dA, dx * BS[t * 128 + n0 + e]); acc = fmaf(hst[e], CS[t * 128 + n0 + e], acc); }
            y[t] = acc;
        }
#pragma unroll
        for (int e4 = 0; e4 < 4; ++e4) { f32x4 v; v.x = hst[4 * e4]; v.y = hst[4 * e4 + 1]; v.z = hst[4 * e4 + 2]; v.w = hst[4 * e4 + 3]; *(f32x4*)(X.out + O_HS + sidx + 4 * e4) = v; }
#pragma unroll
        for (int t = 0; t < 4; ++t) {
            float yy = y[t]; yy += __shfl_xor(yy, 1); yy += __shfl_xor(yy, 2); yy += __shfl_xor(yy, 4);
            if (nq == 0) { const float yv = yy + Dh * XS[t * 512 + hh * 64 + p]; const float z = bf2f(zr[t]); YG[t * 512 + hh * 64 + p] = yv * silu_f(z); }
        }
    }
    __syncthreads();
    if (wid < 4) {
        const int t = wid; float ss = 0.f;
#pragma unroll
        for (int k = 0; k < 8; ++k) { const float v = YG[t * 512 + lane + 64 * k]; ss += v * v; }
        ss = wave_sum(ss); const float rs = rsqrtf(ss * (1.f / 512.f) + EPS);
#pragma unroll
        for (int k = 0; k < 8; ++k) { const int col = lane + 64 * k; X.YMIX[(size_t)(row0 + t) * NMIX + 512 * grp + col] = (u16)f2bf(YG[t * 512 + col] * rs); }
    }
}
constexpr int KNP = 72;
constexpr int VTP = 264;
__device__ __forceinline__ void attn_prompt_unit(const Ctx& X, int l, int b, int nb, ldsp L, int tid, int wid, int lane) {
    LAS u16* Kn = (LAS u16*)L;
    LAS u16* Vt = (LAS u16*)(L + 73728);
    const int i = lane & 15, g = lane >> 4;
    {
        const int key = tid >> 1, part = tid & 1, tk = nb * 128 - 128 + key; const bool last = (nb == 63) && key >= 128;
        if (tk < 0) {
#pragma unroll
            for (int kvh = 0; kvh < 2; ++kvh) {
                LAS u16* kd = Kn + (kvh * 256 + key) * KNP + 16 * part; LAS u16* vd = Vt + (kvh * 64 + 16 * part) * VTP + key;
                *(LAS u32x4*)(kd) = (u32x4){0u, 0u, 0u, 0u}; *(LAS u32x4*)(kd + 8) = (u32x4){0u, 0u, 0u, 0u}; *(LAS u32x4*)(kd + 32) = (u32x4){0u, 0u, 0u, 0u}; *(LAS u32x4*)(kd + 40) = (u32x4){0u, 0u, 0u, 0u};
#pragma unroll
                for (int d = 0; d < 16; ++d) { vd[d * VTP] = 0; vd[(32 + d) * VTP] = 0; }
            }
        } else {
            const u16* src0 = X.PROJ + (size_t)(b * 8192 + tk) * NPROJ + 16 * part;
            u32x4 kw[2][4], vw[2][4];
#pragma unroll
            for (int kvh = 0; kvh < 2; ++kvh) {
                const u16* src = src0 + 64 * kvh;
                kw[kvh][0] = *(const u32x4*)(src + C_K); kw[kvh][1] = *(const u32x4*)(src + C_K + 8); kw[kvh][2] = *(const u32x4*)(src + C_K + 32); kw[kvh][3] = *(const u32x4*)(src + C_K + 40);
                vw[kvh][0] = *(const u32x4*)(src + C_V); vw[kvh][1] = *(const u32x4*)(src + C_V + 8); vw[kvh][2] = *(const u32x4*)(src + C_V + 32); vw[kvh][3] = *(const u32x4*)(src + C_V + 40);
            }
            float cs[16], sn[16];
            {
                const f32x4* cp = (const f32x4*)(X.COS + (size_t)tk * 32 + 16 * part); const f32x4* sp = (const f32x4*)(X.SIN + (size_t)tk * 32 + 16 * part);
#pragma unroll
                for (int e = 0; e < 4; ++e) { const f32x4 c4 = cp[e], s4 = sp[e]; cs[4 * e] = c4.x; cs[4 * e + 1] = c4.y; cs[4 * e + 2] = c4.z; cs[4 * e + 3] = c4.w; sn[4 * e] = s4.x; sn[4 * e + 1] = s4.y; sn[4 * e + 2] = s4.z; sn[4 * e + 3] = s4.w; }
            }
            const float* kn = X.in[I_KN] + l * 64 + 16 * part;
#pragma unroll
            for (int kvh = 0; kvh < 2; ++kvh) {
                LAS u16* kd = Kn + (kvh * 256 + key) * KNP + 16 * part; LAS u16* vd = Vt + (kvh * 64 + 16 * part) * VTP + key;
                float x1[16], x2[16]; float ss = 0.f;
#pragma unroll
                for (int q = 0; q < 4; ++q) { x1[2 * q] = bflo(kw[kvh][0][q]); x1[2 * q + 1] = bfhi(kw[kvh][0][q]); x1[8 + 2 * q] = bflo(kw[kvh][1][q]); x1[8 + 2 * q + 1] = bfhi(kw[kvh][1][q]);
                    x2[2 * q] = bflo(kw[kvh][2][q]); x2[2 * q + 1] = bfhi(kw[kvh][2][q]); x2[8 + 2 * q] = bflo(kw[kvh][3][q]); x2[8 + 2 * q + 1] = bfhi(kw[kvh][3][q]); }
#pragma unroll
                for (int d = 0; d < 16; ++d) ss += x1[d] * x1[d] + x2[d] * x2[d];
                ss += __shfl_xor(ss, 1);
                const float rs = rsqrtf(ss * (1.f / 64.f) + EPS);
#pragma unroll
                for (int d = 0; d < 16; ++d) { const float u1 = x1[d] * rs * kn[d], u2 = x2[d] * rs * kn[d + 32], c = cs[d], sv = sn[d]; x1[d] = u1 * c - u2 * sv; x2[d] = u2 * c + u1 * sv; }
#pragma unroll
                for (int e = 0; e < 2; ++e) { u32x4 w; w.x = pk2(x1[8 * e], x1[8 * e + 1]); w.y = pk2(x1[8 * e + 2], x1[8 * e + 3]); w.z = pk2(x1[8 * e + 4], x1[8 * e + 5]); w.w = pk2(x1[8 * e + 6], x1[8 * e + 7]); *(LAS u32x4*)(kd + 8 * e) = w;
                    u32x4 v; v.x = pk2(x2[8 * e], x2[8 * e + 1]); v.y = pk2(x2[8 * e + 2], x2[8 * e + 3]); v.z = pk2(x2[8 * e + 4], x2[8 * e + 5]); v.w = pk2(x2[8 * e + 6], x2[8 * e + 7]); *(LAS u32x4*)(kd + 32 + 8 * e) = v; }
                const size_t oidx = (((size_t)(l * 4 + b) * 128 + (key - 128)) * 2 + kvh) * 64 + 16 * part;
                if (last) { float* o = X.out + O_KP + oidx;
#pragma unroll
                    for (int e = 0; e < 4; ++e) { *(f32x4*)(o + 4 * e) = (f32x4){x1[4 * e], x1[4 * e + 1], x1[4 * e + 2], x1[4 * e + 3]}; *(f32x4*)(o + 32 + 4 * e) = (f32x4){x2[4 * e], x2[4 * e + 1], x2[4 * e + 2], x2[4 * e + 3]}; } }
#pragma unroll
                for (int hf = 0; hf < 2; ++hf)
#pragma unroll
                    for (int e = 0; e < 2; ++e) { const u32x4 w = vw[kvh][2 * hf + e];
#pragma unroll
                        for (int q = 0; q < 4; ++q) { vd[(32 * hf + 8 * e + 2 * q) * VTP] = (u16)(w[q] & 0xffffu); vd[(32 * hf + 8 * e + 2 * q + 1) * VTP] = (u16)(w[q] >> 16); }
                        if (last) { float* ov = X.out + O_VP + oidx + 32 * hf + 8 * e; *(f32x4*)(ov) = (f32x4){bflo(w[0]), bfhi(w[0]), bflo(w[1]), bfhi(w[1])}; *(f32x4*)(ov + 4) = (f32x4){bflo(w[2]), bfhi(w[2]), bflo(w[3]), bfhi(w[3])}; } }
            }
        }
    }
    __syncthreads();
    const int kvh = wid >> 2; const float sink = X.in[I_SINK][l * 8 + wid];
    const float* qn = X.in[I_QN] + l * 64;
    u32x4 nqa, nqb; f32x4 ncs0, ncs1, nsn0, nsn1;
    {
        const int tq0 = nb * 128 + i; const size_t row0q = (size_t)b * 8192 + tq0;
        nqa = *(const u32x4*)(X.PROJ + row0q * NPROJ + 64 * wid + 8 * g); nqb = *(const u32x4*)(X.PROJ + row0q * NPROJ + 64 * wid + 32 + 8 * g);
        ncs0 = *(const f32x4*)(X.COS + (size_t)tq0 * 32 + 8 * g); ncs1 = *(const f32x4*)(X.COS + (size_t)tq0 * 32 + 8 * g + 4);
        nsn0 = *(const f32x4*)(X.SIN + (size_t)tq0 * 32 + 8 * g); nsn1 = *(const f32x4*)(X.SIN + (size_t)tq0 * 32 + 8 * g + 4);
    }
    for (int qt = 0; qt < 8; ++qt) {
        const int qi = 16 * qt + i, tq = nb * 128 + qi; const size_t row = (size_t)b * 8192 + tq;
        bf16x8 qf0, qf1;
        {
            const u32x4 wa = nqa, wb = nqb; const f32x4 c0 = ncs0, c1 = ncs1, s0v = nsn0, s1v = nsn1;
            {
                const int qn_ = qt < 7 ? qt + 1 : 7; const int tqn = nb * 128 + 16 * qn_ + i; const size_t rown = (size_t)b * 8192 + tqn;
                nqa = *(const u32x4*)(X.PROJ + rown * NPROJ + 64 * wid + 8 * g); nqb = *(const u32x4*)(X.PROJ + rown * NPROJ + 64 * wid + 32 + 8 * g);
                ncs0 = *(const f32x4*)(X.COS + (size_t)tqn * 32 + 8 * g); ncs1 = *(const f32x4*)(X.COS + (size_t)tqn * 32 + 8 * g + 4);
                nsn0 = *(const f32x4*)(X.SIN + (size_t)tqn * 32 + 8 * g); nsn1 = *(const f32x4*)(X.SIN + (size_t)tqn * 32 + 8 * g + 4);
            }
            float x1[8], x2[8]; float ss = 0.f;
#pragma unroll
            for (int q = 0; q < 4; ++q) { x1[2 * q] = bflo(wa[q]); x1[2 * q + 1] = bfhi(wa[q]); x2[2 * q] = bflo(wb[q]); x2[2 * q + 1] = bfhi(wb[q]); }
#pragma unroll
            for (int e = 0; e < 8; ++e) ss += x1[e] * x1[e] + x2[e] * x2[e];
            ss += __shfl_xor(ss, 16); ss += __shfl_xor(ss, 32);
            const float rs = rsqrtf(ss * (1.f / 64.f) + EPS) * 0.125f;
            const float cs[8] = {c0.x, c0.y, c0.z, c0.w, c1.x, c1.y, c1.z, c1.w}, sn[8] = {s0v.x, s0v.y, s0v.z, s0v.w, s1v.x, s1v.y, s1v.z, s1v.w};
            float o1[8], o2[8];
#pragma unroll
            for (int e = 0; e < 8; ++e) { const float a = x1[e] * rs * qn[8 * g + e], bb = x2[e] * rs * qn[32 + 8 * g + e], c = cs[e], s = sn[e]; o1[e] = a * c - bb * s; o2[e] = bb * c + a * s; }
            u32x4 w0, w1; w0.x = pk2(o1[0], o1[1]); w0.y = pk2(o1[2], o1[3]); w0.z = pk2(o1[4], o1[5]); w0.w = pk2(o1[6], o1[7]);
            w1.x = pk2(o2[0], o2[1]); w1.y = pk2(o2[2], o2[3]); w1.z = pk2(o2[4], o2[5]); w1.w = pk2(o2[6], o2[7]);
            qf0 = __builtin_bit_cast(bf16x8, w0); qf1 = __builtin_bit_cast(bf16x8, w1);
        }
        f32x4 s[9]; float mx = -INFINITY;
#pragma unroll
        for (int kk = 0; kk < 9; ++kk) {
            const int kt = qt + kk; ldsp kp = (ldsp)(Kn + (kvh * 256 + 16 * kt + i) * KNP + 8 * g);
            f32x4 a = {0.f, 0.f, 0.f, 0.f}; a = mfma16(lds16(kp), qf0, a); a = mfma16(lds16(kp + 64), qf1, a);
#pragma unroll
            for (int j = 0; j < 4; ++j) { const int kj = 16 * kt + 4 * g + j; const bool ok = (kj > qi) && (kj <= qi + 128) && (nb > 0 || kj >= 128); a[j] = ok ? a[j] : -INFINITY; mx = fmaxf(mx, a[j]); }
            s[kk] = a;
        }
        mx = fmaxf(mx, __shfl_xor(mx, 16)); mx = fmaxf(mx, __shfl_xor(mx, 32)); mx = fmaxf(mx, sink);
        float sum = 0.f;
#pragma unroll
        for (int kk = 0; kk < 9; ++kk)
#pragma unroll
            for (int j = 0; j < 4; ++j) { const float p = __expf(s[kk][j] - mx); s[kk][j] = p; sum += p; }
        sum += __shfl_xor(sum, 16); sum += __shfl_xor(sum, 32);
        const float inv = 1.f / (sum + __expf(sink - mx));
        f32x4 o[4];
#pragma unroll
        for (int dt = 0; dt < 4; ++dt) o[dt] = (f32x4){0.f, 0.f, 0.f, 0.f};
#pragma unroll
        for (int pi = 0; pi < 5; ++pi) {
            const int k0 = 2 * pi, k1 = (2 * pi + 1 < 9) ? 2 * pi + 1 : 2 * pi;
            u32x4 pw; pw.x = pk2(s[k0][0], s[k0][1]); pw.y = pk2(s[k0][2], s[k0][3]);
            if (2 * pi + 1 < 9) { pw.z = pk2(s[k1][0], s[k1][1]); pw.w = pk2(s[k1][2], s[k1][3]); } else { pw.z = 0u; pw.w = 0u; }
            const bf16x8 pf = __builtin_bit_cast(bf16x8, pw);
#pragma unroll
            for (int dt = 0; dt < 4; ++dt) {
                LAS u16* vr = Vt + (kvh * 64 + 16 * dt + i) * VTP + 4 * g;
                const bf16x8 vf = lds8x2((ldsp)(vr + 16 * (qt + k0)), (ldsp)(vr + 16 * (qt + k1)));
                o[dt] = mfma16(vf, pf, o[dt]);
            }
        }
#pragma unroll
        for (int dt = 0; dt < 4; ++dt) { u32x2 w; w.x = pk2(o[dt][0] * inv, o[dt][1] * inv); w.y = pk2(o[dt][2] * inv, o[dt][3] * inv);
            *(u32x2*)(X.YMIX + row * NMIX + 1024 + 64 * wid + 16 * dt + 4 * g) = w; }
    }
}

__device__ __forceinline__ void scan_unit(const Ctx& X, int l, int hs, int tid) {
    const int b = hs >> 7, h = (hs >> 3) & 15, pq = hs & 7;
    const int p = 8 * pq + (tid >> 6), n = (tid & 63) * 2;
    u16* base = X.ST + ((size_t)(b * 64) * 16 + h) * 8192 + p * 128 + n;
    const float* cd = X.CD + (b * 64) * 16 + h;
    float h0 = 0.f, h1 = 0.f;
    for (int c0 = 0; c0 < 64; c0 += 32) {
        unsigned st[32]; float dc[32];
#pragma unroll
        for (int e = 0; e < 32; ++e) { st[e] = *(const unsigned*)(base + (size_t)(c0 + e) * 16 * 8192); dc[e] = cd[(c0 + e) * 16]; }
#pragma unroll
        for (int e = 0; e < 32; ++e) {
            *(unsigned*)(base + (size_t)(c0 + e) * 16 * 8192) = pk2(h0, h1);
            h0 = fmaf(h0, dc[e], bflo(st[e])); h1 = fmaf(h1, dc[e], bfhi(st[e]));
        }
    }
    float* o = X.out + O_HP + ((size_t)((l * 4 + b) * 16 + h) * 64 + p) * 128 + n; o[0] = h0; o[1] = h1;
}

constexpr int KCP = 132;
__device__ __forceinline__ void attn_sample_unit(const Ctx& X, int l, int b, ldsp L, int tid, int wid, int lane) {
    LAS u16* KC = (LAS u16*)L;
    LAS u16* VC = (LAS u16*)(L + 34848);
    LAS float* QS = (LAS float*)(L + 69696);
    LAS float* SS = (LAS float*)(L + 77888);
    const int row0 = MP + b * 4;
#pragma unroll
    for (int k = 0; k < 8; ++k) {
        const int idx = tid + 512 * k, j = idx >> 5, c4 = (idx & 31) * 4; const size_t off = ((size_t)(l * 128 + b) * 128 + j) * 128 + c4;
        const f32x4 kv = *(const f32x4*)(X.in[I_CK] + off), vv = *(const f32x4*)(X.in[I_CV] + off);
        { u32x2 kw2; kw2.x = pk2(kv.x, kv.y); kw2.y = pk2(kv.z, kv.w); *(LAS u32x2*)(KC + j * KCP + c4) = kw2; u32x2 vw2; vw2.x = pk2(vv.x, vv.y); vw2.y = pk2(vv.z, vv.w); *(LAS u32x2*)(VC + j * KCP + c4) = vw2; }
        if (j >= 4) { const size_t oo = ((size_t)(l * 128 + b) * 128 + (j - 4)) * 128 + c4; *(f32x4*)(X.out + O_KS + oo) = kv; *(f32x4*)(X.out + O_VS + oo) = vv; }
    }
    {
        const int t = wid >> 1, kvh = wid & 1; const u16* src = X.PROJ + (size_t)(row0 + t) * NPROJ;
        const float x = bf2f(src[C_K + 64 * kvh + lane]); const float ss = wave_sum(x * x);
        const float xn = x * rsqrtf(ss * (1.f / 64.f) + EPS) * X.in[I_KN][l * 64 + lane]; const float pr = __shfl_xor(xn, 32);
        const float c = X.COS[(size_t)(8192 + t) * 32 + (lane & 31)], s = X.SIN[(size_t)(8192 + t) * 32 + (lane & 31)];
        const float o = lane < 32 ? xn * c - pr * s : xn * c + pr * s;
        KC[(128 + t) * KCP + kvh * 64 + lane] = (u16)f2bf(o);
        const size_t oo = ((size_t)(l * 128 + b) * 128 + 124 + t) * 128 + kvh * 64 + lane;
        X.out[O_KS + oo] = o;
        const unsigned vraw = src[C_V + 64 * kvh + lane]; VC[(128 + t) * KCP + kvh * 64 + lane] = (u16)vraw; X.out[O_VS + oo] = bf2f(vraw);
    }
#pragma unroll
    for (int k = 0; k < 4; ++k) {
        const int pair = 4 * wid + k, t = pair >> 3, head = pair & 7;
        const float x = bf2f(X.PROJ[(size_t)(row0 + t) * NPROJ + 64 * head + lane]); const float ss = wave_sum(x * x);
        const float xn = x * rsqrtf(ss * (1.f / 64.f) + EPS) * X.in[I_QN][l * 64 + lane]; const float pr = __shfl_xor(xn, 32);
        const float c = X.COS[(size_t)(8192 + t) * 32 + (lane & 31)], s = X.SIN[(size_t)(8192 + t) * 32 + (lane & 31)];
        QS[pair * 64 + lane] = (lane < 32 ? xn * c - pr * s : xn * c + pr * s) * 0.125f;
    }
    __syncthreads();
    for (int it = 0; it < 9; ++it) {
        const int idx = tid + 512 * it;
        if (idx < 32 * 132) {
            const int pair = idx / 132, key = idx - pair * 132, t = pair >> 3, head = pair & 7, kvh = head >> 2;
            const bool ok = key < 128 ? key > t : (key - 128) <= t;
            float s = 0.f;
#pragma unroll
            for (int d = 0; d < 64; d += 4) { const u32x2 kw2 = *(LAS u32x2*)(KC + key * KCP + kvh * 64 + d); const f32x4 q4 = *(LAS f32x4*)(QS + pair * 64 + d);
                s = fmaf(q4.x, bflo(kw2.x), s); s = fmaf(q4.y, bfhi(kw2.x), s); s = fmaf(q4.z, bflo(kw2.y), s); s = fmaf(q4.w, bfhi(kw2.y), s); }
            SS[pair * 136 + key] = ok ? s : -INFINITY;
        }
    }
    __syncthreads();
#pragma unroll
    for (int k = 0; k < 4; ++k) {
        const int pair = 4 * wid + k, head = pair & 7; const float sink = X.in[I_SINK][l * 8 + head];
        const float v0 = SS[pair * 136 + lane], v1 = SS[pair * 136 + 64 + lane], v2 = lane < 4 ? SS[pair * 136 + 128 + lane] : -INFINITY;
        const float mx = fmaxf(wave_max(fmaxf(fmaxf(v0, v1), v2)), sink);
        const float e0 = __expf(v0 - mx), e1 = __expf(v1 - mx), e2 = __expf(v2 - mx);
        const float inv = 1.f / (wave_sum(e0 + e1 + e2) + __expf(sink - mx));
        SS[pair * 136 + lane] = e0 * inv; SS[pair * 136 + 64 + lane] = e1 * inv; if (lane < 4) SS[pair * 136 + 128 + lane] = e2 * inv;
    }
    __syncthreads();
    {
        const int pair = tid >> 4, d4 = (tid & 15) * 4, head = pair & 7, kvh = head >> 2, t = pair >> 3;
        float a0 = 0.f, a1 = 0.f, a2 = 0.f, a3 = 0.f;
        for (int key = 0; key < 132; ++key) {
            const float p = SS[pair * 136 + key]; const u32x2 vw2 = *(LAS u32x2*)(VC + key * KCP + kvh * 64 + d4); const unsigned w0 = vw2.x, w1 = vw2.y;
            a0 = fmaf(p, bflo(w0), a0); a1 = fmaf(p, bfhi(w0), a1); a2 = fmaf(p, bflo(w1), a2); a3 = fmaf(p, bfhi(w1), a3);
        }
        u32x2 w; w.x = pk2(a0, a1); w.y = pk2(a2, a3); *(u32x2*)(X.YMIX + (size_t)(row0 + t) * NMIX + 1024 + 64 * head + d4) = w;
    }
}

constexpr int CNP = 136;
template <int MODE> __device__ __forceinline__ void ssd_out_unit(const Ctx& X, int l, int b, int c, ldsp L, int tid, int wid, int lane) {
    LAS float* DTL = (LAS float*)L; LAS float* ACL = (LAS float*)(L + 8192);
    LAS u16* CcL = (LAS u16*)(L + 16384);
    LAS u16* CBL = (LAS u16*)(L + 16384 + 34816);
    LAS float* SSQ = (LAS float*)(L + 16384 + 34816 + 18432);
    LAS u16* XT = (LAS u16*)(L + 73728);
    LAS u16* BcL = XT;
    const int i = lane & 15, g = lane >> 4, r0 = b * 8192 + c * 128;
    const float* cw = X.in[I_CW] + (size_t)l * 4 * 1536; const float* cb = X.in[I_CB] + (size_t)l * 1536;
    { const f32x4 d4 = *(const f32x4*)(X.DT + (size_t)r0 * 16 + tid * 4); const int s_ = tid >> 2, h0 = (tid & 3) * 4;
      DTL[(h0 + 0) * 128 + s_] = d4.x; DTL[(h0 + 1) * 128 + s_] = d4.y; DTL[(h0 + 2) * 128 + s_] = d4.z; DTL[(h0 + 3) * 128 + s_] = d4.w; }
    __syncthreads();
    acum_scan(DTL, ACL, X.in[I_ALOG] + l * 16, wid, lane);
    if (c == 63) for (int idx = tid; idx < 3 * 1536; idx += 512) { const int j = idx / 1536, col = idx - j * 1536;
        X.out[O_CP + ((size_t)(l * 4 + b) * 3 + j) * 1536 + col] = bf2f(X.PROJ[(size_t)(b * 8192 + 8189 + j) * NPROJ + C_X + col]); }
    __syncthreads();
    for (int grp = 0; grp < 2; ++grp) {
        {
            const int cg = lane, tok0 = 16 * wid, isC = cg >> 5, n0 = 4 * (cg & 31), xcol0 = 1024 + 256 * isC + 128 * grp + n0; const ConvW4 w = conv4_w(cw, cb, xcol0);
            float raw[19][4]; conv4_load<16>(raw, X.PROJ, r0 + tok0, !(c == 0 && tok0 == 0), xcol0);
            LAS u16* dst = (isC ? CcL : BcL) + tok0 * CNP + n0;
#pragma unroll
            for (int k = 0; k < 16; ++k) { u32x2 pw; pw.x = pk2(CONV4_TAP(w, raw, k, 0), CONV4_TAP(w, raw, k, 1)); pw.y = pk2(CONV4_TAP(w, raw, k, 2), CONV4_TAP(w, raw, k, 3)); *(LAS u32x2*)(dst + k * CNP) = pw; }
        }
        __syncthreads();
        if (MODE != 1) for (int tix = wid; tix < 36; tix += 8) {
            int qt = 0; while ((qt + 1) * (qt + 2) / 2 <= tix) ++qt; const int st = tix - qt * (qt + 1) / 2;
            f32x4 a = {0.f, 0.f, 0.f, 0.f};
#pragma unroll
            for (int kk = 0; kk < 4; ++kk) a = mfma16(lds16((ldsp)(BcL + (16 * st + i) * CNP + 32 * kk + 8 * g)), lds16((ldsp)(CcL + (16 * qt + i) * CNP + 32 * kk + 8 * g)), a);
            { u32x2 cw; cw.x = pk2(a[0], a[1]); cw.y = pk2(a[2], a[3]); *(LAS u32x2*)(CBL + (tix * 64 + lane) * 4) = cw; }
        }
        __syncthreads();
        for (int quad = 0; quad < 2; ++quad) {
            const int hq = 2 * grp + quad;
            bf16x8 hsf[4][4];
            {
                const int cg = lane, tok0 = 16 * wid, xcol0 = 256 * hq + 4 * cg; const ConvW4 w = conv4_w(cw, cb, xcol0);
                float raw[19][4]; conv4_load<16>(raw, X.PROJ, r0 + tok0, !(c == 0 && tok0 == 0), xcol0);
                {
                    const u16* hsb = X.ST + ((size_t)((b * 64 + c) * 16 + 4 * hq + (wid >> 1))) * 8192;
#pragma unroll
                    for (int pt = 0; pt < 4; ++pt)
#pragma unroll
                        for (int kk = 0; kk < 4; ++kk) hsf[pt][kk] = *(const bf16x8*)(hsb + (16 * pt + i) * 128 + 32 * kk + 8 * g);
                }
#pragma unroll
                for (int e = 0; e < 4; ++e)
#pragma unroll
                    for (int kq = 0; kq < 4; ++kq) { u32x2 pw; pw.x = pk2(CONV4_TAP(w, raw, 4 * kq, e), CONV4_TAP(w, raw, 4 * kq + 1, e)); pw.y = pk2(CONV4_TAP(w, raw, 4 * kq + 2, e), CONV4_TAP(w, raw, 4 * kq + 3, e));
                        *(LAS u32x2*)(XT + (4 * cg + e) * XTP + tok0 + 4 * kq) = pw; }
            }
            __syncthreads();
            if (MODE != 1) {
                const int hl = wid >> 1, half = wid & 1, h = 4 * hq + hl, hh = quad * 4 + hl;
                const float Dh = X.in[I_DSK][l * 16 + h];
                for (int qx = 0; qx < 4; ++qx) {
                    const int qt = qx == 0 ? half : (qx == 1 ? 3 - half : (qx == 2 ? 4 + half : 7 - half));
                    const int q = 16 * qt + i; const float aq = ACL[h * 128 + q], eaq = __expf(aq);
                    const size_t row = (size_t)r0 + q; u32x2 zw[4];
#pragma unroll
                    for (int pt = 0; pt < 4; ++pt) zw[pt] = *(const u32x2*)(X.PROJ + row * NPROJ + C_Z + 64 * h + 16 * pt + 4 * g);
                    f32x4 accy[4], acci[4];
#pragma unroll
                    for (int pt = 0; pt < 4; ++pt) { accy[pt] = (f32x4){0.f, 0.f, 0.f, 0.f}; acci[pt] = (f32x4){0.f, 0.f, 0.f, 0.f}; }
#pragma unroll
                    for (int kk = 0; kk < 4; ++kk) { const bf16x8 cf = lds16((ldsp)(CcL + q * CNP + 32 * kk + 8 * g));
#pragma unroll
                        for (int pt = 0; pt < 4; ++pt) accy[pt] = mfma16(hsf[pt][kk], cf, accy[pt]); }
                    const int tb = qt * (qt + 1) / 2, npair = qt / 2 + 1;
                    for (int pi = 0; pi < npair; ++pi) {
                        const int st0 = 2 * pi; const bool has1 = (st0 + 1) <= qt; const int st1 = has1 ? st0 + 1 : st0;
                        float m0[4], m1[4];
                        {
                            const int sa0 = 16 * st0 + 4 * g, sb0 = 16 * st1 + 4 * g;
                            const u32x2 cwa = *(LAS u32x2*)(CBL + ((tb + st0) * 64 + lane) * 4), cwb = *(LAS u32x2*)(CBL + ((tb + st1) * 64 + lane) * 4);
                            const f32x4 aca = *(LAS f32x4*)(ACL + h * 128 + sa0), acb = *(LAS f32x4*)(ACL + h * 128 + sb0);
                            const f32x4 dta = *(LAS f32x4*)(DTL + h * 128 + sa0), dtb = *(LAS f32x4*)(DTL + h * 128 + sb0);
                            const float ca[4] = {bflo(cwa.x), bfhi(cwa.x), bflo(cwa.y), bfhi(cwa.y)}, cb4[4] = {bflo(cwb.x), bfhi(cwb.x), bflo(cwb.y), bfhi(cwb.y)};
#pragma unroll
                            for (int j = 0; j < 4; ++j) {
                                const float va = ca[j] * __expf(fminf(aq - aca[j], 0.f)) * dta[j], vb = cb4[j] * __expf(fminf(aq - acb[j], 0.f)) * dtb[j];
                                m0[j] = (sa0 + j) <= q ? va : 0.f; m1[j] = (has1 && (sb0 + j) <= q) ? vb : 0.f;
                            }
                        }
                        u32x4 mw; mw.x = pk2(m0[0], m0[1]); mw.y = pk2(m0[2], m0[3]); mw.z = pk2(m1[0], m1[1]); mw.w = pk2(m1[2], m1[3]);
                        const bf16x8 mf = __builtin_bit_cast(bf16x8, mw);
#pragma unroll
                        for (int pt = 0; pt < 4; ++pt) { LAS u16* xr = XT + (hl * 64 + 16 * pt + i) * XTP + 4 * g;
                            acci[pt] = mfma16(lds8x2((ldsp)(xr + 16 * st0), (ldsp)(xr + 16 * st1)), mf, acci[pt]); }
                    }
                    float ss = 0.f;
#pragma unroll
                    for (int pt = 0; pt < 4; ++pt) {
                        const int p0 = 16 * pt + 4 * g;
                        const float z[4] = {bflo(zw[pt].x), bfhi(zw[pt].x), bflo(zw[pt].y), bfhi(zw[pt].y)}; float o[4];
#pragma unroll
                        for (int j = 0; j < 4; ++j) { const float xv = bf2f(XT[(hl * 64 + p0 + j) * XTP + q]); const float y = acci[pt][j] + eaq * accy[pt][j] + Dh * xv; o[j] = y * silu_f(z[j]); ss += o[j] * o[j]; }
                        u32x2 w; w.x = pk2(o[0], o[1]); w.y = pk2(o[2], o[3]); *(u32x2*)(X.YMIX + row * NMIX + 64 * h + p0) = w;
                    }
                    ss += __shfl_xor(ss, 16); ss += __shfl_xor(ss, 32);
                    if (g == 0) SSQ[q * 8 + hh] = ss;
                }
            }
            __syncthreads();
        }
        if (MODE == 0 && tid < 128) {
            const f32x4 s0 = *(LAS f32x4*)(SSQ + tid * 8), s1 = *(LAS f32x4*)(SSQ + tid * 8 + 4);
            X.RS[((size_t)r0 + tid) * 2 + grp] = rsqrtf((((s0.x + s0.y) + (s0.z + s0.w)) + ((s1.x + s1.y) + (s1.z + s1.w))) * (1.f / 512.f) + EPS);
        }
        __syncthreads();
    }
}
constexpr int N_PHASES = 1 + 7 * NL;

__device__ __forceinline__ void small_res_unit(const u16* A, const u16* WT, int K, float* outf, u16* xb, float* ssp, int u, ldsp L, int tid, int wid, int lane) {
    const int rt = u >> 4, ct = u & 15, i = lane & 15, g = lane >> 4;
    const int trow = 32 * rt + 16 * (wid >> 2) + i, col0 = 64 * ct + 16 * (wid & 3);
    const u16* ap = A + (size_t)(MP + trow) * K + 8 * g; const u16* wp = WT + (size_t)(col0 + i) * K + 8 * g;
    f32x4 acc = {0.f, 0.f, 0.f, 0.f};
    if (K == NMIX) {
#pragma unroll 24
        for (int kk = 0; kk < NMIX / 32; ++kk) acc = mfma16(*(const bf16x8*)(wp + 32 * kk), *(const bf16x8*)(ap + 32 * kk), acc);
    } else {
#pragma unroll 22
        for (int kk = 0; kk < DFF / 32; ++kk) acc = mfma16(*(const bf16x8*)(wp + 32 * kk), *(const bf16x8*)(ap + 32 * kk), acc);
    }
    const size_t o = (size_t)(MP + trow) * DM + col0 + 4 * g;
    const u32x2 rw = *(const u32x2*)(xb + o); const f32x4 r = {bflo(rw.x), bfhi(rw.x), bflo(rw.y), bfhi(rw.y)};
    const f32x4 v = acc + r;
    if (outf) *(f32x4*)(outf + o) = v;
    u32x2 w; w.x = pk2(v[0], v[1]); w.y = pk2(v[2], v[3]); *(u32x2*)(xb + o) = w;
    float ss = (v[0] * v[0] + v[1] * v[1]) + (v[2] * v[2] + v[3] * v[3]); ss += __shfl_xor(ss, 16); ss += __shfl_xor(ss, 32);
    LAS float* red = (LAS float*)L;
    if (g == 0) red[wid * 16 + i] = ss;
    __syncthreads();
    if (tid < 32) { const int hw = tid >> 4, t = tid & 15; ssp[(size_t)(MP + 32 * rt + 16 * hw + t) * 16 + ct] = (red[(4 * hw) * 16 + t] + red[(4 * hw + 1) * 16 + t]) + (red[(4 * hw + 2) * 16 + t] + red[(4 * hw + 3) * 16 + t]); }
    __syncthreads();
}

__device__ __forceinline__ void small_swiglu_unit(const u16* A, const u16* WT, const float* ssp, u16* H, int u, int wid, int lane) {
    const int rt = u / 44, ct = u - rt * 44, i = lane & 15, g = lane >> 4;
    const int trow = MP + 32 * rt + 16 * (wid >> 2) + i, f0 = 64 * ct + 16 * (wid & 3);
    const int wrow = (f0 >> 7) * 256 + (f0 & 127) + i;
    const u16* ap = A + (size_t)trow * DM + 8 * g; const u16* gp = WT + (size_t)wrow * DM + 8 * g; const u16* up = gp + (size_t)128 * DM;
    f32x4 ag = {0.f, 0.f, 0.f, 0.f}, au = {0.f, 0.f, 0.f, 0.f};
#pragma unroll 8
    for (int kk = 0; kk < DM / 32; ++kk) { const bf16x8 a = *(const bf16x8*)(ap + 32 * kk); ag = mfma16(*(const bf16x8*)(gp + 32 * kk), a, ag); au = mfma16(*(const bf16x8*)(up + 32 * kk), a, au); }
    const float rs = rstd_row(ssp, trow);
    u32x2 w; w.x = pk2(silu_f(ag[0] * rs) * (au[0] * rs), silu_f(ag[1] * rs) * (au[1] * rs)); w.y = pk2(silu_f(ag[2] * rs) * (au[2] * rs), silu_f(ag[3] * rs) * (au[3] * rs));
    *(u32x2*)(H + (size_t)trow * DFF + f0 + 4 * g) = w;
}
#define XB_TMO      128
#define XB_XCNT(j)  (256  + 64 * (j))
#define XB_XSUB(j)  (1280 + 64 * (j))
#define XB_XGEN(j)  (2304 + 64 * (j))
#define XB_TOP      3328
#define XB_TOPGEN   3392
#define XCD_BAR_WORDS 3456
#define XB_SPIN_CAP (1u << 18)

__device__ __forceinline__ unsigned xb_ld(unsigned* p)              { return __hip_atomic_load(p, __ATOMIC_RELAXED, __HIP_MEMORY_SCOPE_AGENT); }
__device__ __forceinline__ unsigned xb_add(unsigned* p, unsigned v) { return __hip_atomic_fetch_add(p, v, __ATOMIC_RELAXED, __HIP_MEMORY_SCOPE_AGENT); }
__device__ __forceinline__ unsigned xb_xcc_id() { return (unsigned)__builtin_amdgcn_s_getreg((3 << 11) | 20) & 0xFu; }
#define XB_SPIN(cond, bar) do { unsigned _sp = 0; while (cond) { __builtin_amdgcn_s_sleep(1); \
    if ((++_sp & 255u) == 0u) { if (xb_ld(&(bar)[XB_TMO])) break; if (_sp > XB_SPIN_CAP) { atomicAdd(&(bar)[XB_TMO], 1u); break; } } } } while (0)

struct XcdBarrier {
    unsigned* bar; unsigned x;
    volatile LAS unsigned* st;
};

__device__ __forceinline__ XcdBarrier xcd_barrier_post(unsigned* bar, volatile LAS unsigned* st) {
    XcdBarrier b; b.bar = bar; b.x = xb_xcc_id(); b.st = st;
    if (threadIdx.x == 0) (void)xb_add(&bar[XB_XCNT(b.x)], 1u);
    return b;
}
__device__ __forceinline__ void xcd_barrier_complete(unsigned* bar, unsigned x, unsigned& nloc, unsigned& nx) {
    const unsigned G = gridDim.x * gridDim.y * gridDim.z;
    unsigned sum, cnt, mine, sp = 0u;
    for (;;) {
        sum = 0u; cnt = 0u; mine = 0u;
#pragma unroll
        for (unsigned j = 0; j < 16; ++j) { const unsigned c = xb_ld(&bar[XB_XCNT(j)]); sum += c; cnt += (c > 0u) ? 1u : 0u; mine = (j == x) ? c : mine; }
        if (sum == G) break;
        __builtin_amdgcn_s_sleep(1);
        if ((++sp & 255u) == 0u) { if (xb_ld(&bar[XB_TMO])) break; if (sp > XB_SPIN_CAP) { atomicAdd(&bar[XB_TMO], 1u); break; } }
    }
    nloc = mine > 0u ? mine : 1u; nx = cnt > 0u ? cnt : 1u;
}

__device__ __forceinline__ void xcd_barrier(const XcdBarrier& b) {
    asm volatile("s_waitcnt vmcnt(0)" ::: "memory");
    __syncthreads();
    if (threadIdx.x == 0) {
        unsigned* bar = b.bar;
        __builtin_amdgcn_s_waitcnt(0);
        unsigned nloc = b.st[0], nx = b.st[1];
        if (nloc == 0u) { xcd_barrier_complete(bar, b.x, nloc, nx); b.st[0] = nloc; b.st[1] = nx; }
        const unsigned old = xb_add(&bar[XB_XSUB(b.x)], 1u);
        const unsigned gen = old / nloc;
        if (old + 1u == (gen + 1u) * nloc) {
            __builtin_amdgcn_fence(__ATOMIC_RELEASE, "agent");
            asm volatile("s_waitcnt vmcnt(0)" ::: "memory");
            const unsigned og = xb_add(&bar[XB_TOP], 1u);
            const unsigned tg = og / nx;
            if (og + 1u == (tg + 1u) * nx) xb_add(&bar[XB_TOPGEN], 1u);
            else XB_SPIN(xb_ld(&bar[XB_TOPGEN]) == tg, bar);
            __builtin_amdgcn_fence(__ATOMIC_ACQUIRE, "agent");
            xb_add(&bar[XB_XGEN(b.x)], 1u);
            asm volatile("s_waitcnt vmcnt(0)" ::: "memory");
        } else {
            XB_SPIN(xb_ld(&bar[XB_XGEN(b.x)]) == gen, bar);
            __builtin_amdgcn_fence(__ATOMIC_ACQUIRE, "agent");
            asm volatile("s_waitcnt vmcnt(0)" ::: "memory");
        }
    }
    __syncthreads();
}

#ifndef REP_SUB
#define REP_SUB 0
#endif
#ifndef REP_PH
#define REP_PH -1
#endif
#ifndef REP_MASK
#define REP_MASK 0
#endif
#ifndef UN_MASK
#define UN_MASK 31
#endif
#ifndef PH_MASK
#define PH_MASK 255
#endif
__global__ void __launch_bounds__(512, 2) hymba_mk(Params P) {
    extern __shared__ __attribute__((aligned(16))) unsigned char lds_raw[];
    ldsp L = (ldsp)lds_raw;
    u16* HB;
    volatile LAS unsigned* bst = (volatile LAS unsigned*)(L + LDS_BYTES - 64);
    if (threadIdx.x < 2) bst[threadIdx.x] = 0u;
    __syncthreads();
    const XcdBarrier xbar = xcd_barrier_post((unsigned*)(P.ws + WS_BAR), bst);
    if (P.ph_hi < 0) cg::this_grid().sync();
    for (int phi = P.ph_lo; phi < P.ph_hi + (REP_PH >= 0 ? 1 : 0); ++phi) {
        if (phi > P.ph_lo) xcd_barrier(xbar);
        const int ph = (REP_PH >= 0 && phi > REP_PH) ? phi - 1 : phi; const int rep = (REP_PH >= 0 && phi == REP_PH + 1) ? 1 : 0;
#ifdef EXTRA_SYNCS
        if (phi == 1) for (int es = 0; es < EXTRA_SYNCS; ++es) xcd_barrier(xbar);
#endif
        const __attribute__((address_space(4))) Params* pp = (const __attribute__((address_space(4))) Params*)__builtin_amdgcn_kernarg_segment_ptr();
        asm volatile("" : "+s"(pp));
        int tid = threadIdx.x; asm volatile("" : "+v"(tid));
        int bx = blockIdx.x, G = gridDim.x; asm volatile("" : "+s"(bx), "+s"(G));
        const int lane = tid & 63, wid = __builtin_amdgcn_readfirstlane(tid >> 6);
        Ctx X;
#pragma unroll
        for (int k = 0; k < 21; ++k) X.in[k] = pp->in[k];
        X.out = pp->out; X.ws = pp->ws;
        X.WinT = (u16*)(X.ws + WS_WIN); X.WoutT = (u16*)(X.ws + WS_WOUT); X.WguT = (u16*)(X.ws + WS_WGU); X.WdnT = (u16*)(X.ws + WS_WDN);
        X.COS = (float*)(X.ws + WS_ROPE); X.SIN = (float*)(X.ws + WS_ROPE + SZ_ROPE); X.XB = (u16*)(X.ws + WS_XB); X.SSP = (float*)(X.ws + WS_SSP);
        X.PROJ = (u16*)(X.ws + WS_PROJ); X.YMIX = (u16*)(X.ws + WS_YMIX); X.DT = (float*)(X.ws + WS_DT); X.CD = (float*)(X.ws + WS_CD); X.ST = (u16*)(X.ws + WS_ST); X.RS = (float*)(X.ws + WS_RS);
        HB = X.PROJ;
        if (ph == 0) { if (PH_MASK & 128) phase_prologue(X, L, tid, wid, lane); if (REP_MASK & 128) { __syncthreads(); phase_prologue(X, L, tid, wid, lane); } continue; }
        const int l = (ph - 1) / 7, k = (ph - 1) % 7;
        {
        if (k == 0 && (PH_MASK & 1)) {
            pg8::Gemm g{X.XB, X.WinT + (size_t)l * NIN * DM, M, NPROJ, DM}; pg8::StaticOrder S; S.init(M, NPROJ, G, bx);
            EpiProj E{X.PROJ, X.SSP, L + 131072};
            pg8::gemm_phase<EpiProj, pg8::StaticOrder, true, true>(L, g, S, E, tid);
            if (l == 0 && rep == 0) idle_weight_items(X, L, 0, 130 * 13, G, bx, wid, lane);
        } else if (k == 1 && (PH_MASK & 2)) {
            for (int u = bx; u < 512; u += G) {
                __syncthreads(); asm volatile("" : "+v"(tid)); const int lane = tid & 63, wid = __builtin_amdgcn_readfirstlane(tid >> 6);
                if (rep && REP_SUB == 1 && u >= 256) continue; if (rep && REP_SUB == 2 && u < 256) continue;
                if (u < 256) { if (UN_MASK & 8) ssd_states_unit(X, l, u >> 6, u & 63, L, tid, wid, lane); }
                else { if (UN_MASK & 16) ssd_sample_unit(X, l, (u - 256) >> 1, (u - 256) & 1, L, tid, wid, lane); }
            }
        } else if (k == 2 && (PH_MASK & 4)) {
#define PHB_SYNC() do { __syncthreads(); asm volatile("" : "+v"(tid)); } while (0)
            for (int u = bx; u < 256; u += G) { PHB_SYNC(); const int lane = tid & 63, wid = __builtin_amdgcn_readfirstlane(tid >> 6); attn_prompt_unit(X, l, u >> 6, u & 63, L, tid, wid, lane); }
            for (int u = bx; u < 128; u += G) { PHB_SYNC(); const int lane = tid & 63, wid = __builtin_amdgcn_readfirstlane(tid >> 6); attn_sample_unit(X, l, u, L, tid, wid, lane); }
            {
                int s0 = bx, sn = bx < 512 ? (512 - bx + G - 1) / G : 0, ss = G;
                if (G == 256) { if (bx < 128) { s0 = bx; sn = 1; ss = 1; } else { s0 = 128 + 3 * (bx - 128); sn = 3; ss = 1; } }
                if (rep == 0) for (int i2 = 0; i2 < sn; ++i2) scan_unit(X, l, s0 + i2 * ss, tid);
            }
        } else if (k == 3 && (PH_MASK & 8)) {
            for (int u = bx; u < 256; u += G) { __syncthreads(); asm volatile("" : "+v"(tid)); const int lane = tid & 63, wid = __builtin_amdgcn_readfirstlane(tid >> 6); if (rep && REP_SUB != 0) ssd_out_unit<REP_SUB>(X, l, u >> 6, u & 63, L, tid, wid, lane); else ssd_out_unit<0>(X, l, u >> 6, u & 63, L, tid, wid, lane); }
        } else if (k == 4 && (PH_MASK & 16)) {
            pg8::Gemm g{X.YMIX, X.WoutT + (size_t)l * DM * NMIX, MP, DM, NMIX}; pg8::StaticOrder S; S.init(MP, DM, G, bx);
            EpiResT<true> E{X.XB, nullptr, X.SSP, X.RS};
            pg8::gemm_phase<EpiResT<true>, pg8::StaticOrder, true, true>(L, g, S, E, tid);
            for (int u = bx; u < 256; u += G) small_res_unit(X.YMIX, X.WoutT + (size_t)l * DM * NMIX, NMIX, nullptr, X.XB, X.SSP, u, L, tid, wid, lane);
#if (REP_MASK & 256)
            if (l == 0) for (int rr = 0; rr < 4; ++rr) for (int u = bx; u < 256; u += G) small_res_unit(X.YMIX, X.WoutT + (size_t)l * DM * NMIX, NMIX, nullptr, X.XB, X.SSP, u, L, tid, wid, lane);
#endif
        } else if (k == 5 && (PH_MASK & 32)) {
            pg8::Gemm g{X.XB, X.WguT + (size_t)l * NGU * DM, M, NGU, DM}; pg8::StaticOrder S; S.init(M, NGU, G, bx);
            EpiSwiglu E{HB, X.SSP, L + 131072};
            pg8::gemm_phase<EpiSwiglu, pg8::StaticOrder, true, true>(L, g, S, E, tid);
            if (l == 0 && rep == 0) idle_weight_items(X, L, 1, 130 * 22, G, bx, wid, lane);
        } else if (PH_MASK & 64) {
            pg8::Gemm g{HB, X.WdnT + (size_t)l * DM * DFF, MP, DM, DFF}; pg8::StaticOrder S; S.init(MP, DM, G, bx);
            EpiResT<false> E{X.XB, l == NL - 1 ? X.out : nullptr, X.SSP, nullptr};
            pg8::gemm_phase<EpiResT<false>, pg8::StaticOrder, true, true>(L, g, S, E, tid);
            for (int u = bx; u < 256; u += G) small_res_unit(HB, X.WdnT + (size_t)l * DM * DFF, DFF, l == NL - 1 ? X.out : nullptr, X.XB, X.SSP, u, L, tid, wid, lane);
        }
        }
    }
}

#ifndef MK_ONE_LAUNCH
#define MK_ONE_LAUNCH 1
#endif
extern "C" void kernel_launch(void* const* d_in, const int* in_sizes, int n_in, void* d_out, int out_size, void* d_ws, size_t ws_size, hipStream_t stream) {
    static int grid = 0;
    if (grid == 0) {
        if (n_in != 21 || (size_t)out_size != O_END || ws_size < WS_BAR + SZ_BAR) { fprintf(stderr, "kernel_launch: unexpected shapes (n_in %d out %d ws %zu)\n", n_in, out_size, ws_size); grid = -1; return; }
        int dev = 0, cus = 0, per_cu = 0;
        (void)hipGetDevice(&dev); (void)hipDeviceGetAttribute(&cus, hipDeviceAttributeMultiprocessorCount, dev);
        if (hipFuncSetAttribute((const void*)hymba_mk, hipFuncAttributeMaxDynamicSharedMemorySize, LDS_BYTES) != hipSuccess) { fprintf(stderr, "kernel_launch: hipFuncSetAttribute failed\n"); grid = -1; return; }
        if (hipOccupancyMaxActiveBlocksPerMultiprocessor(&per_cu, (const void*)hymba_mk, 512, LDS_BYTES) != hipSuccess || per_cu < 1) { fprintf(stderr, "kernel_launch: occupancy query gave %d\n", per_cu); per_cu = 1; }
        (void)hipGetLastError();
        grid = cus * per_cu;
    }
    if (grid < 0) return;
    Params p{};
    for (int i = 0; i < 21; ++i) p.in[i] = (const float*)d_in[i];
    p.out = (float*)d_out; p.ws = (unsigned char*)d_ws;
#if MK_ONE_LAUNCH
    p.ph_lo = 0; p.ph_hi = N_PHASES;
    (void)hipMemsetAsync((unsigned char*)d_ws + WS_BAR, 0, SZ_BAR, stream);
    void* args[] = {&p};
    hipError_t e = hipLaunchCooperativeKernel((const void*)hymba_mk, dim3(grid), dim3(512), args, LDS_BYTES, stream);
    if (e != hipSuccess) fprintf(stderr, "cooperative launch failed: %s (grid %d)\n", hipGetErrorString(e), grid);
#else
    for (int ph = 0; ph < N_PHASES; ++ph) { p.ph_lo = ph; p.ph_hi = ph + 1; hipLaunchKernelGGL(hymba_mk, dim3(grid), dim3(512), LDS_BYTES, stream, p); }
#endif
}
```

```cpp
#include <hip/hip_runtime.h>
#include <hip/hip_cooperative_groups.h>
#include <cstdio>
#include <cstdint>
#include <cmath>
namespace cg = cooperative_groups;
namespace pg8 {
#define PG8_LAS __attribute__((address_space(3)))
typedef unsigned short bf16_t;
typedef short bf16x8 __attribute__((ext_vector_type(8)));
typedef float f32x4 __attribute__((ext_vector_type(4)));
typedef unsigned u32x4 __attribute__((ext_vector_type(4)));
constexpr int BM = 256, BK = 64, HALF = 128, HTB = HALF * BK * 2  , STAGE_BYTES = 8 * HTB, NXCD = 8, WGM = 8;

__host__ __device__ __forceinline__ int lds_byte(int r, int c) { const int st = (r >> 4) * 2 + (c >> 5), rr = r & 15, cc = c & 31, ob = rr * 64 + cc * 2; return st * 1024 + (ob ^ (((ob >> 9) & 1) << 5)); }
__host__ __device__ __forceinline__ void stage_rc(int b, int& R, int& C) { const int st = b / 1024, sb = b % 1024, swz = sb ^ (((sb >> 9) & 1) << 5); R = (st >> 1) * 16 + swz / 64; C = (st & 1) * 32 + (swz % 64) / 2; }
__host__ __device__ __forceinline__ int perm32(int rho) { const int n = rho >> 4, i = rho & 15; return 8 * (i >> 2) + 4 * n + (i & 3); }

struct Unit { int pm, pn; };
struct Gemm { const bf16_t* A; const bf16_t* Bt; int M, N, K; };

struct StaticOrder {
    int nM, nN, nwg, G, c;
    __host__ __device__ void init(int M, int N, int G_, int c_) { nM = M / BM; nN = N / BM; nwg = nM * nN; G = G_; c = c_; }
    __host__ __device__ bool next(int i, Unit& u) const {
        const long L = (long)i * G + c; if (L >= nwg) return false;
        int wgid = (int)L; { const int q = nwg / NXCD, r = nwg % NXCD, xcd = wgid % NXCD, off = wgid / NXCD; wgid = (xcd < r ? xcd * (q + 1) : r * (q + 1) + (xcd - r) * q) + off; }
        const int nig = WGM * nN, gid = wgid / nig, fm = gid * WGM, gsz = (nM - fm) < WGM ? (nM - fm) : WGM;
        u.pm = fm + ((wgid % nig) % gsz); u.pn = (wgid % nig) / gsz; return true;
    }
    __device__ __forceinline__ void a_ready(const Unit&) const {}
    __device__ __forceinline__ void done(const Unit&) const {}
};
__device__ __forceinline__ unsigned cvt_pk_bf16(float lo, float hi) { unsigned r; asm volatile("v_cvt_pk_bf16_f32 %0, %1, %2" : "=v"(r) : "v"(lo), "v"(hi)); return r; }
typedef float f32x2 __attribute__((ext_vector_type(2)));
template <class Epi, class Sched, bool ALIGN_EPI = false, bool SP2 = false>
__device__ __forceinline__ void gemm_phase(PG8_LAS unsigned char* lds, const Gemm g, const Sched& S, const Epi& E, const int tid) {
    const int wid = __builtin_amdgcn_readfirstlane(tid >> 6), lane = tid & 63, wr = wid >> 2, wc = wid & 3, fr = lane & 15, fq = lane >> 4;
    const int K = g.K, nt = K / BK;
    unsigned voffA[2], voffB[2];
#pragma unroll
    for (int i = 0; i < 2; ++i) { int R, C; stage_rc(tid * 16 + i * 8192, R, C); const int Rb = Epi::PERM ? ((R & ~31) + perm32(R & 31)) : R;
        voffA[i] = (unsigned)(R * K + C) * 2u; voffB[i] = (unsigned)(Rb * K + C) * 2u; }
    const size_t kstep = (size_t)(BK * 2);
    const size_t hstep = (size_t)HALF * K * 2;
    const size_t tstep = 2 * hstep;
    const unsigned ldsw = (unsigned)wid * 1024u;
    const int aoff = lds_byte(wr * 64 + fr, fq * 8), boff = lds_byte(wc * 32 + fr, fq * 8);
#define PG8_SA(b, h) (((b) * 2 + (h)) * HTB)
#define PG8_SB(b, h) ((4 + (b) * 2 + (h)) * HTB)
#define PG8_STAGE(bufoff, gbase, voff) do { _Pragma("unroll") for (int _i = 0; _i < 2; ++_i) \
        __builtin_amdgcn_global_load_lds((const unsigned*)((const char*)(gbase) + (voff)[_i]), (PG8_LAS unsigned*)(lds + (bufoff) + ldsw + _i * 8192), 16, 0, 0); } while (0)
#define PG8_LDA(dst, b, h) do { _Pragma("unroll") for (int m = 0; m < 4; ++m) _Pragma("unroll") for (int k = 0; k < 2; ++k) dst[m][k] = *(const PG8_LAS bf16x8*)(lds + PG8_SA(b, h) + aoff + m * 2048 + k * 1024); } while (0)
#define PG8_LDB(dst, b, h) do { _Pragma("unroll") for (int n = 0; n < 2; ++n) _Pragma("unroll") for (int k = 0; k < 2; ++k) dst[n][k] = *(const PG8_LAS bf16x8*)(lds + PG8_SB(b, h) + boff + n * 2048 + k * 1024); } while (0)
#define PG8_MMA(ai, bj, At, Bt) do { __builtin_amdgcn_s_setprio(1); _Pragma("unroll") for (int m = 0; m < 4; ++m) _Pragma("unroll") for (int n = 0; n < 2; ++n) _Pragma("unroll") for (int k = 0; k < 2; ++k) \
        acc[ai][bj][m][n] = __builtin_amdgcn_mfma_f32_16x16x32_bf16(Bt[n][k], At[m][k], acc[ai][bj][m][n], 0, 0, 0); __builtin_amdgcn_s_setprio(0); } while (0)
#define PG8_WAIT_V(n) asm volatile("s_waitcnt vmcnt(" #n ")" ::: "memory")
#define PG8_WAIT_L(n) asm volatile("s_waitcnt lgkmcnt(" #n ")" ::: "memory")
#define PG8_BAR __builtin_amdgcn_s_barrier()
#define PG8_SCHED __builtin_amdgcn_sched_barrier(0)
    Unit cur, nxt; int ui = 0;
    if (!S.next(0, cur)) return;
    f32x4 acc[2][2][4][2];
#pragma unroll
    for (int a = 0; a < 2; ++a)
#pragma unroll
        for (int b = 0; b < 2; ++b)
#pragma unroll
            for (int m = 0; m < 4; ++m)
#pragma unroll
                for (int n = 0; n < 2; ++n) acc[a][b][m][n] = (f32x4){0.f, 0.f, 0.f, 0.f};
    bf16x8 At[4][2], B0[2][2], B1[2][2];
    const char* cA = (const char*)g.A + (size_t)cur.pm * tstep; const char* cB = (const char*)g.Bt + (size_t)cur.pn * tstep;
    S.a_ready(cur);
    if constexpr (SP2) {
        PG8_STAGE(PG8_SB(0, 0), cB, voffB); PG8_STAGE(PG8_SB(0, 1), cB + hstep, voffB); PG8_STAGE(PG8_SA(0, 0), cA, voffA); PG8_STAGE(PG8_SA(0, 1), cA + hstep, voffA);
        if (wr == 1) PG8_BAR;
        PG8_WAIT_V(2); PG8_BAR;
        PG8_STAGE(PG8_SB(1, 0), cB + kstep, voffB); PG8_STAGE(PG8_SA(1, 0), cA + kstep, voffA); PG8_STAGE(PG8_SB(1, 1), cB + hstep + kstep, voffB);
        PG8_WAIT_V(6); PG8_BAR;
    } else {
        PG8_STAGE(PG8_SB(0, 0), cB, voffB); PG8_STAGE(PG8_SA(0, 0), cA, voffA); PG8_STAGE(PG8_SB(0, 1), cB + hstep, voffB); PG8_STAGE(PG8_SA(0, 1), cA + hstep, voffA);
        if (wr == 1) PG8_BAR;
        PG8_WAIT_V(4); PG8_BAR;
        PG8_STAGE(PG8_SB(1, 0), cB + kstep, voffB); PG8_STAGE(PG8_SA(1, 0), cA + kstep, voffA); PG8_STAGE(PG8_SB(1, 1), cB + hstep + kstep, voffB);
        PG8_WAIT_V(6); PG8_BAR;
    }
    for (;;) {
        const bool has_next = S.next(ui + 1, nxt);
        const char* nA = has_next ? (const char*)g.A + (size_t)nxt.pm * tstep : cA; const char* nB = has_next ? (const char*)g.Bt + (size_t)nxt.pn * tstep : cB;
        for (int t = 0; t < nt; t += 2) {
            const bool last = (t == nt - 2);
            const char* a1 = cA + (size_t)(t + 1) * kstep;
            const char* a2 = last ? nA : cA + (size_t)(t + 2) * kstep; const char* b2 = last ? nB : cB + (size_t)(t + 2) * kstep;
            const char* a3 = a2 + kstep; const char* b3 = b2 + kstep;
            if (last && has_next) S.a_ready(nxt);
            if constexpr (Epi::KSCALE) E.kscale(acc, t, cur, wr, fr);
            if constexpr (SP2) {
            PG8_LDB(B0, 0, 0); PG8_LDB(B1, 0, 1); PG8_SCHED; PG8_LDA(At, 0, 0); PG8_STAGE(PG8_SA(1, 1), a1 + hstep, voffA);
            PG8_WAIT_V(8); PG8_WAIT_L(0); PG8_BAR; PG8_MMA(0, 0, At, B0); PG8_MMA(0, 1, At, B1); PG8_BAR; PG8_SCHED;
            PG8_LDA(At, 0, 1); PG8_STAGE(PG8_SB(0, 0), b2, voffB); PG8_STAGE(PG8_SB(0, 1), b2 + hstep, voffB); PG8_STAGE(PG8_SA(0, 0), a2, voffA);
            PG8_WAIT_V(8); PG8_WAIT_L(0); PG8_BAR; PG8_MMA(1, 0, At, B0); PG8_MMA(1, 1, At, B1); PG8_BAR; PG8_SCHED;
            PG8_LDB(B0, 1, 0); PG8_LDB(B1, 1, 1); PG8_SCHED; PG8_LDA(At, 1, 0); PG8_STAGE(PG8_SA(0, 1), a2 + hstep, voffA);
            PG8_WAIT_V(8); PG8_WAIT_L(0); PG8_BAR; PG8_MMA(0, 0, At, B0); PG8_MMA(0, 1, At, B1); PG8_BAR; PG8_SCHED;
            PG8_LDA(At, 1, 1); PG8_STAGE(PG8_SB(1, 0), b3, voffB); PG8_STAGE(PG8_SB(1, 1), b3 + hstep, voffB); PG8_STAGE(PG8_SA(1, 0), a3, voffA);
            PG8_WAIT_V(8); PG8_WAIT_L(0); PG8_BAR; PG8_MMA(1, 0, At, B0); PG8_MMA(1, 1, At, B1); PG8_BAR; PG8_SCHED;
            } else {
            PG8_LDB(B0, 0, 0); PG8_SCHED; PG8_LDA(At, 0, 0); PG8_STAGE(PG8_SA(1, 1), a1 + hstep, voffA);
            PG8_WAIT_L(8); PG8_BAR; PG8_WAIT_L(0); PG8_MMA(0, 0, At, B0); PG8_BAR; PG8_SCHED;
            PG8_LDB(B1, 0, 1); PG8_STAGE(PG8_SB(0, 0), b2, voffB);
            PG8_BAR; PG8_WAIT_L(0); PG8_MMA(0, 1, At, B1); PG8_BAR;
            PG8_LDA(At, 0, 1); PG8_STAGE(PG8_SA(0, 0), a2, voffA);
            PG8_BAR; PG8_WAIT_L(0); PG8_MMA(1, 0, At, B0); PG8_BAR; PG8_SCHED;
            PG8_STAGE(PG8_SB(0, 1), b2 + hstep, voffB);
            PG8_WAIT_V(6); PG8_BAR; PG8_MMA(1, 1, At, B1); PG8_BAR;
            PG8_LDB(B0, 1, 0); PG8_SCHED; PG8_LDA(At, 1, 0); PG8_STAGE(PG8_SA(0, 1), a2 + hstep, voffA);
            PG8_WAIT_L(8); PG8_BAR; PG8_WAIT_L(0); PG8_MMA(0, 0, At, B0); PG8_BAR; PG8_SCHED;
            PG8_LDB(B1, 1, 1); PG8_STAGE(PG8_SB(1, 0), b3, voffB);
            PG8_BAR; PG8_WAIT_L(0); PG8_MMA(0, 1, At, B1); PG8_BAR;
            PG8_LDA(At, 1, 1); PG8_STAGE(PG8_SA(1, 0), a3, voffA);
            PG8_BAR; PG8_WAIT_L(0); PG8_MMA(1, 0, At, B0); PG8_BAR; PG8_SCHED;
            PG8_STAGE(PG8_SB(1, 1), b3 + hstep, voffB);
            PG8_WAIT_V(6); PG8_BAR; PG8_MMA(1, 1, At, B1); PG8_BAR;
            }
        }
        if constexpr (ALIGN_EPI) { if (wr == 0) PG8_BAR; }
        if constexpr (!Epi::AFTER_DRAIN) { E(acc, cur, wr, wc, fr, fq); S.done(cur); }
        if (!has_next) break;
#pragma unroll
        for (int a = 0; a < 2; ++a)
#pragma unroll
            for (int b = 0; b < 2; ++b)
#pragma unroll
                for (int m = 0; m < 4; ++m)
#pragma unroll
                    for (int n = 0; n < 2; ++n) acc[a][b][m][n] = (f32x4){0.f, 0.f, 0.f, 0.f};
        cur = nxt; cA = nA; cB = nB; ++ui;
        if constexpr (ALIGN_EPI) { if (wr == 1) PG8_BAR; }
    }
    PG8_WAIT_V(0);
    if constexpr (!ALIGN_EPI) { if (wr == 0) PG8_BAR; }
    PG8_BAR;
    if constexpr (Epi::AFTER_DRAIN) { E.fused(acc, cur, wr, wc, fr, fq, lds, wid, lane); S.done(cur); }
#undef PG8_SA
#undef PG8_SB
#undef PG8_STAGE
#undef PG8_LDA
#undef PG8_LDB
#undef PG8_MMA
#undef PG8_WAIT_V
#undef PG8_WAIT_L
#undef PG8_BAR
#undef PG8_SCHED
}
}
#define LAS __attribute__((address_space(3)))
typedef unsigned short u16;
typedef short bf16x8 __attribute__((ext_vector_type(8)));
typedef float f32x4 __attribute__((ext_vector_type(4)));
typedef unsigned u32x4 __attribute__((ext_vector_type(4)));
typedef unsigned u32x2 __attribute__((ext_vector_type(2)));
typedef LAS unsigned char* ldsp;

constexpr int DM = 1024, NL = 2;
constexpr int MP = 4 * 8192, MS = 128 * 4, M = MP + MS;
constexpr int NPROJ = 3328, NIN = 3344, NMIX = 1536, DFF = 2816, NGU = 5632;
constexpr int C_K = 512, C_V = 640, C_Z = 768, C_X = 1792, C_B = 2816, C_C = 3072;
constexpr float EPS = 1e-6f;
constexpr int NPOS = 8196;

constexpr size_t WS_WIN = 0;
constexpr size_t SZ_WIN = (size_t)NIN * DM * 2;
constexpr size_t WS_WOUT = WS_WIN + NL * SZ_WIN;
constexpr size_t SZ_WOUT = (size_t)DM * NMIX * 2;
constexpr size_t WS_WGU = WS_WOUT + NL * SZ_WOUT;
constexpr size_t SZ_WGU = (size_t)NGU * DM * 2;
constexpr size_t WS_WDN = WS_WGU + NL * SZ_WGU;
constexpr size_t SZ_WDN = (size_t)DM * DFF * 2;
constexpr size_t WS_ROPE = WS_WDN + NL * SZ_WDN;
constexpr size_t SZ_ROPE = (size_t)NPOS * 32 * 4;
constexpr size_t WS_XB = WS_ROPE + 2 * SZ_ROPE;
constexpr size_t WS_SSP = WS_XB + (size_t)M * DM * 2;
constexpr size_t WS_PROJ = WS_SSP + (size_t)M * 16 * 4;
constexpr size_t WS_YMIX = WS_PROJ + (size_t)M * NPROJ * 2;
constexpr size_t WS_DT = WS_YMIX + (size_t)M * NMIX * 2;
constexpr size_t WS_CD = WS_DT + (size_t)MP * 16 * 4;
constexpr size_t WS_ST = WS_CD + (size_t)4 * 64 * 16 * 4;
constexpr size_t WS_END = WS_ST + (size_t)4 * 64 * 16 * 64 * 128 * 2;
constexpr size_t WS_RS = WS_END;
constexpr size_t WS_BAR = WS_RS + (size_t)MP * 2 * 4, SZ_BAR = 16384;
static_assert(WS_BAR + SZ_BAR <= (size_t)4 * MP * DM * 4 && WS_BAR % 256 == 0, "workspace");
static_assert(WS_XB % 256 == 0 && WS_SSP % 256 == 0 && WS_PROJ % 256 == 0 && WS_YMIX % 256 == 0 && WS_DT % 256 == 0 && WS_ST % 256 == 0 && WS_ROPE % 256 == 0, "align");

constexpr size_t O_Y = 0;
constexpr size_t O_KP = (size_t)M * DM;
constexpr size_t O_VP = O_KP + (size_t)2 * 4 * 128 * 128;
constexpr size_t O_CP = O_VP + (size_t)2 * 4 * 128 * 128;
constexpr size_t O_HP = O_CP + (size_t)2 * 4 * 3 * 1536;
constexpr size_t O_KS = O_HP + (size_t)2 * 4 * 16 * 64 * 128;
constexpr size_t O_VS = O_KS + (size_t)2 * 128 * 128 * 128;
constexpr size_t O_CS = O_VS + (size_t)2 * 128 * 128 * 128;
constexpr size_t O_HS = O_CS + (size_t)2 * 128 * 3 * 1536;
constexpr size_t O_END = O_HS + (size_t)2 * 128 * 16 * 64 * 128;

constexpr int LDS_BYTES = 147456;

enum { I_XP = 0, I_XS, I_CK, I_CV, I_SCONV, I_SSSM, I_NMIX, I_WIN, I_QN, I_KN, I_SINK, I_CW, I_CB, I_DTB, I_ALOG, I_DSK, I_SNORM, I_WOUT, I_NFFN, I_WGU, I_WDN };

struct Params { const float* in[21]; float* out; unsigned char* ws; int ph_lo, ph_hi; };

typedef float f32x2_t __attribute__((ext_vector_type(2))); typedef __bf16 bf16x2_t __attribute__((ext_vector_type(2)));
__device__ __forceinline__ unsigned pk2(float lo, float hi) { f32x2_t v = {lo, hi}; bf16x2_t b = __builtin_convertvector(v, bf16x2_t); return __builtin_bit_cast(unsigned, b); }
__device__ __forceinline__ unsigned f2bf(float f) { return pk2(f, 0.f) & 0xffffu; }
__device__ __forceinline__ float bf2f(unsigned h) { return __builtin_bit_cast(float, h << 16); }
__device__ __forceinline__ float bflo(unsigned w) { return __builtin_bit_cast(float, w << 16); }
__device__ __forceinline__ float bfhi(unsigned w) { return __builtin_bit_cast(float, w & 0xffff0000u); }
__device__ __forceinline__ float silu_f(float x) { return x * __builtin_amdgcn_rcpf(1.f + __expf(-x)); }
__device__ __forceinline__ float softplus_f(float x) { return x > 15.f ? x : log1pf(__expf(x)); }
__device__ __forceinline__ float wave_sum(float v) {
#pragma unroll
    for (int o = 1; o < 64; o <<= 1) v += __shfl_xor(v, o);
    return v;
}
__device__ __forceinline__ float wave_max(float v) {
#pragma unroll
    for (int o = 1; o < 64; o <<= 1) v = fmaxf(v, __shfl_xor(v, o));
    return v;
}
__device__ __forceinline__ float wave_incl_scan(float v, int lane) {
#pragma unroll
    for (int off = 1; off < 64; off <<= 1) { const float t = __shfl_up(v, off); if (lane >= off) v += t; }
    return v;
}
__device__ __forceinline__ bf16x8 mk8(u32x2 lo, u32x2 hi) { u32x4 w; w.x = lo.x; w.y = lo.y; w.z = hi.x; w.w = hi.y; return __builtin_bit_cast(bf16x8, w); }
__device__ __forceinline__ bf16x8 lds16(ldsp p) { return __builtin_bit_cast(bf16x8, *(LAS u32x4*)p); }
__device__ __forceinline__ bf16x8 lds8x2(ldsp p0, ldsp p1) { return mk8(*(LAS u32x2*)p0, *(LAS u32x2*)p1); }
__device__ __forceinline__ f32x4 mfma16(bf16x8 a, bf16x8 b, f32x4 c) { return __builtin_amdgcn_mfma_f32_16x16x32_bf16(a, b, c, 0, 0, 0); }
#define LDS_WAIT() asm volatile("s_waitcnt lgkmcnt(0)" ::: "memory")

__device__ __forceinline__ float rstd_row(const float* ssp, int row) {
    const f32x4* p = (const f32x4*)(ssp + (size_t)row * 16);
    const f32x4 a = p[0], b = p[1], c = p[2], d = p[3];
    const float s = (((a.x + a.y) + (a.z + a.w)) + ((b.x + b.y) + (b.z + b.w))) + (((c.x + c.y) + (c.z + c.w)) + ((d.x + d.y) + (d.z + d.w)));
    return rsqrtf(s * (1.f / 1024.f) + EPS);
}

struct EpiProj {
    static constexpr bool PERM = true, AFTER_DRAIN = false, KSCALE = false;
    u16* O; const float* ssp; ldsp rsl;
    __device__ __forceinline__ void operator()(const pg8::f32x4 (&acc)[2][2][4][2], const pg8::Unit& u, int wr, int wc, int fr, int fq) const {
        const int row0 = u.pm * 256 + wr * 64 + fr, col0 = u.pn * 256 + wc * 32 + 8 * fq;
        { const int t = wc * 64 + fq * 16 + fr; if (wr == 0) ((LAS float*)rsl)[t] = rstd_row(ssp, u.pm * 256 + t);
          asm volatile("s_waitcnt lgkmcnt(0)" ::: "memory"); __builtin_amdgcn_s_barrier(); asm volatile("" ::: "memory"); }
#pragma unroll
        for (int ai = 0; ai < 2; ++ai)
#pragma unroll
            for (int m = 0; m < 4; ++m) {
                const int row = row0 + ai * 128 + m * 16; const float rs = ((LAS float*)rsl)[wr * 64 + fr + ai * 128 + m * 16]; u16* rowp = O + (size_t)row * NPROJ + col0;
#pragma unroll
                for (int bj = 0; bj < 2; ++bj) {
                    const f32x4 v0 = acc[ai][bj][m][0] * rs, v1 = acc[ai][bj][m][1] * rs; u32x4 w;
                    w.x = pg8::cvt_pk_bf16(v0[0], v0[1]); w.y = pg8::cvt_pk_bf16(v0[2], v0[3]); w.z = pg8::cvt_pk_bf16(v1[0], v1[1]); w.w = pg8::cvt_pk_bf16(v1[2], v1[3]);
                    *(u32x4*)(rowp + bj * 128) = w; }
            }
    }
};
struct EpiSwiglu {
    static constexpr bool PERM = true, AFTER_DRAIN = false, KSCALE = false;
    u16* O; const float* ssp; ldsp rsl;
    __device__ __forceinline__ void operator()(const pg8::f32x4 (&acc)[2][2][4][2], const pg8::Unit& u, int wr, int wc, int fr, int fq) const {
        const int row0 = u.pm * 256 + wr * 64 + fr, col0 = u.pn * 128 + wc * 32 + 8 * fq;
        { const int t = wc * 64 + fq * 16 + fr; if (wr == 0) ((LAS float*)rsl)[t] = rstd_row(ssp, u.pm * 256 + t);
          asm volatile("s_waitcnt lgkmcnt(0)" ::: "memory"); __builtin_amdgcn_s_barrier(); asm volatile("" ::: "memory"); }
#pragma unroll
        for (int ai = 0; ai < 2; ++ai)
#pragma unroll
            for (int m = 0; m < 4; ++m) {
                const int row = row0 + ai * 128 + m * 16; const float rs = ((LAS float*)rsl)[wr * 64 + fr + ai * 128 + m * 16];
                float h[8];
#pragma unroll
                for (int n = 0; n < 2; ++n)
#pragma unroll
                    for (int j = 0; j < 4; ++j) { const float g = acc[ai][0][m][n][j] * rs, up = acc[ai][1][m][n][j] * rs; h[n * 4 + j] = silu_f(g) * up; }
                u32x4 w; w.x = pg8::cvt_pk_bf16(h[0], h[1]); w.y = pg8::cvt_pk_bf16(h[2], h[3]); w.z = pg8::cvt_pk_bf16(h[4], h[5]); w.w = pg8::cvt_pk_bf16(h[6], h[7]);
                *(u32x4*)(O + (size_t)row * DFF + col0) = w;
            }
    }
};
template <bool KS> struct EpiResT {
    static constexpr bool PERM = false, AFTER_DRAIN = false, KSCALE = KS;
    u16* xb; float* outf; float* ssp; const float* rs;
    __device__ __forceinline__ void kscale(pg8::f32x4 (&acc)[2][2][4][2], int t, const pg8::Unit& u, int wr, int fr) const {
        if (t != 8 && t != 16) return;
#pragma unroll
        for (int ai = 0; ai < 2; ++ai)
#pragma unroll
            for (int m = 0; m < 4; ++m) {
                const int row = u.pm * 256 + wr * 64 + fr + ai * 128 + m * 16; const float s0 = rs[2 * row], s1 = rs[2 * row + 1];
                const float f = t == 8 ? s0 * __builtin_amdgcn_rcpf(s1) : s1;
#pragma unroll
                for (int bj = 0; bj < 2; ++bj)
#pragma unroll
                    for (int n = 0; n < 2; ++n) acc[ai][bj][m][n] = acc[ai][bj][m][n] * f;
            }
    }
    __device__ __forceinline__ void operator()(const pg8::f32x4 (&acc)[2][2][4][2], const pg8::Unit& u, int wr, int wc, int fr, int fq) const {
        const int row0 = u.pm * 256 + wr * 64 + fr, col0 = u.pn * 256 + wc * 32 + 4 * fq;
#pragma unroll
        for (int ai = 0; ai < 2; ++ai) {
            u32x2 rw[4][2][2];
#pragma unroll
            for (int m = 0; m < 4; ++m)
#pragma unroll
                for (int bj = 0; bj < 2; ++bj)
#pragma unroll
                    for (int n = 0; n < 2; ++n) rw[m][bj][n] = *(const u32x2*)(xb + (size_t)(row0 + ai * 128 + m * 16) * DM + col0 + bj * 128 + n * 16);
#pragma unroll
            for (int m = 0; m < 4; ++m) {
                const int row = row0 + ai * 128 + m * 16;
                u16* xp = xb + (size_t)row * DM + col0; float ss = 0.f;
#pragma unroll
                for (int bj = 0; bj < 2; ++bj)
#pragma unroll
                    for (int n = 0; n < 2; ++n) {
                        const u32x2 w0 = rw[m][bj][n]; const f32x4 r = {bflo(w0.x), bfhi(w0.x), bflo(w0.y), bfhi(w0.y)}; const f32x4 v = acc[ai][bj][m][n] + r;
                        if (outf) *(f32x4*)(outf + (size_t)row * DM + col0 + bj * 128 + n * 16) = v;
                        u32x2 w; w.x = pg8::cvt_pk_bf16(v[0], v[1]); w.y = pg8::cvt_pk_bf16(v[2], v[3]);
                        *(u32x2*)(xp + bj * 128 + n * 16) = w; ss += (v[0] * v[0] + v[1] * v[1]) + (v[2] * v[2] + v[3] * v[3]); }
                ss += __shfl_xor(ss, 16); ss += __shfl_xor(ss, 32);
                if (fq == 0) ssp[(size_t)row * 16 + u.pn * 4 + wc] = ss;
            }
        }
    }
};
struct Ctx {
    const float* in[21]; float* out; unsigned char* ws;
    u16 *WinT, *WoutT, *WguT, *WdnT; float *COS, *SIN; u16* XB; float* SSP; u16* PROJ; u16* YMIX; float* DT; float* CD; u16* ST; float* RS;
};

__device__ __forceinline__ void tr_item(const float* __restrict__ W, int K, int N, const float* __restrict__ gk, u16* WT, int perm, LAS float* scr, int item, int lane) {
    const int nblk = (N + 31) >> 5, kb = item / nblk, nb = item - kb * nblk, k0 = 64 * kb, n0 = 32 * nb;
    const int kd0 = perm == 2 ? (k0 < 512 ? k0 + 1024 : k0 - 512) : k0;
    const int nn = n0 + (lane & 31);
    float wv[32];
#pragma unroll
    for (int i = 0; i < 32; ++i) { const int kk = 2 * i + (lane >> 5); wv[i] = (nn < N) ? W[(size_t)(k0 + kk) * N + nn] : 0.f; }
#pragma unroll
    for (int i = 0; i < 32; ++i) { const int kk = 2 * i + (lane >> 5); float v = wv[i]; if (gk) { if (perm == 2) { if (k0 >= 512) v *= gk[k0 + kk - 512]; } else v *= gk[k0 + kk]; } scr[kk * 33 + (lane & 31)] = v; }
    LDS_WAIT(); asm volatile("" ::: "memory");
    const int c = lane & 7;
#pragma unroll
    for (int j = 0; j < 4; ++j) {
        const int nl = (lane >> 3) + 8 * j, n = n0 + nl;
        if (n < N) {
            int dr = n; if (perm == 1) { const int up = n >= DFF, f = up ? n - DFF : n; dr = (f >> 7) * 256 + up * 128 + (f & 127); }
            const LAS float* s = scr + (8 * c) * 33 + nl;
            u32x4 o; o.x = pk2(s[0 * 33], s[1 * 33]); o.y = pk2(s[2 * 33], s[3 * 33]); o.z = pk2(s[4 * 33], s[5 * 33]); o.w = pk2(s[6 * 33], s[7 * 33]);
            *(u32x4*)(WT + (size_t)dr * K + kd0 + 8 * c) = o; }
    }
    LDS_WAIT(); asm volatile("" ::: "memory");
}
constexpr int I_IN = (DM / 64) * ((NIN + 31) / 32), I_OUT = (NMIX / 64) * (DM / 32), I_GU = (DM / 64) * (NGU / 32), I_DN = (DFF / 64) * (DM / 32), I_L = I_IN + I_OUT + I_GU + I_DN;
__device__ __forceinline__ void tr_layer_item(const Ctx& X, int l, int r, LAS float* scr, int lane) {
    if (r < I_IN) { tr_item(X.in[I_WIN] + (size_t)l * DM * NIN, DM, NIN, X.in[I_NMIX] + l * DM, X.WinT + (size_t)l * NIN * DM, 0, scr, r, lane); return; } r -= I_IN;
    if (r < I_OUT) { tr_item(X.in[I_WOUT] + (size_t)l * NMIX * DM, NMIX, DM, X.in[I_SNORM] + l * 1024, X.WoutT + (size_t)l * DM * NMIX, 2, scr, r, lane); return; } r -= I_OUT;
    if (r < I_GU) { tr_item(X.in[I_WGU] + (size_t)l * DM * NGU, DM, NGU, X.in[I_NFFN] + l * DM, X.WguT + (size_t)l * NGU * DM, 1, scr, r, lane); return; } r -= I_GU;
    tr_item(X.in[I_WDN] + (size_t)l * DFF * DM, DFF, DM, nullptr, X.WdnT + (size_t)l * DM * DFF, 0, scr, r, lane);
}
__device__ __forceinline__ void idle_weight_items(const Ctx& X, ldsp L, int stage, int nwg, int G, int bx, int wid, int lane) {
    const int nround = (nwg + G - 1) / G, first_idle = nwg - (nround - 1) * G;
    LAS float* scr = (LAS float*)(L + wid * 16384);
    int nw = (G - first_idle) * 8, wi = (bx - first_idle) * 8 + wid;
    if (first_idle >= G) { nw = G * 8; wi = bx * 8 + wid; }
    else if (bx < first_idle) return;
    if (stage == 0) { for (int r = I_IN + wi; r < I_L; r += nw) tr_layer_item(X, 0, r, scr, lane); }
    else { for (int r = wi; r < I_L; r += nw) tr_layer_item(X, 1, r, scr, lane); }
}
__device__ __forceinline__ void phase_prologue(const Ctx& X, ldsp L, int tid, int wid, int lane) {
    LAS float* scr = (LAS float*)(L + wid * 16384);
    const int gw = blockIdx.x * 8 + wid, NGW = gridDim.x * 8;
    for (int it = gw; it < I_IN; it += NGW) tr_layer_item(X, 0, it, scr, lane);
    for (int rb = gw * 4; rb < M; rb += NGW * 4) {
        f32x4 v[4][4];
#pragma unroll
        for (int rr = 0; rr < 4; ++rr) { const int row = rb + rr; const float* xr = row < MP ? X.in[I_XP] + (size_t)row * DM : X.in[I_XS] + (size_t)(row - MP) * DM;
#pragma unroll
            for (int j = 0; j < 4; ++j) v[rr][j] = ((const f32x4*)xr)[lane + 64 * j]; }
#pragma unroll
        for (int rr = 0; rr < 4; ++rr) { const int row = rb + rr; float ss = 0.f;
#pragma unroll
            for (int j = 0; j < 4; ++j) { const f32x4 w4 = v[rr][j]; ss += (w4.x * w4.x + w4.y * w4.y) + (w4.z * w4.z + w4.w * w4.w);
                u32x2 w; w.x = pk2(w4.x, w4.y); w.y = pk2(w4.z, w4.w); ((u32x2*)(X.XB + (size_t)row * DM))[lane + 64 * j] = w; }
            ss = wave_sum(ss);
            if (lane < 16) X.SSP[(size_t)row * 16 + lane] = lane == 0 ? ss : 0.f; }
    }
    for (int idx = blockIdx.x * 512 + tid; idx < NPOS * 32; idx += gridDim.x * 512) {
        const int pi = idx >> 5, j = idx & 31; const float pos = pi < 8192 ? (float)pi : (float)(16384 + pi - 8192);
        const float inv = powf(10000.f, -(float)j * (1.f / 32.f));
        float sv, cv; sincosf(pos * inv, &sv, &cv); X.COS[idx] = cv; X.SIN[idx] = sv;
    }
}

struct ConvCol { float w0, w1, w2, w3, bias, a, b, c; const u16* p; };
__device__ __forceinline__ void conv_init(ConvCol& cc, const u16* proj, int row, bool havePrev, int xcol, const float* cw, const float* cb) {
    cc.w0 = cw[xcol]; cc.w1 = cw[1536 + xcol]; cc.w2 = cw[2 * 1536 + xcol]; cc.w3 = cw[3 * 1536 + xcol]; cc.bias = cb[xcol];
    cc.p = proj + (size_t)row * NPROJ + C_X + xcol;
    cc.a = havePrev ? bf2f(cc.p[-3 * NPROJ]) : 0.f; cc.b = havePrev ? bf2f(cc.p[-2 * NPROJ]) : 0.f; cc.c = havePrev ? bf2f(cc.p[-1 * NPROJ]) : 0.f;
}
__device__ __forceinline__ float conv_step(ConvCol& cc) {
    const float d = bf2f(*cc.p); cc.p += NPROJ;
    const float v = fmaf(cc.a, cc.w0, fmaf(cc.b, cc.w1, fmaf(cc.c, cc.w2, fmaf(d, cc.w3, cc.bias))));
    cc.a = cc.b; cc.b = cc.c; cc.c = d; return silu_f(v);
}

struct ConvW { float w0, w1, w2, w3, bias; };
__device__ __forceinline__ ConvW conv_w(const float* cw, const float* cb, int xcol) { ConvW w; w.w0 = cw[xcol]; w.w1 = cw[1536 + xcol]; w.w2 = cw[2 * 1536 + xcol]; w.w3 = cw[3 * 1536 + xcol]; w.bias = cb[xcol]; return w; }
template <int NS> __device__ __forceinline__ void conv_load(float (&raw)[NS + 3], const u16* proj, int row, bool havePrev, int xcol) {
    const u16* p = proj + (size_t)row * NPROJ + C_X + xcol;
#pragma unroll
    for (int k = 0; k < NS + 3; ++k) { unsigned v = 0u; if (k >= 3 || havePrev) v = p[(k - 3) * NPROJ]; raw[k] = bf2f(v); }
}
__device__ __forceinline__ float conv_tap(const ConvW& w, float a, float b, float c, float d) { return silu_f(fmaf(a, w.w0, fmaf(b, w.w1, fmaf(c, w.w2, fmaf(d, w.w3, w.bias))))); }

struct ConvW4 { f32x4 w0, w1, w2, w3, bias; };
__device__ __forceinline__ ConvW4 conv4_w(const float* cw, const float* cb, int xcol0) { ConvW4 w; w.w0 = *(const f32x4*)(cw + xcol0); w.w1 = *(const f32x4*)(cw + 1536 + xcol0); w.w2 = *(const f32x4*)(cw + 2 * 1536 + xcol0); w.w3 = *(const f32x4*)(cw + 3 * 1536 + xcol0); w.bias = *(const f32x4*)(cb + xcol0); return w; }
template <int NT> __device__ __forceinline__ void conv4_load(float (&raw)[NT + 3][4], const u16* proj, int row, bool havePrev, int xcol0) {
    const u16* p = proj + (size_t)row * NPROJ + C_X + xcol0;
#pragma unroll
    for (int k = 0; k < NT + 3; ++k) { u32x2 v = {0u, 0u}; if (k >= 3 || havePrev) v = *(const u32x2*)(p + (k - 3) * NPROJ); raw[k][0] = bflo(v.x); raw[k][1] = bfhi(v.x); raw[k][2] = bflo(v.y); raw[k][3] = bfhi(v.y); }
}
#define CONV4_TAP(w, raw, k, e) silu_f(fmaf(raw[(k)][e], w.w0[e], fmaf(raw[(k) + 1][e], w.w1[e], fmaf(raw[(k) + 2][e], w.w2[e], fmaf(raw[(k) + 3][e], w.w3[e], w.bias[e])))))
__device__ __forceinline__ void acum_scan(LAS float* DTL, LAS float* ACL, const float* alog, int wid, int lane) {
#pragma unroll
    for (int hh = 0; hh < 2; ++hh) {
        const int h = 2 * wid + hh; const float A = -expf(alog[h]);
        float v0 = DTL[h * 128 + lane] * A, v1 = DTL[h * 128 + 64 + lane] * A;
        v0 = wave_incl_scan(v0, lane); v1 = wave_incl_scan(v1, lane); v1 += __shfl(v0, 63);
        ACL[h * 128 + lane] = v0; ACL[h * 128 + 64 + lane] = v1;
    }
}

constexpr int XTP = 132;
__device__ __forceinline__ void ssd_states_unit(const Ctx& X, int l, int b, int c, ldsp L, int tid, int wid, int lane) {
    LAS float* DTL = (LAS float*)L; LAS float* ACL = (LAS float*)(L + 8192);
    LAS u16* BT = (LAS u16*)(L + 16384);
    LAS u16* XT = (LAS u16*)(L + 16384 + 33792);
    const int i = lane & 15, g = lane >> 4, r0 = b * 8192 + c * 128;
    const float* cw = X.in[I_CW] + (size_t)l * 4 * 1536; const float* cb = X.in[I_CB] + (size_t)l * 1536;
    {
        const u16* ap = X.XB + (size_t)(r0 + 16 * wid + i) * DM + 8 * g; const u16* bp = X.WinT + (size_t)l * NIN * DM + (size_t)(NPROJ + i) * DM + 8 * g;
        f32x4 acc = {0.f, 0.f, 0.f, 0.f};
#pragma unroll 16
        for (int kk = 0; kk < 32; ++kk) { const bf16x8 a = *(const bf16x8*)(ap + 32 * kk), w = *(const bf16x8*)(bp + 32 * kk); acc = mfma16(a, w, acc); }
        const float bias = X.in[I_DTB][l * 16 + i];
#pragma unroll
        for (int j = 0; j < 4; ++j) { const int tok = 16 * wid + 4 * g + j; const float dt = softplus_f(acc[j] * rstd_row(X.SSP, r0 + tok) + bias);
            DTL[i * 128 + tok] = dt; X.DT[(size_t)(r0 + tok) * 16 + i] = dt; }
    }
    __syncthreads();
    acum_scan(DTL, ACL, X.in[I_ALOG] + l * 16, wid, lane);
    __syncthreads();
    if (tid < 16) X.CD[(b * 64 + c) * 16 + tid] = __expf(ACL[tid * 128 + 127]);
    LAS float* WSL = (LAS float*)(L + 16384 + 33792 + 67584);
#pragma unroll
    for (int e = 0; e < 4; ++e) { const int idx = tid * 4 + e, h = idx >> 7; WSL[idx] = DTL[idx] * __expf(ACL[h * 128 + 127] - ACL[idx]); }
    __syncthreads();
    for (int hq = 0; hq < 4; ++hq) {
        const int grp = hq >> 1;
        if ((hq & 1) == 0) {
            const int cg = lane & 31, tok0 = 16 * wid + 8 * (lane >> 5), xcol0 = 1024 + 128 * grp + 4 * cg; const ConvW4 w = conv4_w(cw, cb, xcol0);
            float raw[11][4]; conv4_load<8>(raw, X.PROJ, r0 + tok0, !(c == 0 && tok0 == 0), xcol0);
#pragma unroll
            for (int e = 0; e < 4; ++e)
#pragma unroll
                for (int kq = 0; kq < 2; ++kq) { u32x2 pw; pw.x = pk2(CONV4_TAP(w, raw, 4 * kq, e), CONV4_TAP(w, raw, 4 * kq + 1, e)); pw.y = pk2(CONV4_TAP(w, raw, 4 * kq + 2, e), CONV4_TAP(w, raw, 4 * kq + 3, e));
                    *(LAS u32x2*)(BT + (4 * cg + e) * XTP + tok0 + 4 * kq) = pw; }
        }
        {
            const int cg = lane, tok0 = 16 * wid, xcol0 = 256 * hq + 4 * cg, h = 4 * hq + (cg >> 4); const ConvW4 w = conv4_w(cw, cb, xcol0);
            float raw[19][4]; conv4_load<16>(raw, X.PROJ, r0 + tok0, !(c == 0 && tok0 == 0), xcol0);
            float ws[16];
#pragma unroll
            for (int k4 = 0; k4 < 4; ++k4) { const f32x4 t4 = *(LAS f32x4*)(WSL + h * 128 + tok0 + 4 * k4); ws[4 * k4] = t4.x; ws[4 * k4 + 1] = t4.y; ws[4 * k4 + 2] = t4.z; ws[4 * k4 + 3] = t4.w; }
#pragma unroll
            for (int e = 0; e < 4; ++e)
#pragma unroll
                for (int kq = 0; kq < 4; ++kq) { u32x2 pw; pw.x = pk2(CONV4_TAP(w, raw, 4 * kq, e) * ws[4 * kq], CONV4_TAP(w, raw, 4 * kq + 1, e) * ws[4 * kq + 1]); pw.y = pk2(CONV4_TAP(w, raw, 4 * kq + 2, e) * ws[4 * kq + 2], CONV4_TAP(w, raw, 4 * kq + 3, e) * ws[4 * kq + 3]);
                    *(LAS u32x2*)(XT + (4 * cg + e) * XTP + tok0 + 4 * kq) = pw; }
        }
        __syncthreads();
        {
            const int hl = wid >> 1, ph = wid & 1, h = 4 * hq + hl;
            f32x4 acc[2][8];
#pragma unroll
            for (int pp = 0; pp < 2; ++pp)
#pragma unroll
                for (int nt = 0; nt < 8; ++nt) acc[pp][nt] = (f32x4){0.f, 0.f, 0.f, 0.f};
#pragma unroll 1
            for (int ks = 0; ks < 4; ++ks) {
                bf16x8 bfr[8], xfr[2];
#pragma unroll
                for (int nt = 0; nt < 8; ++nt) { ldsp p = (ldsp)(BT + (16 * nt + i) * XTP + 32 * ks + 8 * g); bfr[nt] = lds8x2(p, p + 8); }
#pragma unroll
                for (int pp = 0; pp < 2; ++pp) { ldsp p = (ldsp)(XT + (hl * 64 + 16 * (2 * ph + pp) + i) * XTP + 32 * ks + 8 * g); xfr[pp] = lds8x2(p, p + 8); }
#pragma unroll
                for (int pp = 0; pp < 2; ++pp)
#pragma unroll
                    for (int nt = 0; nt < 8; ++nt) acc[pp][nt] = mfma16(bfr[nt], xfr[pp], acc[pp][nt]);
            }
            u16* sb = X.ST + ((size_t)((b * 64 + c) * 16 + h)) * 8192;
#pragma unroll
            for (int pp = 0; pp < 2; ++pp)
#pragma unroll
                for (int nt = 0; nt < 8; ++nt) { const int p = 16 * (2 * ph + pp) + i, n = 16 * nt + 4 * g; u32x2 w; w.x = pk2(acc[pp][nt][0], acc[pp][nt][1]); w.y = pk2(acc[pp][nt][2], acc[pp][nt][3]);
                    *(u32x2*)(sb + p * 128 + n) = w; }
        }
        __syncthreads();
    }
}

__device__ __forceinline__ void ssd_sample_unit(const Ctx& X, int l, int b, int grp, ldsp L, int tid, int wid, int lane) {
    LAS float* XS = (LAS float*)L;
    LAS float* BS = (LAS float*)(L + 8192);
    LAS float* CS = (LAS float*)(L + 10240);
    LAS float* DTS = (LAS float*)(L + 12288);
    LAS float* YG = (LAS float*)(L + 12544);
    const float* cw = X.in[I_CW] + (size_t)l * 4 * 1536; const float* cb = X.in[I_CB] + (size_t)l * 1536;
    const int row0 = MP + b * 4;
    const int p = tid >> 3, nq = tid & 7, n0 = 16 * nq;
    const float* sbase = X.in[I_SSSM] + ((size_t)((l * 128 + b) * 16 + 8 * grp) * 64 + p) * 128 + n0;
    f32x4 nx[4], nx1[4], nx2[4];
#pragma unroll
    for (int e4 = 0; e4 < 4; ++e4) { nx[e4] = *(const f32x4*)(sbase + 4 * e4); nx1[e4] = *(const f32x4*)(sbase + 8192 + 4 * e4); nx2[e4] = *(const f32x4*)(sbase + 2 * 8192 + 4 * e4); }
    for (int ci = tid; ci < 768; ci += 512) {
        const int xcol = ci < 512 ? 512 * grp + ci : (ci < 640 ? 1024 + 128 * grp + (ci - 512) : 1280 + 128 * grp + (ci - 640));
        float xp[7];
#pragma unroll
        for (int j = 0; j < 3; ++j) xp[j] = X.in[I_SCONV][((size_t)(l * 128 + b) * 3 + j) * 1536 + xcol];
#pragma unroll
        for (int t = 0; t < 4; ++t) xp[3 + t] = bf2f(X.PROJ[(size_t)(row0 + t) * NPROJ + C_X + xcol]);
        const float w0 = cw[xcol], w1 = cw[1536 + xcol], w2 = cw[2 * 1536 + xcol], w3 = cw[3 * 1536 + xcol], bias = cb[xcol];
#pragma unroll
        for (int t = 0; t < 4; ++t) {
            const float v = silu_f(fmaf(xp[t], w0, fmaf(xp[t + 1], w1, fmaf(xp[t + 2], w2, fmaf(xp[t + 3], w3, bias)))));
            if (ci < 512) XS[t * 512 + ci] = v; else if (ci < 640) BS[t * 128 + ci - 512] = v; else CS[t * 128 + ci - 640] = v;
        }
#pragma unroll
        for (int j = 0; j < 3; ++j) X.out[O_CS + ((size_t)(l * 128 + b) * 3 + j) * 1536 + xcol] = xp[4 + j];
    }
    {
        const int h = 8 * grp + wid; const u16* wp = X.WinT + (size_t)l * NIN * DM + (size_t)(NPROJ + h) * DM + lane * 16;
        const u32x4 wa = *(const u32x4*)wp, wb = *(const u32x4*)(wp + 8);
#pragma unroll
        for (int t = 0; t < 4; ++t) {
            const u16* xp = X.XB + (size_t)(row0 + t) * DM + lane * 16; const u32x4 xa = *(const u32x4*)xp, xb = *(const u32x4*)(xp + 8);
            float s = 0.f;
#pragma unroll
            for (int e = 0; e < 4; ++e) { s += bflo(xa[e]) * bflo(wa[e]) + bfhi(xa[e]) * bfhi(wa[e]); s += bflo(xb[e]) * bflo(wb[e]) + bfhi(xb[e]) * bfhi(wb[e]); }
            s = wave_sum(s);
            const float dt = softplus_f(s * rstd_row(X.SSP, row0 + t) + X.in[I_DTB][l * 16 + h]);
            if (lane == 0) DTS[t * 8 + wid] = dt;
        }
    }
    __syncthreads();
#pragma unroll 1
    for (int hh = 0; hh < 8; ++hh) {
        const int h = 8 * grp + hh; const size_t sidx = ((size_t)((l * 128 + b) * 16 + h) * 64 + p) * 128 + n0;
        unsigned zr[4];
#pragma unroll
        for (int t = 0; t < 4; ++t) zr[t] = X.PROJ[(size_t)(row0 + t) * NPROJ + C_Z + 64 * h + p];
        float hst[16];
#pragma unroll
        for (int e4 = 0; e4 < 4; ++e4) { const f32x4 v = nx[e4]; hst[4 * e4] = v.x; hst[4 * e4 + 1] = v.y; hst[4 * e4 + 2] = v.z; hst[4 * e4 + 3] = v.w; nx[e4] = nx1[e4]; nx1[e4] = nx2[e4]; }
        if (hh < 5) {
#pragma unroll
            for (int e4 = 0; e4 < 4; ++e4) nx2[e4] = *(const f32x4*)(sbase + (size_t)(hh + 3) * 8192 + 4 * e4);
        }
        const float A = -expf(X.in[I_ALOG][l * 16 + h]), Dh = X.in[I_DSK][l * 16 + h];
        float y[4];
#pragma unroll
        for (int t = 0; t < 4; ++t) {
            const float dt = DTS[t * 8 + hh], dA = __expf(dt * A), dx = dt * XS[t * 512 + hh * 64 + p]; float acc = 0.f;
#pragma unroll
            for (int e = 0; e < 16; ++e) { hst[e] = fmaf(hst[e], dA, dx * BS[t * 128 + n0 + e]); acc = fmaf(hst[e], CS[t * 128 + n0 + e], acc); }
            y[t] = acc;
        }
#pragma unroll
        for (int e4 = 0; e4 < 4; ++e4) { f32x4 v; v.x = hst[4 * e4]; v.y = hst[4 * e4 + 1]; v.z = hst[4 * e4 + 2]; v.w = hst[4 * e4 + 3]; *(f32x4*)(X.out + O_HS + sidx + 4 * e4) = v; }
#pragma unroll
        for (int t = 0; t < 4; ++t) {
            float yy = y[t]; yy += __shfl_xor(yy, 1); yy += __shfl_xor(yy, 2); yy += __shfl_xor(yy, 4);
            if (nq == 0) { const float yv = yy + Dh * XS[t * 512 + hh * 64 + p]; const float z = bf2f(zr[t]); YG[t * 512 + hh * 64 + p] = yv * silu_f(z); }
        }
    }
    __syncthreads();
    if (wid < 4) {
        const int t = wid; float ss = 0.f;
#pragma unroll
        for (int k = 0; k < 8; ++k) { const float v = YG[t * 512 + lane + 64 * k]; ss += v * v; }
        ss = wave_sum(ss); const float rs = rsqrtf(ss * (1.f / 512.f) + EPS);
#pragma unroll
        for (int k = 0; k < 8; ++k) { const int col = lane + 64 * k; X.YMIX[(size_t)(row0 + t) * NMIX + 512 * grp + col] = (u16)f2bf(YG[t * 512 + col] * rs); }
    }
}
constexpr int KNP = 72;
constexpr int VTP = 264;
__device__ __forceinline__ void attn_prompt_unit(const Ctx& X, int l, int b, int nb, ldsp L, int tid, int wid, int lane) {
    LAS u16* Kn = (LAS u16*)L;
    LAS u16* Vt = (LAS u16*)(L + 73728);
    const int i = lane & 15, g = lane >> 4;
    {
        const int key = tid >> 1, part = tid & 1, tk = nb * 128 - 128 + key; const bool last = (nb == 63) && key >= 128;
        if (tk < 0) {
#pragma unroll
            for (int kvh = 0; kvh < 2; ++kvh) {
                LAS u16* kd = Kn + (kvh * 256 + key) * KNP + 16 * part; LAS u16* vd = Vt + (kvh * 64 + 16 * part) * VTP + key;
                *(LAS u32x4*)(kd) = (u32x4){0u, 0u, 0u, 0u}; *(LAS u32x4*)(kd + 8) = (u32x4){0u, 0u, 0u, 0u}; *(LAS u32x4*)(kd + 32) = (u32x4){0u, 0u, 0u, 0u}; *(LAS u32x4*)(kd + 40) = (u32x4){0u, 0u, 0u, 0u};
#pragma unroll
                for (int d = 0; d < 16; ++d) { vd[d * VTP] = 0; vd[(32 + d) * VTP] = 0; }
            }
        } else {
            const u16* src0 = X.PROJ + (size_t)(b * 8192 + tk) * NPROJ + 16 * part;
            u32x4 kw[2][4], vw[2][4];
#pragma unroll
            for (int kvh = 0; kvh < 2; ++kvh) {
                const u16* src = src0 + 64 * kvh;
                kw[kvh][0] = *(const u32x4*)(src + C_K); kw[kvh][1] = *(const u32x4*)(src + C_K + 8); kw[kvh][2] = *(const u32x4*)(src + C_K + 32); kw[kvh][3] = *(const u32x4*)(src + C_K + 40);
                vw[kvh][0] = *(const u32x4*)(src + C_V); vw[kvh][1] = *(const u32x4*)(src + C_V + 8); vw[kvh][2] = *(const u32x4*)(src + C_V + 32); vw[kvh][3] = *(const u32x4*)(src + C_V + 40);
            }
            float cs[16], sn[16];
            {
                const f32x4* cp = (const f32x4*)(X.COS + (size_t)tk * 32 + 16 * part); const f32x4* sp = (const f32x4*)(X.SIN + (size_t)tk * 32 + 16 * part);
#pragma unroll
                for (int e = 0; e < 4; ++e) { const f32x4 c4 = cp[e], s4 = sp[e]; cs[4 * e] = c4.x; cs[4 * e + 1] = c4.y; cs[4 * e + 2] = c4.z; cs[4 * e + 3] = c4.w; sn[4 * e] = s4.x; sn[4 * e + 1] = s4.y; sn[4 * e + 2] = s4.z; sn[4 * e + 3] = s4.w; }
            }
            const float* kn = X.in[I_KN] + l * 64 + 16 * part;
#pragma unroll
            for (int kvh = 0; kvh < 2; ++kvh) {
                LAS u16* kd = Kn + (kvh * 256 + key) * KNP + 16 * part; LAS u16* vd = Vt + (kvh * 64 + 16 * part) * VTP + key;
                float x1[16], x2[16]; float ss = 0.f;
#pragma unroll
                for (int q = 0; q < 4; ++q) { x1[2 * q] = bflo(kw[kvh][0][q]); x1[2 * q + 1] = bfhi(kw[kvh][0][q]); x1[8 + 2 * q] = bflo(kw[kvh][1][q]); x1[8 + 2 * q + 1] = bfhi(kw[kvh][1][q]);
                    x2[2 * q] = bflo(kw[kvh][2][q]); x2[2 * q + 1] = bfhi(kw[kvh][2][q]); x2[8 + 2 * q] = bflo(kw[kvh][3][q]); x2[8 + 2 * q + 1] = bfhi(kw[kvh][3][q]); }
#pragma unroll
                for (int d = 0; d < 16; ++d) ss += x1[d] * x1[d] + x2[d] * x2[d];
                ss += __shfl_xor(ss, 1);
                const float rs = rsqrtf(ss * (1.f / 64.f) + EPS);
#pragma unroll
                for (int d = 0; d < 16; ++d) { const float u1 = x1[d] * rs * kn[d], u2 = x2[d] * rs * kn[d + 32], c = cs[d], sv = sn[d]; x1[d] = u1 * c - u2 * sv; x2[d] = u2 * c + u1 * sv; }
#pragma unroll
                for (int e = 0; e < 2; ++e) { u32x4 w; w.x = pk2(x1[8 * e], x1[8 * e + 1]); w.y = pk2(x1[8 * e + 2], x1[8 * e + 3]); w.z = pk2(x1[8 * e + 4], x1[8 * e + 5]); w.w = pk2(x1[8 * e + 6], x1[8 * e + 7]); *(LAS u32x4*)(kd + 8 * e) = w;
                    u32x4 v; v.x = pk2(x2[8 * e], x2[8 * e + 1]); v.y = pk2(x2[8 * e + 2], x2[8 * e + 3]); v.z = pk2(x2[8 * e + 4], x2[8 * e + 5]); v.w = pk2(x2[8 * e + 6], x2[8 * e + 7]); *(LAS u32x4*)(kd + 32 + 8 * e) = v; }
                const size_t oidx = (((size_t)(l * 4 + b) * 128 + (key - 128)) * 2 + kvh) * 64 + 16 * part;
                if (last) { float* o = X.out + O_KP + oidx;
#pragma unroll
                    for (int e = 0; e < 4; ++e) { *(f32x4*)(o + 4 * e) = (f32x4){x1[4 * e], x1[4 * e + 1], x1[4 * e + 2], x1[4 * e + 3]}; *(f32x4*)(o + 32 + 4 * e) = (f32x4){x2[4 * e], x2[4 * e + 1], x2[4 * e + 2], x2[4 * e + 3]}; } }
#pragma unroll
                for (int hf = 0; hf < 2; ++hf)
#pragma unroll
                    for (int e = 0; e < 2; ++e) { const u32x4 w = vw[kvh][2 * hf + e];
#pragma unroll
                        for (int q = 0; q < 4; ++q) { vd[(32 * hf + 8 * e + 2 * q) * VTP] = (u16)(w[q] & 0xffffu); vd[(32 * hf + 8 * e + 2 * q + 1) * VTP] = (u16)(w[q] >> 16); }
                        if (last) { float* ov = X.out + O_VP + oidx + 32 * hf + 8 * e; *(f32x4*)(ov) = (f32x4){bflo(w[0]), bfhi(w[0]), bflo(w[1]), bfhi(w[1])}; *(f32x4*)(ov + 4) = (f32x4){bflo(w[2]), bfhi(w[2]), bflo(w[3]), bfhi(w[3])}; } }
            }
        }
    }
    __syncthreads();
    const int kvh = wid >> 2; const float sink = X.in[I_SINK][l * 8 + wid] * 1.44269504089f;
    const float* qn = X.in[I_QN] + l * 64;
    u32x4 nqa, nqb; f32x4 ncs0, ncs1, nsn0, nsn1;
    {
        const int tq0 = nb * 128 + i; const size_t row0q = (size_t)b * 8192 + tq0;
        nqa = *(const u32x4*)(X.PROJ + row0q * NPROJ + 64 * wid + 8 * g); nqb = *(const u32x4*)(X.PROJ + row0q * NPROJ + 64 * wid + 32 + 8 * g);
        ncs0 = *(const f32x4*)(X.COS + (size_t)tq0 * 32 + 8 * g); ncs1 = *(const f32x4*)(X.COS + (size_t)tq0 * 32 + 8 * g + 4);
        nsn0 = *(const f32x4*)(X.SIN + (size_t)tq0 * 32 + 8 * g); nsn1 = *(const f32x4*)(X.SIN + (size_t)tq0 * 32 + 8 * g + 4);
    }
    for (int qt = 0; qt < 8; ++qt) {
        const int qi = 16 * qt + i, tq = nb * 128 + qi; const size_t row = (size_t)b * 8192 + tq;
        bf16x8 qf0, qf1;
        {
            const u32x4 wa = nqa, wb = nqb; const f32x4 c0 = ncs0, c1 = ncs1, s0v = nsn0, s1v = nsn1;
            {
                const int qn_ = qt < 7 ? qt + 1 : 7; const int tqn = nb * 128 + 16 * qn_ + i; const size_t rown = (size_t)b * 8192 + tqn;
                nqa = *(const u32x4*)(X.PROJ + rown * NPROJ + 64 * wid + 8 * g); nqb = *(const u32x4*)(X.PROJ + rown * NPROJ + 64 * wid + 32 + 8 * g);
                ncs0 = *(const f32x4*)(X.COS + (size_t)tqn * 32 + 8 * g); ncs1 = *(const f32x4*)(X.COS + (size_t)tqn * 32 + 8 * g + 4);
                nsn0 = *(const f32x4*)(X.SIN + (size_t)tqn * 32 + 8 * g); nsn1 = *(const f32x4*)(X.SIN + (size_t)tqn * 32 + 8 * g + 4);
            }
            float x1[8], x2[8]; float ss = 0.f;
#pragma unroll
            for (int q = 0; q < 4; ++q) { x1[2 * q] = bflo(wa[q]); x1[2 * q + 1] = bfhi(wa[q]); x2[2 * q] = bflo(wb[q]); x2[2 * q + 1] = bfhi(wb[q]); }
#pragma unroll
            for (int e = 0; e < 8; ++e) ss += x1[e] * x1[e] + x2[e] * x2[e];
            ss += __shfl_xor(ss, 16); ss += __shfl_xor(ss, 32);
            const float rs = rsqrtf(ss * (1.f / 64.f) + EPS) * (0.125f * 1.44269504089f);
            const float cs[8] = {c0.x, c0.y, c0.z, c0.w, c1.x, c1.y, c1.z, c1.w}, sn[8] = {s0v.x, s0v.y, s0v.z, s0v.w, s1v.x, s1v.y, s1v.z, s1v.w};
            float o1[8], o2[8];
#pragma unroll
            for (int e = 0; e < 8; ++e) { const float a = x1[e] * rs * qn[8 * g + e], bb = x2[e] * rs * qn[32 + 8 * g + e], c = cs[e], s = sn[e]; o1[e] = a * c - bb * s; o2[e] = bb * c + a * s; }
            u32x4 w0, w1; w0.x = pk2(o1[0], o1[1]); w0.y = pk2(o1[2], o1[3]); w0.z = pk2(o1[4], o1[5]); w0.w = pk2(o1[6], o1[7]);
            w1.x = pk2(o2[0], o2[1]); w1.y = pk2(o2[2], o2[3]); w1.z = pk2(o2[4], o2[5]); w1.w = pk2(o2[6], o2[7]);
            qf0 = __builtin_bit_cast(bf16x8, w0); qf1 = __builtin_bit_cast(bf16x8, w1);
        }
        f32x4 s[9]; float mx = -INFINITY;
#pragma unroll
        for (int kk = 0; kk < 9; ++kk) {
            const int kt = qt + kk; ldsp kp = (ldsp)(Kn + (kvh * 256 + 16 * kt + i) * KNP + 8 * g);
            f32x4 a = {0.f, 0.f, 0.f, 0.f}; a = mfma16(lds16(kp), qf0, a); a = mfma16(lds16(kp + 64), qf1, a);
#pragma unroll
            for (int j = 0; j < 4; ++j) {
                bool ok = (nb > 0) || (kt >= 8);
                if (kk == 0) ok = ok && (4 * g + j > i);
                if (kk == 8) ok = ok && (4 * g + j <= i);
                a[j] = ok ? a[j] : -INFINITY; mx = fmaxf(mx, a[j]); }
            s[kk] = a;
        }
        mx = fmaxf(mx, __shfl_xor(mx, 16)); mx = fmaxf(mx, __shfl_xor(mx, 32)); mx = fmaxf(mx, sink);
        float sum = 0.f;
#pragma unroll
        for (int kk = 0; kk < 9; ++kk)
#pragma unroll
            for (int j = 0; j < 4; ++j) { const float p = __builtin_amdgcn_exp2f(s[kk][j] - mx); s[kk][j] = p; sum += p; }
        sum += __shfl_xor(sum, 16); sum += __shfl_xor(sum, 32);
        const float inv = __builtin_amdgcn_rcpf(sum + __builtin_amdgcn_exp2f(sink - mx));
        f32x4 o[4];
#pragma unroll
        for (int dt = 0; dt < 4; ++dt) o[dt] = (f32x4){0.f, 0.f, 0.f, 0.f};
#pragma unroll
        for (int pi = 0; pi < 5; ++pi) {
            const int k0 = 2 * pi, k1 = (2 * pi + 1 < 9) ? 2 * pi + 1 : 2 * pi;
            u32x4 pw; pw.x = pk2(s[k0][0], s[k0][1]); pw.y = pk2(s[k0][2], s[k0][3]);
            if (2 * pi + 1 < 9) { pw.z = pk2(s[k1][0], s[k1][1]); pw.w = pk2(s[k1][2], s[k1][3]); } else { pw.z = 0u; pw.w = 0u; }
            const bf16x8 pf = __builtin_bit_cast(bf16x8, pw);
#pragma unroll
            for (int dt = 0; dt < 4; ++dt) {
                LAS u16* vr = Vt + (kvh * 64 + 16 * dt + i) * VTP + 4 * g;
                const bf16x8 vf = lds8x2((ldsp)(vr + 16 * (qt + k0)), (ldsp)(vr + 16 * (qt + k1)));
                o[dt] = mfma16(vf, pf, o[dt]);
            }
        }
#pragma unroll
        for (int dt = 0; dt < 4; ++dt) { u32x2 w; w.x = pk2(o[dt][0] * inv, o[dt][1] * inv); w.y = pk2(o[dt][2] * inv, o[dt][3] * inv);
            *(u32x2*)(X.YMIX + row * NMIX + 1024 + 64 * wid + 16 * dt + 4 * g) = w; }
    }
}

__device__ __forceinline__ void scan_unit(const Ctx& X, int l, int hs, int tid) {
    const int b = hs >> 7, h = (hs >> 3) & 15, pq = hs & 7;
    const int p = 8 * pq + (tid >> 6), n = (tid & 63) * 2;
    u16* base = X.ST + ((size_t)(b * 64) * 16 + h) * 8192 + p * 128 + n;
    const float* cd = X.CD + (b * 64) * 16 + h;
    float h0 = 0.f, h1 = 0.f;
    for (int c0 = 0; c0 < 64; c0 += 32) {
        unsigned st[32]; float dc[32];
#pragma unroll
        for (int e = 0; e < 32; ++e) { st[e] = *(const unsigned*)(base + (size_t)(c0 + e) * 16 * 8192); dc[e] = cd[(c0 + e) * 16]; }
#pragma unroll
        for (int e = 0; e < 32; ++e) {
            *(unsigned*)(base + (size_t)(c0 + e) * 16 * 8192) = pk2(h0, h1);
            h0 = fmaf(h0, dc[e], bflo(st[e])); h1 = fmaf(h1, dc[e], bfhi(st[e]));
        }
    }
    float* o = X.out + O_HP + ((size_t)((l * 4 + b) * 16 + h) * 64 + p) * 128 + n; o[0] = h0; o[1] = h1;
}

constexpr int KCP = 132;
__device__ __forceinline__ void attn_sample_unit(const Ctx& X, int l, int b, ldsp L, int tid, int wid, int lane) {
    LAS u16* KC = (LAS u16*)L;
    LAS u16* VC = (LAS u16*)(L + 34848);
    LAS float* QS = (LAS float*)(L + 69696);
    LAS float* SS = (LAS float*)(L + 77888);
    const int row0 = MP + b * 4;
#pragma unroll
    for (int k = 0; k < 8; ++k) {
        const int idx = tid + 512 * k, j = idx >> 5, c4 = (idx & 31) * 4; const size_t off = ((size_t)(l * 128 + b) * 128 + j) * 128 + c4;
        const f32x4 kv = *(const f32x4*)(X.in[I_CK] + off), vv = *(const f32x4*)(X.in[I_CV] + off);
        { u32x2 kw2; kw2.x = pk2(kv.x, kv.y); kw2.y = pk2(kv.z, kv.w); *(LAS u32x2*)(KC + j * KCP + c4) = kw2; u32x2 vw2; vw2.x = pk2(vv.x, vv.y); vw2.y = pk2(vv.z, vv.w); *(LAS u32x2*)(VC + j * KCP + c4) = vw2; }
        if (j >= 4) { const size_t oo = ((size_t)(l * 128 + b) * 128 + (j - 4)) * 128 + c4; *(f32x4*)(X.out + O_KS + oo) = kv; *(f32x4*)(X.out + O_VS + oo) = vv; }
    }
    {
        const int t = wid >> 1, kvh = wid & 1; const u16* src = X.PROJ + (size_t)(row0 + t) * NPROJ;
        const float x = bf2f(src[C_K + 64 * kvh + lane]); const float ss = wave_sum(x * x);
        const float xn = x * rsqrtf(ss * (1.f / 64.f) + EPS) * X.in[I_KN][l * 64 + lane]; const float pr = __shfl_xor(xn, 32);
        const float c = X.COS[(size_t)(8192 + t) * 32 + (lane & 31)], s = X.SIN[(size_t)(8192 + t) * 32 + (lane & 31)];
        const float o = lane < 32 ? xn * c - pr * s : xn * c + pr * s;
        KC[(128 + t) * KCP + kvh * 64 + lane] = (u16)f2bf(o);
        const size_t oo = ((size_t)(l * 128 + b) * 128 + 124 + t) * 128 + kvh * 64 + lane;
        X.out[O_KS + oo] = o;
        const unsigned vraw = src[C_V + 64 * kvh + lane]; VC[(128 + t) * KCP + kvh * 64 + lane] = (u16)vraw; X.out[O_VS + oo] = bf2f(vraw);
    }
#pragma unroll
    for (int k = 0; k < 4; ++k) {
        const int pair = 4 * wid + k, t = pair >> 3, head = pair & 7;
        const float x = bf2f(X.PROJ[(size_t)(row0 + t) * NPROJ + 64 * head + lane]); const float ss = wave_sum(x * x);
        const float xn = x * rsqrtf(ss * (1.f / 64.f) + EPS) * X.in[I_QN][l * 64 + lane]; const float pr = __shfl_xor(xn, 32);
        const float c = X.COS[(size_t)(8192 + t) * 32 + (lane & 31)], s = X.SIN[(size_t)(8192 + t) * 32 + (lane & 31)];
        QS[pair * 64 + lane] = (lane < 32 ? xn * c - pr * s : xn * c + pr * s) * 0.125f;
    }
    __syncthreads();
    for (int it = 0; it < 9; ++it) {
        const int idx = tid + 512 * it;
        if (idx < 32 * 132) {
            const int pair = idx / 132, key = idx - pair * 132, t = pair >> 3, head = pair & 7, kvh = head >> 2;
            const bool ok = key < 128 ? key > t : (key - 128) <= t;
            float s = 0.f;
#pragma unroll
            for (int d = 0; d < 64; d += 4) { const u32x2 kw2 = *(LAS u32x2*)(KC + key * KCP + kvh * 64 + d); const f32x4 q4 = *(LAS f32x4*)(QS + pair * 64 + d);
                s = fmaf(q4.x, bflo(kw2.x), s); s = fmaf(q4.y, bfhi(kw2.x), s); s = fmaf(q4.z, bflo(kw2.y), s); s = fmaf(q4.w, bfhi(kw2.y), s); }
            SS[pair * 136 + key] = ok ? s : -INFINITY;
        }
    }
    __syncthreads();
#pragma unroll
    for (int k = 0; k < 4; ++k) {
        const int pair = 4 * wid + k, head = pair & 7; const float sink = X.in[I_SINK][l * 8 + head];
        const float v0 = SS[pair * 136 + lane], v1 = SS[pair * 136 + 64 + lane], v2 = lane < 4 ? SS[pair * 136 + 128 + lane] : -INFINITY;
        const float mx = fmaxf(wave_max(fmaxf(fmaxf(v0, v1), v2)), sink);
        const float e0 = __expf(v0 - mx), e1 = __expf(v1 - mx), e2 = __expf(v2 - mx);
        const float inv = 1.f / (wave_sum(e0 + e1 + e2) + __expf(sink - mx));
        SS[pair * 136 + lane] = e0 * inv; SS[pair * 136 + 64 + lane] = e1 * inv; if (lane < 4) SS[pair * 136 + 128 + lane] = e2 * inv;
    }
    __syncthreads();
    {
        const int pair = tid >> 4, d4 = (tid & 15) * 4, head = pair & 7, kvh = head >> 2, t = pair >> 3;
        float a0 = 0.f, a1 = 0.f, a2 = 0.f, a3 = 0.f;
        for (int key = 0; key < 132; ++key) {
            const float p = SS[pair * 136 + key]; const u32x2 vw2 = *(LAS u32x2*)(VC + key * KCP + kvh * 64 + d4); const unsigned w0 = vw2.x, w1 = vw2.y;
            a0 = fmaf(p, bflo(w0), a0); a1 = fmaf(p, bfhi(w0), a1); a2 = fmaf(p, bflo(w1), a2); a3 = fmaf(p, bfhi(w1), a3);
        }
        u32x2 w; w.x = pk2(a0, a1); w.y = pk2(a2, a3); *(u32x2*)(X.YMIX + (size_t)(row0 + t) * NMIX + 1024 + 64 * head + d4) = w;
    }
}

constexpr int CNP = 136;
template <int MODE> __device__ __forceinline__ void ssd_out_unit(const Ctx& X, int l, int b, int c, ldsp L, int tid, int wid, int lane) {
    LAS float* DTL = (LAS float*)L; LAS float* ACL = (LAS float*)(L + 8192);
    LAS u16* CcL = (LAS u16*)(L + 16384);
    LAS u16* CBL = (LAS u16*)(L + 16384 + 34816);
    LAS float* SSQ = (LAS float*)(L + 16384 + 34816 + 18432);
    LAS u16* XT = (LAS u16*)(L + 73728);
    LAS u16* BcL = XT;
    const int i = lane & 15, g = lane >> 4, r0 = b * 8192 + c * 128;
    const float* cw = X.in[I_CW] + (size_t)l * 4 * 1536; const float* cb = X.in[I_CB] + (size_t)l * 1536;
    { const f32x4 d4 = *(const f32x4*)(X.DT + (size_t)r0 * 16 + tid * 4); const int s_ = tid >> 2, h0 = (tid & 3) * 4;
      DTL[(h0 + 0) * 128 + s_] = d4.x; DTL[(h0 + 1) * 128 + s_] = d4.y; DTL[(h0 + 2) * 128 + s_] = d4.z; DTL[(h0 + 3) * 128 + s_] = d4.w; }
    __syncthreads();
    acum_scan(DTL, ACL, X.in[I_ALOG] + l * 16, wid, lane);
    if (c == 63) for (int idx = tid; idx < 3 * 1536; idx += 512) { const int j = idx / 1536, col = idx - j * 1536;
        X.out[O_CP + ((size_t)(l * 4 + b) * 3 + j) * 1536 + col] = bf2f(X.PROJ[(size_t)(b * 8192 + 8189 + j) * NPROJ + C_X + col]); }
    __syncthreads();
    for (int grp = 0; grp < 2; ++grp) {
        {
            const int cg = lane, tok0 = 16 * wid, isC = cg >> 5, n0 = 4 * (cg & 31), xcol0 = 1024 + 256 * isC + 128 * grp + n0; const ConvW4 w = conv4_w(cw, cb, xcol0);
            float raw[19][4]; conv4_load<16>(raw, X.PROJ, r0 + tok0, !(c == 0 && tok0 == 0), xcol0);
            LAS u16* dst = (isC ? CcL : BcL) + tok0 * CNP + n0;
#pragma unroll
            for (int k = 0; k < 16; ++k) { u32x2 pw; pw.x = pk2(CONV4_TAP(w, raw, k, 0), CONV4_TAP(w, raw, k, 1)); pw.y = pk2(CONV4_TAP(w, raw, k, 2), CONV4_TAP(w, raw, k, 3)); *(LAS u32x2*)(dst + k * CNP) = pw; }
        }
        __syncthreads();
        if (MODE != 1) for (int tix = wid; tix < 36; tix += 8) {
            int qt = 0; while ((qt + 1) * (qt + 2) / 2 <= tix) ++qt; const int st = tix - qt * (qt + 1) / 2;
            f32x4 a = {0.f, 0.f, 0.f, 0.f};
#pragma unroll
            for (int kk = 0; kk < 4; ++kk) a = mfma16(lds16((ldsp)(BcL + (16 * st + i) * CNP + 32 * kk + 8 * g)), lds16((ldsp)(CcL + (16 * qt + i) * CNP + 32 * kk + 8 * g)), a);
            { u32x2 cw; cw.x = pk2(a[0], a[1]); cw.y = pk2(a[2], a[3]); *(LAS u32x2*)(CBL + (tix * 64 + lane) * 4) = cw; }
        }
        __syncthreads();
        for (int quad = 0; quad < 2; ++quad) {
            const int hq = 2 * grp + quad;
            bf16x8 hsf[4][4];
            {
                const int cg = lane, tok0 = 16 * wid, xcol0 = 256 * hq + 4 * cg; const ConvW4 w = conv4_w(cw, cb, xcol0);
                float raw[19][4]; conv4_load<16>(raw, X.PROJ, r0 + tok0, !(c == 0 && tok0 == 0), xcol0);
                {
                    const u16* hsb = X.ST + ((size_t)((b * 64 + c) * 16 + 4 * hq + (wid >> 1))) * 8192;
#pragma unroll
                    for (int pt = 0; pt < 4; ++pt)
#pragma unroll
                        for (int kk = 0; kk < 4; ++kk) hsf[pt][kk] = *(const bf16x8*)(hsb + (16 * pt + i) * 128 + 32 * kk + 8 * g);
                }
#pragma unroll
                for (int e = 0; e < 4; ++e)
#pragma unroll
                    for (int kq = 0; kq < 4; ++kq) { u32x2 pw; pw.x = pk2(CONV4_TAP(w, raw, 4 * kq, e), CONV4_TAP(w, raw, 4 * kq + 1, e)); pw.y = pk2(CONV4_TAP(w, raw, 4 * kq + 2, e), CONV4_TAP(w, raw, 4 * kq + 3, e));
                        *(LAS u32x2*)(XT + (4 * cg + e) * XTP + tok0 + 4 * kq) = pw; }
            }
            __syncthreads();
            if (MODE != 1) {
                const int hl = wid >> 1, half = wid & 1, h = 4 * hq + hl, hh = quad * 4 + hl;
                const float Dh = X.in[I_DSK][l * 16 + h];
                for (int qx = 0; qx < 4; ++qx) {
                    const int qt = qx == 0 ? half : (qx == 1 ? 3 - half : (qx == 2 ? 4 + half : 7 - half));
                    const int q = 16 * qt + i; const float aq = ACL[h * 128 + q], eaq = __expf(aq);
                    const size_t row = (size_t)r0 + q; u32x2 zw[4];
#pragma unroll
                    for (int pt = 0; pt < 4; ++pt) zw[pt] = *(const u32x2*)(X.PROJ + row * NPROJ + C_Z + 64 * h + 16 * pt + 4 * g);
                    f32x4 accy[4], acci[4];
#pragma unroll
                    for (int pt = 0; pt < 4; ++pt) { accy[pt] = (f32x4){0.f, 0.f, 0.f, 0.f}; acci[pt] = (f32x4){0.f, 0.f, 0.f, 0.f}; }
#pragma unroll
                    for (int kk = 0; kk < 4; ++kk) { const bf16x8 cf = lds16((ldsp)(CcL + q * CNP + 32 * kk + 8 * g));
#pragma unroll
                        for (int pt = 0; pt < 4; ++pt) accy[pt] = mfma16(hsf[pt][kk], cf, accy[pt]); }
                    const int tb = qt * (qt + 1) / 2, npair = qt / 2 + 1;
                    for (int pi = 0; pi < npair; ++pi) {
                        const int st0 = 2 * pi; const bool has1 = (st0 + 1) <= qt; const int st1 = has1 ? st0 + 1 : st0;
                        float m0[4], m1[4];
                        {
                            const int sa0 = 16 * st0 + 4 * g, sb0 = 16 * st1 + 4 * g;
                            const u32x2 cwa = *(LAS u32x2*)(CBL + ((tb + st0) * 64 + lane) * 4), cwb = *(LAS u32x2*)(CBL + ((tb + st1) * 64 + lane) * 4);
                            const f32x4 aca = *(LAS f32x4*)(ACL + h * 128 + sa0), acb = *(LAS f32x4*)(ACL + h * 128 + sb0);
                            const f32x4 dta = *(LAS f32x4*)(DTL + h * 128 + sa0), dtb = *(LAS f32x4*)(DTL + h * 128 + sb0);
                            const float ca[4] = {bflo(cwa.x), bfhi(cwa.x), bflo(cwa.y), bfhi(cwa.y)}, cb4[4] = {bflo(cwb.x), bfhi(cwb.x), bflo(cwb.y), bfhi(cwb.y)};
#pragma unroll
                            for (int j = 0; j < 4; ++j) {
                                const float va = ca[j] * __expf(fminf(aq - aca[j], 0.f)) * dta[j], vb = cb4[j] * __expf(fminf(aq - acb[j], 0.f)) * dtb[j];
                                m0[j] = (sa0 + j) <= q ? va : 0.f; m1[j] = (has1 && (sb0 + j) <= q) ? vb : 0.f;
                            }
                        }
                        u32x4 mw; mw.x = pk2(m0[0], m0[1]); mw.y = pk2(m0[2], m0[3]); mw.z = pk2(m1[0], m1[1]); mw.w = pk2(m1[2], m1[3]);
                        const bf16x8 mf = __builtin_bit_cast(bf16x8, mw);
#pragma unroll
                        for (int pt = 0; pt < 4; ++pt) { LAS u16* xr = XT + (hl * 64 + 16 * pt + i) * XTP + 4 * g;
                            acci[pt] = mfma16(lds8x2((ldsp)(xr + 16 * st0), (ldsp)(xr + 16 * st1)), mf, acci[pt]); }
                    }
                    float ss = 0.f;
#pragma unroll
                    for (int pt = 0; pt < 4; ++pt) {
                        const int p0 = 16 * pt + 4 * g;
                        const float z[4] = {bflo(zw[pt].x), bfhi(zw[pt].x), bflo(zw[pt].y), bfhi(zw[pt].y)}; float o[4];
#pragma unroll
                        for (int j = 0; j < 4; ++j) { const float xv = bf2f(XT[(hl * 64 + p0 + j) * XTP + q]); const float y = acci[pt][j] + eaq * accy[pt][j] + Dh * xv; o[j] = y * silu_f(z[j]); ss += o[j] * o[j]; }
                        u32x2 w; w.x = pk2(o[0], o[1]); w.y = pk2(o[2], o[3]); *(u32x2*)(X.YMIX + row * NMIX + 64 * h + p0) = w;
                    }
                    ss += __shfl_xor(ss, 16); ss += __shfl_xor(ss, 32);
                    if (g == 0) SSQ[q * 8 + hh] = ss;
                }
            }
            __syncthreads();
        }
        if (MODE == 0 && tid < 128) {
            const f32x4 s0 = *(LAS f32x4*)(SSQ + tid * 8), s1 = *(LAS f32x4*)(SSQ + tid * 8 + 4);
            X.RS[((size_t)r0 + tid) * 2 + grp] = rsqrtf((((s0.x + s0.y) + (s0.z + s0.w)) + ((s1.x + s1.y) + (s1.z + s1.w))) * (1.f / 512.f) + EPS);
        }
        __syncthreads();
    }
}
constexpr int N_PHASES = 1 + 7 * NL;

__device__ __forceinline__ void small_res_unit(const u16* A, const u16* WT, int K, float* outf, u16* xb, float* ssp, int u, ldsp L, int tid, int wid, int lane) {
    const int rt = u >> 4, ct = u & 15, i = lane & 15, g = lane >> 4;
    const int trow = 32 * rt + 16 * (wid >> 2) + i, col0 = 64 * ct + 16 * (wid & 3);
    const u16* ap = A + (size_t)(MP + trow) * K + 8 * g; const u16* wp = WT + (size_t)(col0 + i) * K + 8 * g;
    f32x4 acc = {0.f, 0.f, 0.f, 0.f};
    if (K == NMIX) {
#pragma unroll 24
        for (int kk = 0; kk < NMIX / 32; ++kk) acc = mfma16(*(const bf16x8*)(wp + 32 * kk), *(const bf16x8*)(ap + 32 * kk), acc);
    } else {
#pragma unroll 22
        for (int kk = 0; kk < DFF / 32; ++kk) acc = mfma16(*(const bf16x8*)(wp + 32 * kk), *(const bf16x8*)(ap + 32 * kk), acc);
    }
    const size_t o = (size_t)(MP + trow) * DM + col0 + 4 * g;
    const u32x2 rw = *(const u32x2*)(xb + o); const f32x4 r = {bflo(rw.x), bfhi(rw.x), bflo(rw.y), bfhi(rw.y)};
    const f32x4 v = acc + r;
    if (outf) *(f32x4*)(outf + o) = v;
    u32x2 w; w.x = pk2(v[0], v[1]); w.y = pk2(v[2], v[3]); *(u32x2*)(xb + o) = w;
    float ss = (v[0] * v[0] + v[1] * v[1]) + (v[2] * v[2] + v[3] * v[3]); ss += __shfl_xor(ss, 16); ss += __shfl_xor(ss, 32);
    LAS float* red = (LAS float*)L;
    if (g == 0) red[wid * 16 + i] = ss;
    __syncthreads();
    if (tid < 32) { const int hw = tid >> 4, t = tid & 15; ssp[(size_t)(MP + 32 * rt + 16 * hw + t) * 16 + ct] = (red[(4 * hw) * 16 + t] + red[(4 * hw + 1) * 16 + t]) + (red[(4 * hw + 2) * 16 + t] + red[(4 * hw + 3) * 16 + t]); }
    __syncthreads();
}

__device__ __forceinline__ void small_swiglu_unit(const u16* A, const u16* WT, const float* ssp, u16* H, int u, int wid, int lane) {
    const int rt = u / 44, ct = u - rt * 44, i = lane & 15, g = lane >> 4;
    const int trow = MP + 32 * rt + 16 * (wid >> 2) + i, f0 = 64 * ct + 16 * (wid & 3);
    const int wrow = (f0 >> 7) * 256 + (f0 & 127) + i;
    const u16* ap = A + (size_t)trow * DM + 8 * g; const u16* gp = WT + (size_t)wrow * DM + 8 * g; const u16* up = gp + (size_t)128 * DM;
    f32x4 ag = {0.f, 0.f, 0.f, 0.f}, au = {0.f, 0.f, 0.f, 0.f};
#pragma unroll 8
    for (int kk = 0; kk < DM / 32; ++kk) { const bf16x8 a = *(const bf16x8*)(ap + 32 * kk); ag = mfma16(*(const bf16x8*)(gp + 32 * kk), a, ag); au = mfma16(*(const bf16x8*)(up + 32 * kk), a, au); }
    const float rs = rstd_row(ssp, trow);
    u32x2 w; w.x = pk2(silu_f(ag[0] * rs) * (au[0] * rs), silu_f(ag[1] * rs) * (au[1] * rs)); w.y = pk2(silu_f(ag[2] * rs) * (au[2] * rs), silu_f(ag[3] * rs) * (au[3] * rs));
    *(u32x2*)(H + (size_t)trow * DFF + f0 + 4 * g) = w;
}
#define XB_TMO      128
#define XB_XCNT(j)  (256  + 64 * (j))
#define XB_XSUB(j)  (1280 + 64 * (j))
#define XB_XGEN(j)  (2304 + 64 * (j))
#define XB_TOP      3328
#define XB_TOPGEN   3392
#define XCD_BAR_WORDS 3456
#define XB_SPIN_CAP (1u << 18)

__device__ __forceinline__ unsigned xb_ld(unsigned* p)              { return __hip_atomic_load(p, __ATOMIC_RELAXED, __HIP_MEMORY_SCOPE_AGENT); }
__device__ __forceinline__ unsigned xb_add(unsigned* p, unsigned v) { return __hip_atomic_fetch_add(p, v, __ATOMIC_RELAXED, __HIP_MEMORY_SCOPE_AGENT); }
__device__ __forceinline__ unsigned xb_xcc_id() { return (unsigned)__builtin_amdgcn_s_getreg((3 << 11) | 20) & 0xFu; }
#define XB_SPIN(cond, bar) do { unsigned _sp = 0; while (cond) { __builtin_amdgcn_s_sleep(1); \
    if ((++_sp & 255u) == 0u) { if (xb_ld(&(bar)[XB_TMO])) break; if (_sp > XB_SPIN_CAP) { atomicAdd(&(bar)[XB_TMO], 1u); break; } } } } while (0)

struct XcdBarrier {
    unsigned* bar; unsigned x;
    volatile LAS unsigned* st;
};

__device__ __forceinline__ XcdBarrier xcd_barrier_post(unsigned* bar, volatile LAS unsigned* st) {
    XcdBarrier b; b.bar = bar; b.x = xb_xcc_id(); b.st = st;
    if (threadIdx.x == 0) (void)xb_add(&bar[XB_XCNT(b.x)], 1u);
    return b;
}
__device__ __forceinline__ void xcd_barrier_complete(unsigned* bar, unsigned x, unsigned& nloc, unsigned& nx) {
    const unsigned G = gridDim.x * gridDim.y * gridDim.z;
    unsigned sum, cnt, mine, sp = 0u;
    for (;;) {
        sum = 0u; cnt = 0u; mine = 0u;
#pragma unroll
        for (unsigned j = 0; j < 16; ++j) { const unsigned c = xb_ld(&bar[XB_XCNT(j)]); sum += c; cnt += (c > 0u) ? 1u : 0u; mine = (j == x) ? c : mine; }
        if (sum == G) break;
        __builtin_amdgcn_s_sleep(1);
        if ((++sp & 255u) == 0u) { if (xb_ld(&bar[XB_TMO])) break; if (sp > XB_SPIN_CAP) { atomicAdd(&bar[XB_TMO], 1u); break; } }
    }
    nloc = mine > 0u ? mine : 1u; nx = cnt > 0u ? cnt : 1u;
}

__device__ __forceinline__ void xcd_barrier(const XcdBarrier& b) {
    asm volatile("s_waitcnt vmcnt(0)" ::: "memory");
    __syncthreads();
    if (threadIdx.x == 0) {
        unsigned* bar = b.bar;
        __builtin_amdgcn_s_waitcnt(0);
        unsigned nloc = b.st[0], nx = b.st[1];
        if (nloc == 0u) { xcd_barrier_complete(bar, b.x, nloc, nx); b.st[0] = nloc; b.st[1] = nx; }
        const unsigned old = xb_add(&bar[XB_XSUB(b.x)], 1u);
        const unsigned gen = old / nloc;
        if (old + 1u == (gen + 1u) * nloc) {
            __builtin_amdgcn_fence(__ATOMIC_RELEASE, "agent");
            asm volatile("s_waitcnt vmcnt(0)" ::: "memory");
            const unsigned og = xb_add(&bar[XB_TOP], 1u);
            const unsigned tg = og / nx;
            if (og + 1u == (tg + 1u) * nx) xb_add(&bar[XB_TOPGEN], 1u);
            else XB_SPIN(xb_ld(&bar[XB_TOPGEN]) == tg, bar);
            __builtin_amdgcn_fence(__ATOMIC_ACQUIRE, "agent");
            xb_add(&bar[XB_XGEN(b.x)], 1u);
            asm volatile("s_waitcnt vmcnt(0)" ::: "memory");
        } else {
            XB_SPIN(xb_ld(&bar[XB_XGEN(b.x)]) == gen, bar);
            __builtin_amdgcn_fence(__ATOMIC_ACQUIRE, "agent");
            asm volatile("s_waitcnt vmcnt(0)" ::: "memory");
        }
    }
    __syncthreads();
}

#ifndef REP_SUB
#define REP_SUB 0
#endif
#ifndef REP_PH
#define REP_PH -1
#endif
#ifndef REP_MASK
#define REP_MASK 0
#endif
#ifndef UN_MASK
#define UN_MASK 31
#endif
#ifndef PH_MASK
#define PH_MASK 255
#endif
__global__ void __launch_bounds__(512, 2) hymba_mk(Params P) {
    extern __shared__ __attribute__((aligned(16))) unsigned char lds_raw[];
    ldsp L = (ldsp)lds_raw;
    u16* HB;
    volatile LAS unsigned* bst = (volatile LAS unsigned*)(L + LDS_BYTES - 64);
    if (threadIdx.x < 2) bst[threadIdx.x] = 0u;
    __syncthreads();
    const XcdBarrier xbar = xcd_barrier_post((unsigned*)(P.ws + WS_BAR), bst);
    if (P.ph_hi < 0) cg::this_grid().sync();
    for (int phi = P.ph_lo; phi < P.ph_hi + (REP_PH >= 0 ? 1 : 0); ++phi) {
        if (phi > P.ph_lo) xcd_barrier(xbar);
        const int ph = (REP_PH >= 0 && phi > REP_PH) ? phi - 1 : phi; const int rep = (REP_PH >= 0 && phi == REP_PH + 1) ? 1 : 0;
#ifdef EXTRA_SYNCS
        if (phi == 1) for (int es = 0; es < EXTRA_SYNCS; ++es) xcd_barrier(xbar);
#endif
        const __attribute__((address_space(4))) Params* pp = (const __attribute__((address_space(4))) Params*)__builtin_amdgcn_kernarg_segment_ptr();
        asm volatile("" : "+s"(pp));
        int tid = threadIdx.x; asm volatile("" : "+v"(tid));
        int bx = blockIdx.x, G = gridDim.x; asm volatile("" : "+s"(bx), "+s"(G));
        const int lane = tid & 63, wid = __builtin_amdgcn_readfirstlane(tid >> 6);
        Ctx X;
#pragma unroll
        for (int k = 0; k < 21; ++k) X.in[k] = pp->in[k];
        X.out = pp->out; X.ws = pp->ws;
        X.WinT = (u16*)(X.ws + WS_WIN); X.WoutT = (u16*)(X.ws + WS_WOUT); X.WguT = (u16*)(X.ws + WS_WGU); X.WdnT = (u16*)(X.ws + WS_WDN);
        X.COS = (float*)(X.ws + WS_ROPE); X.SIN = (float*)(X.ws + WS_ROPE + SZ_ROPE); X.XB = (u16*)(X.ws + WS_XB); X.SSP = (float*)(X.ws + WS_SSP);
        X.PROJ = (u16*)(X.ws + WS_PROJ); X.YMIX = (u16*)(X.ws + WS_YMIX); X.DT = (float*)(X.ws + WS_DT); X.CD = (float*)(X.ws + WS_CD); X.ST = (u16*)(X.ws + WS_ST); X.RS = (float*)(X.ws + WS_RS);
        HB = X.PROJ;
        if (ph == 0) { if (PH_MASK & 128) phase_prologue(X, L, tid, wid, lane); if (REP_MASK & 128) { __syncthreads(); phase_prologue(X, L, tid, wid, lane); } continue; }
        const int l = (ph - 1) / 7, k = (ph - 1) % 7;
        {
        if (k == 0 && (PH_MASK & 1)) {
            pg8::Gemm g{X.XB, X.WinT + (size_t)l * NIN * DM, M, NPROJ, DM}; pg8::StaticOrder S; S.init(M, NPROJ, G, bx);
            EpiProj E{X.PROJ, X.SSP, L + 131072};
            pg8::gemm_phase<EpiProj, pg8::StaticOrder, true, true>(L, g, S, E, tid);
            if (l == 0 && rep == 0) idle_weight_items(X, L, 0, 130 * 13, G, bx, wid, lane);
        } else if (k == 1 && (PH_MASK & 2)) {
            for (int u = bx; u < 512; u += G) {
                __syncthreads(); asm volatile("" : "+v"(tid)); const int lane = tid & 63, wid = __builtin_amdgcn_readfirstlane(tid >> 6);
                if (rep && REP_SUB == 1 && u >= 256) continue; if (rep && REP_SUB == 2 && u < 256) continue;
                if (u < 256) { if (UN_MASK & 8) ssd_states_unit(X, l, u >> 6, u & 63, L, tid, wid, lane); }
                else { if (UN_MASK & 16) ssd_sample_unit(X, l, (u - 256) >> 1, (u - 256) & 1, L, tid, wid, lane); }
            }
        } else if (k == 2 && (PH_MASK & 4)) {
#define PHB_SYNC() do { __syncthreads(); asm volatile("" : "+v"(tid)); } while (0)
            for (int u = bx; u < 256; u += G) { PHB_SYNC(); const int lane = tid & 63, wid = __builtin_amdgcn_readfirstlane(tid >> 6); attn_prompt_unit(X, l, u >> 6, u & 63, L, tid, wid, lane); }
            for (int u = bx; u < 128; u += G) { PHB_SYNC(); const int lane = tid & 63, wid = __builtin_amdgcn_readfirstlane(tid >> 6); attn_sample_unit(X, l, u, L, tid, wid, lane); }
            {
                int s0 = bx, sn = bx < 512 ? (512 - bx + G - 1) / G : 0, ss = G;
                if (G == 256) { if (bx < 128) { s0 = bx; sn = 1; ss = 1; } else { s0 = 128 + 3 * (bx - 128); sn = 3; ss = 1; } }
                if (rep == 0) for (int i2 = 0; i2 < sn; ++i2) scan_unit(X, l, s0 + i2 * ss, tid);
            }
        } else if (k == 3 && (PH_MASK & 8)) {
            for (int u = bx; u < 256; u += G) { __syncthreads(); asm volatile("" : "+v"(tid)); const int lane = tid & 63, wid = __builtin_amdgcn_readfirstlane(tid >> 6); if (rep && REP_SUB != 0) ssd_out_unit<REP_SUB>(X, l, u >> 6, u & 63, L, tid, wid, lane); else ssd_out_unit<0>(X, l, u >> 6, u & 63, L, tid, wid, lane); }
        } else if (k == 4 && (PH_MASK & 16)) {
            pg8::Gemm g{X.YMIX, X.WoutT + (size_t)l * DM * NMIX, MP, DM, NMIX}; pg8::StaticOrder S; S.init(MP, DM, G, bx);
            EpiResT<true> E{X.XB, nullptr, X.SSP, X.RS};
            pg8::gemm_phase<EpiResT<true>, pg8::StaticOrder, true, true>(L, g, S, E, tid);
            for (int u = bx; u < 256; u += G) small_res_unit(X.YMIX, X.WoutT + (size_t)l * DM * NMIX, NMIX, nullptr, X.XB, X.SSP, u, L, tid, wid, lane);
#if (REP_MASK & 256)
            if (l == 0) for (int rr = 0; rr < 4; ++rr) for (int u = bx; u < 256; u += G) small_res_unit(X.YMIX, X.WoutT + (size_t)l * DM * NMIX, NMIX, nullptr, X.XB, X.SSP, u, L, tid, wid, lane);
#endif
        } else if (k == 5 && (PH_MASK & 32)) {
            pg8::Gemm g{X.XB, X.WguT + (size_t)l * NGU * DM, M, NGU, DM}; pg8::StaticOrder S; S.init(M, NGU, G, bx);
            EpiSwiglu E{HB, X.SSP, L + 131072};
            pg8::gemm_phase<EpiSwiglu, pg8::StaticOrder, true, true>(L, g, S, E, tid);
            if (l == 0 && rep == 0) idle_weight_items(X, L, 1, 130 * 22, G, bx, wid, lane);
        } else if (PH_MASK & 64) {
            pg8::Gemm g{HB, X.WdnT + (size_t)l * DM * DFF, MP, DM, DFF}; pg8::StaticOrder S; S.init(MP, DM, G, bx);
            EpiResT<false> E{X.XB, l == NL - 1 ? X.out : nullptr, X.SSP, nullptr};
            pg8::gemm_phase<EpiResT<false>, pg8::StaticOrder, true, true>(L, g, S, E, tid);
            for (int u = bx; u < 256; u += G) small_res_unit(HB, X.WdnT + (size_t)l * DM * DFF, DFF, l == NL - 1 ? X.out : nullptr, X.XB, X.SSP, u, L, tid, wid, lane);
        }
        }
    }
}

#ifndef MK_ONE_LAUNCH
#define MK_ONE_LAUNCH 1
#endif
extern "C" void kernel_launch(void* const* d_in, const int* in_sizes, int n_in, void* d_out, int out_size, void* d_ws, size_t ws_size, hipStream_t stream) {
    static int grid = 0;
    if (grid == 0) {
        if (n_in != 21 || (size_t)out_size != O_END || ws_size < WS_BAR + SZ_BAR) { fprintf(stderr, "kernel_launch: unexpected shapes (n_in %d out %d ws %zu)\n", n_in, out_size, ws_size); grid = -1; return; }
        int dev = 0, cus = 0, per_cu = 0;
        (void)hipGetDevice(&dev); (void)hipDeviceGetAttribute(&cus, hipDeviceAttributeMultiprocessorCount, dev);
        if (hipFuncSetAttribute((const void*)hymba_mk, hipFuncAttributeMaxDynamicSharedMemorySize, LDS_BYTES) != hipSuccess) { fprintf(stderr, "kernel_launch: hipFuncSetAttribute failed\n"); grid = -1; return; }
        if (hipOccupancyMaxActiveBlocksPerMultiprocessor(&per_cu, (const void*)hymba_mk, 512, LDS_BYTES) != hipSuccess || per_cu < 1) { fprintf(stderr, "kernel_launch: occupancy query gave %d\n", per_cu); per_cu = 1; }
        (void)hipGetLastError();
        grid = cus * per_cu;
    }
    if (grid < 0) return;
    Params p{};
    for (int i = 0; i < 21; ++i) p.in[i] = (const float*)d_in[i];
    p.out = (float*)d_out; p.ws = (unsigned char*)d_ws;
#if MK_ONE_LAUNCH
    p.ph_lo = 0; p.ph_hi = N_PHASES;
    (void)hipMemsetAsync((unsigned char*)d_ws + WS_BAR, 0, SZ_BAR, stream);
    void* args[] = {&p};
    hipError_t e = hipLaunchCooperativeKernel((const void*)hymba_mk, dim3(grid), dim3(512), args, LDS_BYTES, stream);
    if (e != hipSuccess) fprintf(stderr, "cooperative launch failed: %s (grid %d)\n", hipGetErrorString(e), grid);
#else
    for (int ph = 0; ph < N_PHASES; ++ph) { p.ph_lo = ph; p.ph_hi = ph + 1; hipLaunchKernelGGL(hymba_mk, dim3(grid), dim3(512), LDS_BYTES, stream, p); }
#endif
}
```

```cpp
#include <hip/hip_runtime.h>
#include <hip/hip_cooperative_groups.h>
#include <cstdio>
#include <cstdint>
#include <cmath>
namespace cg = cooperative_groups;
namespace pg8 {
#define PG8_LAS __attribute__((address_space(3)))
typedef unsigned short bf16_t;
typedef short bf16x8 __attribute__((ext_vector_type(8)));
typedef float f32x4 __attribute__((ext_vector_type(4)));
typedef unsigned u32x4 __attribute__((ext_vector_type(4)));
constexpr int BM = 256, BK = 64, HALF = 128, HTB = HALF * BK * 2  , STAGE_BYTES = 8 * HTB, NXCD = 8, WGM = 8;

__host__ __device__ __forceinline__ int lds_byte(int r, int c) { const int st = (r >> 4) * 2 + (c >> 5), rr = r & 15, cc = c & 31, ob = rr * 64 + cc * 2; return st * 1024 + (ob ^ (((ob >> 9) & 1) << 5)); }
__host__ __device__ __forceinline__ void stage_rc(int b, int& R, int& C) { const int st = b / 1024, sb = b % 1024, swz = sb ^ (((sb >> 9) & 1) << 5); R = (st >> 1) * 16 + swz / 64; C = (st & 1) * 32 + (swz % 64) / 2; }
__host__ __device__ __forceinline__ int perm32(int rho) { const int n = rho >> 4, i = rho & 15; return 8 * (i >> 2) + 4 * n + (i & 3); }

struct Unit { int pm, pn; };
struct Gemm { const bf16_t* A; const bf16_t* Bt; int M, N, K; };

struct StaticOrder {
    int nM, nN, nwg, G, c;
    __host__ __device__ void init(int M, int N, int G_, int c_) { nM = M / BM; nN = N / BM; nwg = nM * nN; G = G_; c = c_; }
    __host__ __device__ bool next(int i, Unit& u) const {
        const long L = (long)i * G + c; if (L >= nwg) return false;
        int wgid = (int)L; { const int q = nwg / NXCD, r = nwg % NXCD, xcd = wgid % NXCD, off = wgid / NXCD; wgid = (xcd < r ? xcd * (q + 1) : r * (q + 1) + (xcd - r) * q) + off; }
        const int nig = WGM * nN, gid = wgid / nig, fm = gid * WGM, gsz = (nM - fm) < WGM ? (nM - fm) : WGM;
        u.pm = fm + ((wgid % nig) % gsz); u.pn = (wgid % nig) / gsz; return true;
    }
    __device__ __forceinline__ void a_ready(const Unit&) const {}
    __device__ __forceinline__ void done(const Unit&) const {}
};
__device__ __forceinline__ unsigned cvt_pk_bf16(float lo, float hi) { unsigned r; asm volatile("v_cvt_pk_bf16_f32 %0, %1, %2" : "=v"(r) : "v"(lo), "v"(hi)); return r; }
typedef float f32x2 __attribute__((ext_vector_type(2)));
template <class Epi, class Sched, bool ALIGN_EPI = false, bool SP2 = false>
__device__ __forceinline__ void gemm_phase(PG8_LAS unsigned char* lds, const Gemm g, const Sched& S, const Epi& E, const int tid) {
    const int wid = __builtin_amdgcn_readfirstlane(tid >> 6), lane = tid & 63, wr = wid >> 2, wc = wid & 3, fr = lane & 15, fq = lane >> 4;
    const int K = g.K, nt = K / BK;
    unsigned voffA[2], voffB[2];
#pragma unroll
    for (int i = 0; i < 2; ++i) { int R, C; stage_rc(tid * 16 + i * 8192, R, C); const int Rb = Epi::PERM ? ((R & ~31) + perm32(R & 31)) : R;
        voffA[i] = (unsigned)(R * K + C) * 2u; voffB[i] = (unsigned)(Rb * K + C) * 2u; }
    const size_t kstep = (size_t)(BK * 2);
    const size_t hstep = (size_t)HALF * K * 2;
    const size_t tstep = 2 * hstep;
    const unsigned ldsw = (unsigned)wid * 1024u;
    const int aoff = lds_byte(wr * 64 + fr, fq * 8), boff = lds_byte(wc * 32 + fr, fq * 8);
#define PG8_SA(b, h) (((b) * 2 + (h)) * HTB)
#define PG8_SB(b, h) ((4 + (b) * 2 + (h)) * HTB)
#define PG8_STAGE(bufoff, gbase, voff) do { _Pragma("unroll") for (int _i = 0; _i < 2; ++_i) \
        __builtin_amdgcn_global_load_lds((const unsigned*)((const char*)(gbase) + (voff)[_i]), (PG8_LAS unsigned*)(lds + (bufoff) + ldsw + _i * 8192), 16, 0, 0); } while (0)
#define PG8_LDA(dst, b, h) do { _Pragma("unroll") for (int m = 0; m < 4; ++m) _Pragma("unroll") for (int k = 0; k < 2; ++k) dst[m][k] = *(const PG8_LAS bf16x8*)(lds + PG8_SA(b, h) + aoff + m * 2048 + k * 1024); } while (0)
#define PG8_LDB(dst, b, h) do { _Pragma("unroll") for (int n = 0; n < 2; ++n) _Pragma("unroll") for (int k = 0; k < 2; ++k) dst[n][k] = *(const PG8_LAS bf16x8*)(lds + PG8_SB(b, h) + boff + n * 2048 + k * 1024); } while (0)
#define PG8_MMA(ai, bj, At, Bt) do { __builtin_amdgcn_s_setprio(1); _Pragma("unroll") for (int m = 0; m < 4; ++m) _Pragma("unroll") for (int n = 0; n < 2; ++n) _Pragma("unroll") for (int k = 0; k < 2; ++k) \
        acc[ai][bj][m][n] = __builtin_amdgcn_mfma_f32_16x16x32_bf16(Bt[n][k], At[m][k], acc[ai][bj][m][n], 0, 0, 0); __builtin_amdgcn_s_setprio(0); } while (0)
#define PG8_WAIT_V(n) asm volatile("s_waitcnt vmcnt(" #n ")" ::: "memory")
#define PG8_WAIT_L(n) asm volatile("s_waitcnt lgkmcnt(" #n ")" ::: "memory")
#define PG8_BAR __builtin_amdgcn_s_barrier()
#define PG8_SCHED __builtin_amdgcn_sched_barrier(0)
    Unit cur, nxt; int ui = 0;
    if (!S.next(0, cur)) return;
    f32x4 acc[2][2][4][2];
#pragma unroll
    for (int a = 0; a < 2; ++a)
#pragma unroll
        for (int b = 0; b < 2; ++b)
#pragma unroll
            for (int m = 0; m < 4; ++m)
#pragma unroll
                for (int n = 0; n < 2; ++n) acc[a][b][m][n] = (f32x4){0.f, 0.f, 0.f, 0.f};
    bf16x8 At[4][2], B0[2][2], B1[2][2];
    const char* cA = (const char*)g.A + (size_t)cur.pm * tstep; const char* cB = (const char*)g.Bt + (size_t)cur.pn * tstep;
    S.a_ready(cur);
    if constexpr (SP2) {
        PG8_STAGE(PG8_SB(0, 0), cB, voffB); PG8_STAGE(PG8_SB(0, 1), cB + hstep, voffB); PG8_STAGE(PG8_SA(0, 0), cA, voffA); PG8_STAGE(PG8_SA(0, 1), cA + hstep, voffA);
        if (wr == 1) PG8_BAR;
        PG8_WAIT_V(2); PG8_BAR;
        PG8_STAGE(PG8_SB(1, 0), cB + kstep, voffB); PG8_STAGE(PG8_SA(1, 0), cA + kstep, voffA); PG8_STAGE(PG8_SB(1, 1), cB + hstep + kstep, voffB);
        PG8_WAIT_V(6); PG8_BAR;
    } else {
        PG8_STAGE(PG8_SB(0, 0), cB, voffB); PG8_STAGE(PG8_SA(0, 0), cA, voffA); PG8_STAGE(PG8_SB(0, 1), cB + hstep, voffB); PG8_STAGE(PG8_SA(0, 1), cA + hstep, voffA);
        if (wr == 1) PG8_BAR;
        PG8_WAIT_V(4); PG8_BAR;
        PG8_STAGE(PG8_SB(1, 0), cB + kstep, voffB); PG8_STAGE(PG8_SA(1, 0), cA + kstep, voffA); PG8_STAGE(PG8_SB(1, 1), cB + hstep + kstep, voffB);
        PG8_WAIT_V(6); PG8_BAR;
    }
    for (;;) {
        const bool has_next = S.next(ui + 1, nxt);
        const char* nA = has_next ? (const char*)g.A + (size_t)nxt.pm * tstep : cA; const char* nB = has_next ? (const char*)g.Bt + (size_t)nxt.pn * tstep : cB;
        for (int t = 0; t < nt; t += 2) {
            const bool last = (t == nt - 2);
            const char* a1 = cA + (size_t)(t + 1) * kstep;
            const char* a2 = last ? nA : cA + (size_t)(t + 2) * kstep; const char* b2 = last ? nB : cB + (size_t)(t + 2) * kstep;
            const char* a3 = a2 + kstep; const char* b3 = b2 + kstep;
            if (last && has_next) S.a_ready(nxt);
            if constexpr (Epi::KSCALE) E.kscale(acc, t, cur, wr, fr);
            if constexpr (SP2) {
            PG8_LDB(B0, 0, 0); PG8_LDB(B1, 0, 1); PG8_SCHED; PG8_LDA(At, 0, 0); PG8_STAGE(PG8_SA(1, 1), a1 + hstep, voffA);
            PG8_WAIT_V(8); PG8_WAIT_L(0); PG8_BAR; PG8_MMA(0, 0, At, B0); PG8_MMA(0, 1, At, B1); PG8_BAR; PG8_SCHED;
            PG8_LDA(At, 0, 1); PG8_STAGE(PG8_SB(0, 0), b2, voffB); PG8_STAGE(PG8_SB(0, 1), b2 + hstep, voffB); PG8_STAGE(PG8_SA(0, 0), a2, voffA);
            PG8_WAIT_V(8); PG8_WAIT_L(0); PG8_BAR; PG8_MMA(1, 0, At, B0); PG8_MMA(1, 1, At, B1); PG8_BAR; PG8_SCHED;
            PG8_LDB(B0, 1, 0); PG8_LDB(B1, 1, 1); PG8_SCHED; PG8_LDA(At, 1, 0); PG8_STAGE(PG8_SA(0, 1), a2 + hstep, voffA);
            PG8_WAIT_V(8); PG8_WAIT_L(0); PG8_BAR; PG8_MMA(0, 0, At, B0); PG8_MMA(0, 1, At, B1); PG8_BAR; PG8_SCHED;
            PG8_LDA(At, 1, 1); PG8_STAGE(PG8_SB(1, 0), b3, voffB); PG8_STAGE(PG8_SB(1, 1), b3 + hstep, voffB); PG8_STAGE(PG8_SA(1, 0), a3, voffA);
            PG8_WAIT_V(8); PG8_WAIT_L(0); PG8_BAR; PG8_MMA(1, 0, At, B0); PG8_MMA(1, 1, At, B1); PG8_BAR; PG8_SCHED;
            } else {
            PG8_LDB(B0, 0, 0); PG8_SCHED; PG8_LDA(At, 0, 0); PG8_STAGE(PG8_SA(1, 1), a1 + hstep, voffA);
            PG8_WAIT_L(8); PG8_BAR; PG8_WAIT_L(0); PG8_MMA(0, 0, At, B0); PG8_BAR; PG8_SCHED;
            PG8_LDB(B1, 0, 1); PG8_STAGE(PG8_SB(0, 0), b2, voffB);
            PG8_BAR; PG8_WAIT_L(0); PG8_MMA(0, 1, At, B1); PG8_BAR;
            PG8_LDA(At, 0, 1); PG8_STAGE(PG8_SA(0, 0), a2, voffA);
            PG8_BAR; PG8_WAIT_L(0); PG8_MMA(1, 0, At, B0); PG8_BAR; PG8_SCHED;
            PG8_STAGE(PG8_SB(0, 1), b2 + hstep, voffB);
            PG8_WAIT_V(6); PG8_BAR; PG8_MMA(1, 1, At, B1); PG8_BAR;
            PG8_LDB(B0, 1, 0); PG8_SCHED; PG8_LDA(At, 1, 0); PG8_STAGE(PG8_SA(0, 1), a2 + hstep, voffA);
            PG8_WAIT_L(8); PG8_BAR; PG8_WAIT_L(0); PG8_MMA(0, 0, At, B0); PG8_BAR; PG8_SCHED;
            PG8_LDB(B1, 1, 1); PG8_STAGE(PG8_SB(1, 0), b3, voffB);
            PG8_BAR; PG8_WAIT_L(0); PG8_MMA(0, 1, At, B1); PG8_BAR;
            PG8_LDA(At, 1, 1); PG8_STAGE(PG8_SA(1, 0), a3, voffA);
            PG8_BAR; PG8_WAIT_L(0); PG8_MMA(1, 0, At, B0); PG8_BAR; PG8_SCHED;
            PG8_STAGE(PG8_SB(1, 1), b3 + hstep, voffB);
            PG8_WAIT_V(6); PG8_BAR; PG8_MMA(1, 1, At, B1); PG8_BAR;
            }
        }
        if constexpr (ALIGN_EPI) { if (wr == 0) PG8_BAR; }
        if constexpr (!Epi::AFTER_DRAIN) { E(acc, cur, wr, wc, fr, fq); S.done(cur); }
        if (!has_next) break;
#pragma unroll
        for (int a = 0; a < 2; ++a)
#pragma unroll
            for (int b = 0; b < 2; ++b)
#pragma unroll
                for (int m = 0; m < 4; ++m)
#pragma unroll
                    for (int n = 0; n < 2; ++n) acc[a][b][m][n] = (f32x4){0.f, 0.f, 0.f, 0.f};
        cur = nxt; cA = nA; cB = nB; ++ui;
        if constexpr (ALIGN_EPI) { if (wr == 1) PG8_BAR; }
    }
    PG8_WAIT_V(0);
    if constexpr (!ALIGN_EPI) { if (wr == 0) PG8_BAR; }
    PG8_BAR;
    if constexpr (Epi::AFTER_DRAIN) { E.fused(acc, cur, wr, wc, fr, fq, lds, wid, lane); S.done(cur); }
#undef PG8_SA
#undef PG8_SB
#undef PG8_STAGE
#undef PG8_LDA
#undef PG8_LDB
#undef PG8_MMA
#undef PG8_WAIT_V
#undef PG8_WAIT_L
#undef PG8_BAR
#undef PG8_SCHED
}
}
#define LAS __attribute__((address_space(3)))
typedef unsigned short u16;
typedef short bf16x8 __attribute__((ext_vector_type(8)));
typedef float f32x4 __attribute__((ext_vector_type(4)));
typedef unsigned u32x4 __attribute__((ext_vector_type(4)));
typedef unsigned u32x2 __attribute__((ext_vector_type(2)));
typedef LAS unsigned char* ldsp;

constexpr int DM = 1024, NL = 2;
constexpr int MP = 4 * 8192, MS = 128 * 4, M = MP + MS;
constexpr int NPROJ = 3328, NIN = 3344, NMIX = 1536, DFF = 2816, NGU = 5632;
constexpr int C_K = 512, C_V = 640, C_Z = 768, C_X = 1792, C_B = 2816, C_C = 3072;
constexpr float EPS = 1e-6f;
constexpr int NPOS = 8196;

constexpr size_t WS_WIN = 0;
constexpr size_t SZ_WIN = (size_t)NIN * DM * 2;
constexpr size_t WS_WOUT = WS_WIN + NL * SZ_WIN;
constexpr size_t SZ_WOUT = (size_t)DM * NMIX * 2;
constexpr size_t WS_WGU = WS_WOUT + NL * SZ_WOUT;
constexpr size_t SZ_WGU = (size_t)NGU * DM * 2;
constexpr size_t WS_WDN = WS_WGU + NL * SZ_WGU;
constexpr size_t SZ_WDN = (size_t)DM * DFF * 2;
constexpr size_t WS_ROPE = WS_WDN + NL * SZ_WDN;
constexpr size_t SZ_ROPE = (size_t)NPOS * 32 * 4;
constexpr size_t WS_XB = WS_ROPE + 2 * SZ_ROPE;
constexpr size_t WS_SSP = WS_XB + (size_t)M * DM * 2;
constexpr size_t WS_PROJ = WS_SSP + (size_t)M * 16 * 4;
constexpr size_t WS_YMIX = WS_PROJ + (size_t)M * NPROJ * 2;
constexpr size_t WS_DT = WS_YMIX + (size_t)M * NMIX * 2;
constexpr size_t WS_CD = WS_DT + (size_t)MP * 16 * 4;
constexpr size_t WS_ST = WS_CD + (size_t)4 * 64 * 16 * 4;
constexpr size_t WS_END = WS_ST + (size_t)4 * 64 * 16 * 64 * 128 * 2;
constexpr size_t WS_RS = WS_END;
constexpr size_t WS_BAR = WS_RS + (size_t)MP * 2 * 4, SZ_BAR = 16384;
static_assert(WS_BAR + SZ_BAR <= (size_t)4 * MP * DM * 4 && WS_BAR % 256 == 0, "workspace");
static_assert(WS_XB % 256 == 0 && WS_SSP % 256 == 0 && WS_PROJ % 256 == 0 && WS_YMIX % 256 == 0 && WS_DT % 256 == 0 && WS_ST % 256 == 0 && WS_ROPE % 256 == 0, "align");

constexpr size_t O_Y = 0;
constexpr size_t O_KP = (size_t)M * DM;
constexpr size_t O_VP = O_KP + (size_t)2 * 4 * 128 * 128;
constexpr size_t O_CP = O_VP + (size_t)2 * 4 * 128 * 128;
constexpr size_t O_HP = O_CP + (size_t)2 * 4 * 3 * 1536;
constexpr size_t O_KS = O_HP + (size_t)2 * 4 * 16 * 64 * 128;
constexpr size_t O_VS = O_KS + (size_t)2 * 128 * 128 * 128;
constexpr size_t O_CS = O_VS + (size_t)2 * 128 * 128 * 128;
constexpr size_t O_HS = O_CS + (size_t)2 * 128 * 3 * 1536;
constexpr size_t O_END = O_HS + (size_t)2 * 128 * 16 * 64 * 128;

constexpr int LDS_BYTES = 147456;

enum { I_XP = 0, I_XS, I_CK, I_CV, I_SCONV, I_SSSM, I_NMIX, I_WIN, I_QN, I_KN, I_SINK, I_CW, I_CB, I_DTB, I_ALOG, I_DSK, I_SNORM, I_WOUT, I_NFFN, I_WGU, I_WDN };

struct Params { const float* in[21]; float* out; unsigned char* ws; int ph_lo, ph_hi; };

typedef float f32x2_t __attribute__((ext_vector_type(2))); typedef __bf16 bf16x2_t __attribute__((ext_vector_type(2)));
__device__ __forceinline__ unsigned pk2(float lo, float hi) { f32x2_t v = {lo, hi}; bf16x2_t b = __builtin_convertvector(v, bf16x2_t); return __builtin_bit_cast(unsigned, b); }
__device__ __forceinline__ unsigned f2bf(float f) { return pk2(f, 0.f) & 0xffffu; }
__device__ __forceinline__ float bf2f(unsigned h) { return __builtin_bit_cast(float, h << 16); }
__device__ __forceinline__ float bflo(unsigned w) { return __builtin_bit_cast(float, w << 16); }
__device__ __forceinline__ float bfhi(unsigned w) { return __builtin_bit_cast(float, w & 0xffff0000u); }
__device__ __forceinline__ float silu_f(float x) { return x * __builtin_amdgcn_rcpf(1.f + __expf(-x)); }
__device__ __forceinline__ float softplus_f(float x) { return x > 15.f ? x : log1pf(__expf(x)); }
__device__ __forceinline__ float wave_sum(float v) {
#pragma unroll
    for (int o = 1; o < 64; o <<= 1) v += __shfl_xor(v, o);
    return v;
}
__device__ __forceinline__ float wave_max(float v) {
#pragma unroll
    for (int o = 1; o < 64; o <<= 1) v = fmaxf(v, __shfl_xor(v, o));
    return v;
}
__device__ __forceinline__ float wave_incl_scan(float v, int lane) {
#pragma unroll
    for (int off = 1; off < 64; off <<= 1) { const float t = __shfl_up(v, off); if (lane >= off) v += t; }
    return v;
}
__device__ __forceinline__ bf16x8 mk8(u32x2 lo, u32x2 hi) { u32x4 w; w.x = lo.x; w.y = lo.y; w.z = hi.x; w.w = hi.y; return __builtin_bit_cast(bf16x8, w); }
__device__ __forceinline__ bf16x8 lds16(ldsp p) { return __builtin_bit_cast(bf16x8, *(LAS u32x4*)p); }
__device__ __forceinline__ bf16x8 lds8x2(ldsp p0, ldsp p1) { return mk8(*(LAS u32x2*)p0, *(LAS u32x2*)p1); }
__device__ __forceinline__ f32x4 mfma16(bf16x8 a, bf16x8 b, f32x4 c) { return __builtin_amdgcn_mfma_f32_16x16x32_bf16(a, b, c, 0, 0, 0); }
#define LDS_WAIT() asm volatile("s_waitcnt lgkmcnt(0)" ::: "memory")

__device__ __forceinline__ float rstd_row(const float* ssp, int row) {
    const f32x4* p = (const f32x4*)(ssp + (size_t)row * 16);
    const f32x4 a = p[0], b = p[1], c = p[2], d = p[3];
    const float s = (((a.x + a.y) + (a.z + a.w)) + ((b.x + b.y) + (b.z + b.w))) + (((c.x + c.y) + (c.z + c.w)) + ((d.x + d.y) + (d.z + d.w)));
    return rsqrtf(s * (1.f / 1024.f) + EPS);
}

struct EpiProj {
    static constexpr bool PERM = true, AFTER_DRAIN = false, KSCALE = false;
    u16* O; const float* ssp; ldsp rsl;
    __device__ __forceinline__ void operator()(const pg8::f32x4 (&acc)[2][2][4][2], const pg8::Unit& u, int wr, int wc, int fr, int fq) const {
        const int row0 = u.pm * 256 + wr * 64 + fr, col0 = u.pn * 256 + wc * 32 + 8 * fq;
        { const int t = wc * 64 + fq * 16 + fr; if (wr == 0) ((LAS float*)rsl)[t] = rstd_row(ssp, u.pm * 256 + t);
          asm volatile("s_waitcnt lgkmcnt(0)" ::: "memory"); __builtin_amdgcn_s_barrier(); asm volatile("" ::: "memory"); }
#pragma unroll
        for (int ai = 0; ai < 2; ++ai)
#pragma unroll
            for (int m = 0; m < 4; ++m) {
                const int row = row0 + ai * 128 + m * 16; const float rs = ((LAS float*)rsl)[wr * 64 + fr + ai * 128 + m * 16]; u16* rowp = O + (size_t)row * NPROJ + col0;
#pragma unroll
                for (int bj = 0; bj < 2; ++bj) {
                    const f32x4 v0 = acc[ai][bj][m][0] * rs, v1 = acc[ai][bj][m][1] * rs; u32x4 w;
                    w.x = pg8::cvt_pk_bf16(v0[0], v0[1]); w.y = pg8::cvt_pk_bf16(v0[2], v0[3]); w.z = pg8::cvt_pk_bf16(v1[0], v1[1]); w.w = pg8::cvt_pk_bf16(v1[2], v1[3]);
                    *(u32x4*)(rowp + bj * 128) = w; }
            }
    }
};
struct EpiSwiglu {
    static constexpr bool PERM = true, AFTER_DRAIN = false, KSCALE = false;
    u16* O; const float* ssp; ldsp rsl;
    __device__ __forceinline__ void operator()(const pg8::f32x4 (&acc)[2][2][4][2], const pg8::Unit& u, int wr, int wc, int fr, int fq) const {
        const int row0 = u.pm * 256 + wr * 64 + fr, col0 = u.pn * 128 + wc * 32 + 8 * fq;
        { const int t = wc * 64 + fq * 16 + fr; if (wr == 0) ((LAS float*)rsl)[t] = rstd_row(ssp, u.pm * 256 + t);
          asm volatile("s_waitcnt lgkmcnt(0)" ::: "memory"); __builtin_amdgcn_s_barrier(); asm volatile("" ::: "memory"); }
#pragma unroll
        for (int ai = 0; ai < 2; ++ai)
#pragma unroll
            for (int m = 0; m < 4; ++m) {
                const int row = row0 + ai * 128 + m * 16; const float rs = ((LAS float*)rsl)[wr * 64 + fr + ai * 128 + m * 16];
                float h[8];
#pragma unroll
                for (int n = 0; n < 2; ++n)
#pragma unroll
                    for (int j = 0; j < 4; ++j) { const float g = acc[ai][0][m][n][j] * rs, up = acc[ai][1][m][n][j] * rs; h[n * 4 + j] = silu_f(g) * up; }
                u32x4 w; w.x = pg8::cvt_pk_bf16(h[0], h[1]); w.y = pg8::cvt_pk_bf16(h[2], h[3]); w.z = pg8::cvt_pk_bf16(h[4], h[5]); w.w = pg8::cvt_pk_bf16(h[6], h[7]);
                *(u32x4*)(O + (size_t)row * DFF + col0) = w;
            }
    }
};
template <bool KS> struct EpiResT {
    static constexpr bool PERM = false, AFTER_DRAIN = false, KSCALE = KS;
    u16* xb; float* outf; float* ssp; const float* rs;
    __device__ __forceinline__ void kscale(pg8::f32x4 (&acc)[2][2][4][2], int t, const pg8::Unit& u, int wr, int fr) const {
        if (t != 8 && t != 16) return;
#pragma unroll
        for (int ai = 0; ai < 2; ++ai)
#pragma unroll
            for (int m = 0; m < 4; ++m) {
                const int row = u.pm * 256 + wr * 64 + fr + ai * 128 + m * 16; const float s0 = rs[2 * row], s1 = rs[2 * row + 1];
                const float f = t == 8 ? s0 * __builtin_amdgcn_rcpf(s1) : s1;
#pragma unroll
                for (int bj = 0; bj < 2; ++bj)
#pragma unroll
                    for (int n = 0; n < 2; ++n) acc[ai][bj][m][n] = acc[ai][bj][m][n] * f;
            }
    }
    __device__ __forceinline__ void operator()(const pg8::f32x4 (&acc)[2][2][4][2], const pg8::Unit& u, int wr, int wc, int fr, int fq) const {
        const int row0 = u.pm * 256 + wr * 64 + fr, col0 = u.pn * 256 + wc * 32 + 4 * fq;
#pragma unroll
        for (int ai = 0; ai < 2; ++ai) {
            u32x2 rw[4][2][2];
#pragma unroll
            for (int m = 0; m < 4; ++m)
#pragma unroll
                for (int bj = 0; bj < 2; ++bj)
#pragma unroll
                    for (int n = 0; n < 2; ++n) rw[m][bj][n] = *(const u32x2*)(xb + (size_t)(row0 + ai * 128 + m * 16) * DM + col0 + bj * 128 + n * 16);
#pragma unroll
            for (int m = 0; m < 4; ++m) {
                const int row = row0 + ai * 128 + m * 16;
                u16* xp = xb + (size_t)row * DM + col0; float ss = 0.f;
#pragma unroll
                for (int bj = 0; bj < 2; ++bj)
#pragma unroll
                    for (int n = 0; n < 2; ++n) {
                        const u32x2 w0 = rw[m][bj][n]; const f32x4 r = {bflo(w0.x), bfhi(w0.x), bflo(w0.y), bfhi(w0.y)}; const f32x4 v = acc[ai][bj][m][n] + r;
                        if (outf) *(f32x4*)(outf + (size_t)row * DM + col0 + bj * 128 + n * 16) = v;
                        u32x2 w; w.x = pg8::cvt_pk_bf16(v[0], v[1]); w.y = pg8::cvt_pk_bf16(v[2], v[3]);
                        *(u32x2*)(xp + bj * 128 + n * 16) = w; ss += (v[0] * v[0] + v[1] * v[1]) + (v[2] * v[2] + v[3] * v[3]); }
                ss += __shfl_xor(ss, 16); ss += __shfl_xor(ss, 32);
                if (fq == 0) ssp[(size_t)row * 16 + u.pn * 4 + wc] = ss;
            }
        }
    }
};
struct Ctx {
    const float* in[21]; float* out; unsigned char* ws;
    u16 *WinT, *WoutT, *WguT, *WdnT; float *COS, *SIN; u16* XB; float* SSP; u16* PROJ; u16* YMIX; float* DT; float* CD; u16* ST; float* RS;
};

__device__ __forceinline__ void tr_item(const float* __restrict__ W, int K, int N, const float* __restrict__ gk, u16* WT, int perm, LAS float* scr, int item, int lane) {
    const int nblk = (N + 31) >> 5, kb = item / nblk, nb = item - kb * nblk, k0 = 64 * kb, n0 = 32 * nb;
    const int kd0 = perm == 2 ? (k0 < 512 ? k0 + 1024 : k0 - 512) : k0;
    const int nn = n0 + (lane & 31);
    float wv[32];
#pragma unroll
    for (int i = 0; i < 32; ++i) { const int kk = 2 * i + (lane >> 5); wv[i] = (nn < N) ? W[(size_t)(k0 + kk) * N + nn] : 0.f; }
#pragma unroll
    for (int i = 0; i < 32; ++i) { const int kk = 2 * i + (lane >> 5); float v = wv[i]; if (gk) { if (perm == 2) { if (k0 >= 512) v *= gk[k0 + kk - 512]; } else v *= gk[k0 + kk]; } scr[kk * 33 + (lane & 31)] = v; }
    LDS_WAIT(); asm volatile("" ::: "memory");
    const int c = lane & 7;
#pragma unroll
    for (int j = 0; j < 4; ++j) {
        const int nl = (lane >> 3) + 8 * j, n = n0 + nl;
        if (n < N) {
            int dr = n; if (perm == 1) { const int up = n >= DFF, f = up ? n - DFF : n; dr = (f >> 7) * 256 + up * 128 + (f & 127); }
            const LAS float* s = scr + (8 * c) * 33 + nl;
            u32x4 o; o.x = pk2(s[0 * 33], s[1 * 33]); o.y = pk2(s[2 * 33], s[3 * 33]); o.z = pk2(s[4 * 33], s[5 * 33]); o.w = pk2(s[6 * 33], s[7 * 33]);
            *(u32x4*)(WT + (size_t)dr * K + kd0 + 8 * c) = o; }
    }
    LDS_WAIT(); asm volatile("" ::: "memory");
}
constexpr int I_IN = (DM / 64) * ((NIN + 31) / 32), I_OUT = (NMIX / 64) * (DM / 32), I_GU = (DM / 64) * (NGU / 32), I_DN = (DFF / 64) * (DM / 32), I_L = I_IN + I_OUT + I_GU + I_DN;
__device__ __forceinline__ void tr_layer_item(const Ctx& X, int l, int r, LAS float* scr, int lane) {
    if (r < I_IN) { tr_item(X.in[I_WIN] + (size_t)l * DM * NIN, DM, NIN, X.in[I_NMIX] + l * DM, X.WinT + (size_t)l * NIN * DM, 0, scr, r, lane); return; } r -= I_IN;
    if (r < I_OUT) { tr_item(X.in[I_WOUT] + (size_t)l * NMIX * DM, NMIX, DM, X.in[I_SNORM] + l * 1024, X.WoutT + (size_t)l * DM * NMIX, 2, scr, r, lane); return; } r -= I_OUT;
    if (r < I_GU) { tr_item(X.in[I_WGU] + (size_t)l * DM * NGU, DM, NGU, X.in[I_NFFN] + l * DM, X.WguT + (size_t)l * NGU * DM, 1, scr, r, lane); return; } r -= I_GU;
    tr_item(X.in[I_WDN] + (size_t)l * DFF * DM, DFF, DM, nullptr, X.WdnT + (size_t)l * DM * DFF, 0, scr, r, lane);
}
__device__ __forceinline__ void idle_weight_items(const Ctx& X, ldsp L, int stage, int nwg, int G, int bx, int wid, int lane) {
    const int nround = (nwg + G - 1) / G, first_idle = nwg - (nround - 1) * G;
    LAS float* scr = (LAS float*)(L + wid * 16384);
    int nw = (G - first_idle) * 8, wi = (bx - first_idle) * 8 + wid;
    if (first_idle >= G) { nw = G * 8; wi = bx * 8 + wid; }
    else if (bx < first_idle) return;
    if (stage == 0) { for (int r = I_IN + wi; r < I_L; r += nw) tr_layer_item(X, 0, r, scr, lane); }
    else { for (int r = wi; r < I_L; r += nw) tr_layer_item(X, 1, r, scr, lane); }
}
__device__ __forceinline__ void phase_prologue(const Ctx& X, ldsp L, int tid, int wid, int lane) {
    LAS float* scr = (LAS float*)(L + wid * 16384);
    const int gw = blockIdx.x * 8 + wid, NGW = gridDim.x * 8;
    for (int it = gw; it < I_IN; it += NGW) tr_layer_item(X, 0, it, scr, lane);
    for (int rb = gw * 4; rb < M; rb += NGW * 4) {
        f32x4 v[4][4];
#pragma unroll
        for (int rr = 0; rr < 4; ++rr) { const int row = rb + rr; const float* xr = row < MP ? X.in[I_XP] + (size_t)row * DM : X.in[I_XS] + (size_t)(row - MP) * DM;
#pragma unroll
            for (int j = 0; j < 4; ++j) v[rr][j] = ((const f32x4*)xr)[lane + 64 * j]; }
#pragma unroll
        for (int rr = 0; rr < 4; ++rr) { const int row = rb + rr; float ss = 0.f;
#pragma unroll
            for (int j = 0; j < 4; ++j) { const f32x4 w4 = v[rr][j]; ss += (w4.x * w4.x + w4.y * w4.y) + (w4.z * w4.z + w4.w * w4.w);
                u32x2 w; w.x = pk2(w4.x, w4.y); w.y = pk2(w4.z, w4.w); ((u32x2*)(X.XB + (size_t)row * DM))[lane + 64 * j] = w; }
            ss = wave_sum(ss);
            if (lane < 16) X.SSP[(size_t)row * 16 + lane] = lane == 0 ? ss : 0.f; }
    }
    for (int idx = blockIdx.x * 512 + tid; idx < NPOS * 32; idx += gridDim.x * 512) {
        const int pi = idx >> 5, j = idx & 31; const float pos = pi < 8192 ? (float)pi : (float)(16384 + pi - 8192);
        const float inv = powf(10000.f, -(float)j * (1.f / 32.f));
        float sv, cv; sincosf(pos * inv, &sv, &cv); X.COS[idx] = cv; X.SIN[idx] = sv;
    }
}

struct ConvCol { float w0, w1, w2, w3, bias, a, b, c; const u16* p; };
__device__ __forceinline__ void conv_init(ConvCol& cc, const u16* proj, int row, bool havePrev, int xcol, const float* cw, const float* cb) {
    cc.w0 = cw[xcol]; cc.w1 = cw[1536 + xcol]; cc.w2 = cw[2 * 1536 + xcol]; cc.w3 = cw[3 * 1536 + xcol]; cc.bias = cb[xcol];
    cc.p = proj + (size_t)row * NPROJ + C_X + xcol;
    cc.a = havePrev ? bf2f(cc.p[-3 * NPROJ]) : 0.f; cc.b = havePrev ? bf2f(cc.p[-2 * NPROJ]) : 0.f; cc.c = havePrev ? bf2f(cc.p[-1 * NPROJ]) : 0.f;
}
__device__ __forceinline__ float conv_step(ConvCol& cc) {
    const float d = bf2f(*cc.p); cc.p += NPROJ;
    const float v = fmaf(cc.a, cc.w0, fmaf(cc.b, cc.w1, fmaf(cc.c, cc.w2, fmaf(d, cc.w3, cc.bias))));
    cc.a = cc.b; cc.b = cc.c; cc.c = d; return silu_f(v);
}

struct ConvW { float w0, w1, w2, w3, bias; };
__device__ __forceinline__ ConvW conv_w(const float* cw, const float* cb, int xcol) { ConvW w; w.w0 = cw[xcol]; w.w1 = cw[1536 + xcol]; w.w2 = cw[2 * 1536 + xcol]; w.w3 = cw[3 * 1536 + xcol]; w.bias = cb[xcol]; return w; }
template <int NS> __device__ __forceinline__ void conv_load(float (&raw)[NS + 3], const u16* proj, int row, bool havePrev, int xcol) {
    const u16* p = proj + (size_t)row * NPROJ + C_X + xcol;
#pragma unroll
    for (int k = 0; k < NS + 3; ++k) { unsigned v = 0u; if (k >= 3 || havePrev) v = p[(k - 3) * NPROJ]; raw[k] = bf2f(v); }
}
__device__ __forceinline__ float conv_tap(const ConvW& w, float a, float b, float c, float d) { return silu_f(fmaf(a, w.w0, fmaf(b, w.w1, fmaf(c, w.w2, fmaf(d, w.w3, w.bias))))); }

struct ConvW4 { f32x4 w0, w1, w2, w3, bias; };
__device__ __forceinline__ ConvW4 conv4_w(const float* cw, const float* cb, int xcol0) { ConvW4 w; w.w0 = *(const f32x4*)(cw + xcol0); w.w1 = *(const f32x4*)(cw + 1536 + xcol0); w.w2 = *(const f32x4*)(cw + 2 * 1536 + xcol0); w.w3 = *(const f32x4*)(cw + 3 * 1536 + xcol0); w.bias = *(const f32x4*)(cb + xcol0); return w; }
template <int NT> __device__ __forceinline__ void conv4_load(float (&raw)[NT + 3][4], const u16* proj, int row, bool havePrev, int xcol0) {
    const u16* p = proj + (size_t)row * NPROJ + C_X + xcol0;
#pragma unroll
    for (int k = 0; k < NT + 3; ++k) { u32x2 v = {0u, 0u}; if (k >= 3 || havePrev) v = *(const u32x2*)(p + (k - 3) * NPROJ); raw[k][0] = bflo(v.x); raw[k][1] = bfhi(v.x); raw[k][2] = bflo(v.y); raw[k][3] = bfhi(v.y); }
}
#define CONV4_TAP(w, raw, k, e) silu_f(fmaf(raw[(k)][e], w.w0[e], fmaf(raw[(k) + 1][e], w.w1[e], fmaf(raw[(k) + 2][e], w.w2[e], fmaf(raw[(k) + 3][e], w.w3[e], w.bias[e])))))
__device__ __forceinline__ void acum_scan(LAS float* DTL, LAS float* ACL, const float* alog, int wid, int lane) {
#pragma unroll
    for (int hh = 0; hh < 2; ++hh) {
        const int h = 2 * wid + hh; const float A = -expf(alog[h]) * 1.44269504089f;
        float v0 = DTL[h * 128 + lane] * A, v1 = DTL[h * 128 + 64 + lane] * A;
        v0 = wave_incl_scan(v0, lane); v1 = wave_incl_scan(v1, lane); v1 += __shfl(v0, 63);
        ACL[h * 128 + lane] = v0; ACL[h * 128 + 64 + lane] = v1;
    }
}

constexpr int XTP = 132;
__device__ __forceinline__ void ssd_states_unit(const Ctx& X, int l, int b, int c, ldsp L, int tid, int wid, int lane) {
    LAS float* DTL = (LAS float*)L; LAS float* ACL = (LAS float*)(L + 8192);
    LAS u16* BT = (LAS u16*)(L + 16384);
    LAS u16* XT = (LAS u16*)(L + 16384 + 33792);
    const int i = lane & 15, g = lane >> 4, r0 = b * 8192 + c * 128;
    const float* cw = X.in[I_CW] + (size_t)l * 4 * 1536; const float* cb = X.in[I_CB] + (size_t)l * 1536;
    {
        const u16* ap = X.XB + (size_t)(r0 + 16 * wid + i) * DM + 8 * g; const u16* bp = X.WinT + (size_t)l * NIN * DM + (size_t)(NPROJ + i) * DM + 8 * g;
        f32x4 acc = {0.f, 0.f, 0.f, 0.f};
#pragma unroll 16
        for (int kk = 0; kk < 32; ++kk) { const bf16x8 a = *(const bf16x8*)(ap + 32 * kk), w = *(const bf16x8*)(bp + 32 * kk); acc = mfma16(a, w, acc); }
        const float bias = X.in[I_DTB][l * 16 + i];
#pragma unroll
        for (int j = 0; j < 4; ++j) { const int tok = 16 * wid + 4 * g + j; const float dt = softplus_f(acc[j] * rstd_row(X.SSP, r0 + tok) + bias);
            DTL[i * 128 + tok] = dt; X.DT[(size_t)(r0 + tok) * 16 + i] = dt; }
    }
    __syncthreads();
    acum_scan(DTL, ACL, X.in[I_ALOG] + l * 16, wid, lane);
    __syncthreads();
    if (tid < 16) X.CD[(b * 64 + c) * 16 + tid] = __builtin_amdgcn_exp2f(ACL[tid * 128 + 127]);
    LAS float* WSL = (LAS float*)(L + 16384 + 33792 + 67584);
#pragma unroll
    for (int e = 0; e < 4; ++e) { const int idx = tid * 4 + e, h = idx >> 7; WSL[idx] = DTL[idx] * __builtin_amdgcn_exp2f(ACL[h * 128 + 127] - ACL[idx]); }
    __syncthreads();
    for (int hq = 0; hq < 4; ++hq) {
        const int grp = hq >> 1;
        if ((hq & 1) == 0) {
            const int cg = lane & 31, tok0 = 16 * wid + 8 * (lane >> 5), xcol0 = 1024 + 128 * grp + 4 * cg; const ConvW4 w = conv4_w(cw, cb, xcol0);
            float raw[11][4]; conv4_load<8>(raw, X.PROJ, r0 + tok0, !(c == 0 && tok0 == 0), xcol0);
#pragma unroll
            for (int e = 0; e < 4; ++e)
#pragma unroll
                for (int kq = 0; kq < 2; ++kq) { u32x2 pw; pw.x = pk2(CONV4_TAP(w, raw, 4 * kq, e), CONV4_TAP(w, raw, 4 * kq + 1, e)); pw.y = pk2(CONV4_TAP(w, raw, 4 * kq + 2, e), CONV4_TAP(w, raw, 4 * kq + 3, e));
                    *(LAS u32x2*)(BT + (4 * cg + e) * XTP + tok0 + 4 * kq) = pw; }
        }
        {
            const int cg = lane, tok0 = 16 * wid, xcol0 = 256 * hq + 4 * cg, h = 4 * hq + (cg >> 4); const ConvW4 w = conv4_w(cw, cb, xcol0);
            float raw[19][4]; conv4_load<16>(raw, X.PROJ, r0 + tok0, !(c == 0 && tok0 == 0), xcol0);
            float ws[16];
#pragma unroll
            for (int k4 = 0; k4 < 4; ++k4) { const f32x4 t4 = *(LAS f32x4*)(WSL + h * 128 + tok0 + 4 * k4); ws[4 * k4] = t4.x; ws[4 * k4 + 1] = t4.y; ws[4 * k4 + 2] = t4.z; ws[4 * k4 + 3] = t4.w; }
#pragma unroll
            for (int e = 0; e < 4; ++e)
#pragma unroll
                for (int kq = 0; kq < 4; ++kq) { u32x2 pw; pw.x = pk2(CONV4_TAP(w, raw, 4 * kq, e) * ws[4 * kq], CONV4_TAP(w, raw, 4 * kq + 1, e) * ws[4 * kq + 1]); pw.y = pk2(CONV4_TAP(w, raw, 4 * kq + 2, e) * ws[4 * kq + 2], CONV4_TAP(w, raw, 4 * kq + 3, e) * ws[4 * kq + 3]);
                    *(LAS u32x2*)(XT + (4 * cg + e) * XTP + tok0 + 4 * kq) = pw; }
        }
        __syncthreads();
        {
            const int hl = wid >> 1, ph = wid & 1, h = 4 * hq + hl;
            f32x4 acc[2][8];
#pragma unroll
            for (int pp = 0; pp < 2; ++pp)
#pragma unroll
                for (int nt = 0; nt < 8; ++nt) acc[pp][nt] = (f32x4){0.f, 0.f, 0.f, 0.f};
#pragma unroll 1
            for (int ks = 0; ks < 4; ++ks) {
                bf16x8 bfr[8], xfr[2];
#pragma unroll
                for (int nt = 0; nt < 8; ++nt) { ldsp p = (ldsp)(BT + (16 * nt + i) * XTP + 32 * ks + 8 * g); bfr[nt] = lds8x2(p, p + 8); }
#pragma unroll
                for (int pp = 0; pp < 2; ++pp) { ldsp p = (ldsp)(XT + (hl * 64 + 16 * (2 * ph + pp) + i) * XTP + 32 * ks + 8 * g); xfr[pp] = lds8x2(p, p + 8); }
#pragma unroll
                for (int pp = 0; pp < 2; ++pp)
#pragma unroll
                    for (int nt = 0; nt < 8; ++nt) acc[pp][nt] = mfma16(bfr[nt], xfr[pp], acc[pp][nt]);
            }
            u16* sb = X.ST + ((size_t)((b * 64 + c) * 16 + h)) * 8192;
#pragma unroll
            for (int pp = 0; pp < 2; ++pp)
#pragma unroll
                for (int nt = 0; nt < 8; ++nt) { const int p = 16 * (2 * ph + pp) + i, n = 16 * nt + 4 * g; u32x2 w; w.x = pk2(acc[pp][nt][0], acc[pp][nt][1]); w.y = pk2(acc[pp][nt][2], acc[pp][nt][3]);
                    *(u32x2*)(sb + p * 128 + n) = w; }
        }
        __syncthreads();
    }
}

__device__ __forceinline__ void ssd_sample_unit(const Ctx& X, int l, int b, int grp, ldsp L, int tid, int wid, int lane) {
    LAS float* XS = (LAS float*)L;
    LAS float* BS = (LAS float*)(L + 8192);
    LAS float* CS = (LAS float*)(L + 10240);
    LAS float* DTS = (LAS float*)(L + 12288);
    LAS float* YG = (LAS float*)(L + 12544);
    const float* cw = X.in[I_CW] + (size_t)l * 4 * 1536; const float* cb = X.in[I_CB] + (size_t)l * 1536;
    const int row0 = MP + b * 4;
    const int p = tid >> 3, nq = tid & 7, n0 = 16 * nq;
    const float* sbase = X.in[I_SSSM] + ((size_t)((l * 128 + b) * 16 + 8 * grp) * 64 + p) * 128 + n0;
    f32x4 nx[4], nx1[4], nx2[4];
#pragma unroll
    for (int e4 = 0; e4 < 4; ++e4) { nx[e4] = *(const f32x4*)(sbase + 4 * e4); nx1[e4] = *(const f32x4*)(sbase + 8192 + 4 * e4); nx2[e4] = *(const f32x4*)(sbase + 2 * 8192 + 4 * e4); }
    for (int ci = tid; ci < 768; ci += 512) {
        const int xcol = ci < 512 ? 512 * grp + ci : (ci < 640 ? 1024 + 128 * grp + (ci - 512) : 1280 + 128 * grp + (ci - 640));
        float xp[7];
#pragma unroll
        for (int j = 0; j < 3; ++j) xp[j] = X.in[I_SCONV][((size_t)(l * 128 + b) * 3 + j) * 1536 + xcol];
#pragma unroll
        for (int t = 0; t < 4; ++t) xp[3 + t] = bf2f(X.PROJ[(size_t)(row0 + t) * NPROJ + C_X + xcol]);
        const float w0 = cw[xcol], w1 = cw[1536 + xcol], w2 = cw[2 * 1536 + xcol], w3 = cw[3 * 1536 + xcol], bias = cb[xcol];
#pragma unroll
        for (int t = 0; t < 4; ++t) {
            const float v = silu_f(fmaf(xp[t], w0, fmaf(xp[t + 1], w1, fmaf(xp[t + 2], w2, fmaf(xp[t + 3], w3, bias)))));
            if (ci < 512) XS[t * 512 + ci] = v; else if (ci < 640) BS[t * 128 + ci - 512] = v; else CS[t * 128 + ci - 640] = v;
        }
#pragma unroll
        for (int j = 0; j < 3; ++j) X.out[O_CS + ((size_t)(l * 128 + b) * 3 + j) * 1536 + xcol] = xp[4 + j];
    }
    {
        const int h = 8 * grp + wid; const u16* wp = X.WinT + (size_t)l * NIN * DM + (size_t)(NPROJ + h) * DM + lane * 16;
        const u32x4 wa = *(const u32x4*)wp, wb = *(const u32x4*)(wp + 8);
#pragma unroll
        for (int t = 0; t < 4; ++t) {
            const u16* xp = X.XB + (size_t)(row0 + t) * DM + lane * 16; const u32x4 xa = *(const u32x4*)xp, xb = *(const u32x4*)(xp + 8);
            float s = 0.f;
#pragma unroll
            for (int e = 0; e < 4; ++e) { s += bflo(xa[e]) * bflo(wa[e]) + bfhi(xa[e]) * bfhi(wa[e]); s += bflo(xb[e]) * bflo(wb[e]) + bfhi(xb[e]) * bfhi(wb[e]); }
            s = wave_sum(s);
            const float dt = softplus_f(s * rstd_row(X.SSP, row0 + t) + X.in[I_DTB][l * 16 + h]);
            if (lane == 0) DTS[t * 8 + wid] = dt;
        }
    }
    __syncthreads();
#pragma unroll 1
    for (int hh = 0; hh < 8; ++hh) {
        const int h = 8 * grp + hh; const size_t sidx = ((size_t)((l * 128 + b) * 16 + h) * 64 + p) * 128 + n0;
        unsigned zr[4];
#pragma unroll
        for (int t = 0; t < 4; ++t) zr[t] = X.PROJ[(size_t)(row0 + t) * NPROJ + C_Z + 64 * h + p];
        float hst[16];
#pragma unroll
        for (int e4 = 0; e4 < 4; ++e4) { const f32x4 v = nx[e4]; hst[4 * e4] = v.x; hst[4 * e4 + 1] = v.y; hst[4 * e4 + 2] = v.z; hst[4 * e4 + 3] = v.w; nx[e4] = nx1[e4]; nx1[e4] = nx2[e4]; }
        if (hh < 5) {
#pragma unroll
            for (int e4 = 0; e4 < 4; ++e4) nx2[e4] = *(const f32x4*)(sbase + (size_t)(hh + 3) * 8192 + 4 * e4);
        }
        const float A = -expf(X.in[I_ALOG][l * 16 + h]), Dh = X.in[I_DSK][l * 16 + h];
        float y[4];
#pragma unroll
        for (int t = 0; t < 4; ++t) {
            const float dt = DTS[t * 8 + hh], dA = __expf(dt * A), dx = dt * XS[t * 512 + hh * 64 + p]; float acc = 0.f;
#pragma unroll
            for (int e = 0; e < 16; ++e) { hst[e] = fmaf(hst[e], dA, dx * BS[t * 128 + n0 + e]); acc = fmaf(hst[e], CS[t * 128 + n0 + e], acc); }
            y[t] = acc;
        }
#pragma unroll
        for (int e4 = 0; e4 < 4; ++e4) { f32x4 v; v.x = hst[4 * e4]; v.y = hst[4 * e4 + 1]; v.z = hst[4 * e4 + 2]; v.w = hst[4 * e4 + 3]; *(f32x4*)(X.out + O_HS + sidx + 4 * e4) = v; }
#pragma unroll
        for (int t = 0; t < 4; ++t) {
            float yy = y[t]; yy += __shfl_xor(yy, 1); yy += __shfl_xor(yy, 2); yy += __shfl_xor(yy, 4);
            if (nq == 0) { const float yv = yy + Dh * XS[t * 512 + hh * 64 + p]; const float z = bf2f(zr[t]); YG[t * 512 + hh * 64 + p] = yv * silu_f(z); }
        }
    }
    __syncthreads();
    if (wid < 4) {
        const int t = wid; float ss = 0.f;
#pragma unroll
        for (int k = 0; k < 8; ++k) { const float v = YG[t * 512 + lane + 64 * k]; ss += v * v; }
        ss = wave_sum(ss); const float rs = rsqrtf(ss * (1.f / 512.f) + EPS);
#pragma unroll
        for (int k = 0; k < 8; ++k) { const int col = lane + 64 * k; X.YMIX[(size_t)(row0 + t) * NMIX + 512 * grp + col] = (u16)f2bf(YG[t * 512 + col] * rs); }
    }
}
constexpr int KNP = 72;
constexpr int VTP = 264;
__device__ __forceinline__ void attn_prompt_unit(const Ctx& X, int l, int b, int nb, ldsp L, int tid, int wid, int lane) {
    LAS u16* Kn = (LAS u16*)L;
    LAS u16* Vt = (LAS u16*)(L + 73728);
    const int i = lane & 15, g = lane >> 4;
    {
        const int key = tid >> 1, part = tid & 1, tk = nb * 128 - 128 + key; const bool last = (nb == 63) && key >= 128;
        if (tk < 0) {
#pragma unroll
            for (int kvh = 0; kvh < 2; ++kvh) {
                LAS u16* kd = Kn + (kvh * 256 + key) * KNP + 16 * part; LAS u16* vd = Vt + (kvh * 64 + 16 * part) * VTP + key;
                *(LAS u32x4*)(kd) = (u32x4){0u, 0u, 0u, 0u}; *(LAS u32x4*)(kd + 8) = (u32x4){0u, 0u, 0u, 0u}; *(LAS u32x4*)(kd + 32) = (u32x4){0u, 0u, 0u, 0u}; *(LAS u32x4*)(kd + 40) = (u32x4){0u, 0u, 0u, 0u};
#pragma unroll
                for (int d = 0; d < 16; ++d) { vd[d * VTP] = 0; vd[(32 + d) * VTP] = 0; }
            }
        } else {
            const u16* src0 = X.PROJ + (size_t)(b * 8192 + tk) * NPROJ + 16 * part;
            u32x4 kw[2][4], vw[2][4];
#pragma unroll
            for (int kvh = 0; kvh < 2; ++kvh) {
                const u16* src = src0 + 64 * kvh;
                kw[kvh][0] = *(const u32x4*)(src + C_K); kw[kvh][1] = *(const u32x4*)(src + C_K + 8); kw[kvh][2] = *(const u32x4*)(src + C_K + 32); kw[kvh][3] = *(const u32x4*)(src + C_K + 40);
                vw[kvh][0] = *(const u32x4*)(src + C_V); vw[kvh][1] = *(const u32x4*)(src + C_V + 8); vw[kvh][2] = *(const u32x4*)(src + C_V + 32); vw[kvh][3] = *(const u32x4*)(src + C_V + 40);
            }
            float cs[16], sn[16];
            {
                const f32x4* cp = (const f32x4*)(X.COS + (size_t)tk * 32 + 16 * part); const f32x4* sp = (const f32x4*)(X.SIN + (size_t)tk * 32 + 16 * part);
#pragma unroll
                for (int e = 0; e < 4; ++e) { const f32x4 c4 = cp[e], s4 = sp[e]; cs[4 * e] = c4.x; cs[4 * e + 1] = c4.y; cs[4 * e + 2] = c4.z; cs[4 * e + 3] = c4.w; sn[4 * e] = s4.x; sn[4 * e + 1] = s4.y; sn[4 * e + 2] = s4.z; sn[4 * e + 3] = s4.w; }
            }
            const float* kn = X.in[I_KN] + l * 64 + 16 * part;
#pragma unroll
            for (int kvh = 0; kvh < 2; ++kvh) {
                LAS u16* kd = Kn + (kvh * 256 + key) * KNP + 16 * part; LAS u16* vd = Vt + (kvh * 64 + 16 * part) * VTP + key;
                float x1[16], x2[16]; float ss = 0.f;
#pragma unroll
                for (int q = 0; q < 4; ++q) { x1[2 * q] = bflo(kw[kvh][0][q]); x1[2 * q + 1] = bfhi(kw[kvh][0][q]); x1[8 + 2 * q] = bflo(kw[kvh][1][q]); x1[8 + 2 * q + 1] = bfhi(kw[kvh][1][q]);
                    x2[2 * q] = bflo(kw[kvh][2][q]); x2[2 * q + 1] = bfhi(kw[kvh][2][q]); x2[8 + 2 * q] = bflo(kw[kvh][3][q]); x2[8 + 2 * q + 1] = bfhi(kw[kvh][3][q]); }
#pragma unroll
                for (int d = 0; d < 16; ++d) ss += x1[d] * x1[d] + x2[d] * x2[d];
                ss += __shfl_xor(ss, 1);
                const float rs = rsqrtf(ss * (1.f / 64.f) + EPS);
#pragma unroll
                for (int d = 0; d < 16; ++d) { const float u1 = x1[d] * rs * kn[d], u2 = x2[d] * rs * kn[d + 32], c = cs[d], sv = sn[d]; x1[d] = u1 * c - u2 * sv; x2[d] = u2 * c + u1 * sv; }
#pragma unroll
                for (int e = 0; e < 2; ++e) { u32x4 w; w.x = pk2(x1[8 * e], x1[8 * e + 1]); w.y = pk2(x1[8 * e + 2], x1[8 * e + 3]); w.z = pk2(x1[8 * e + 4], x1[8 * e + 5]); w.w = pk2(x1[8 * e + 6], x1[8 * e + 7]); *(LAS u32x4*)(kd + 8 * e) = w;
                    u32x4 v; v.x = pk2(x2[8 * e], x2[8 * e + 1]); v.y = pk2(x2[8 * e + 2], x2[8 * e + 3]); v.z = pk2(x2[8 * e + 4], x2[8 * e + 5]); v.w = pk2(x2[8 * e + 6], x2[8 * e + 7]); *(LAS u32x4*)(kd + 32 + 8 * e) = v; }
                const size_t oidx = (((size_t)(l * 4 + b) * 128 + (key - 128)) * 2 + kvh) * 64 + 16 * part;
                if (last) { float* o = X.out + O_KP + oidx;
#pragma unroll
                    for (int e = 0; e < 4; ++e) { *(f32x4*)(o + 4 * e) = (f32x4){x1[4 * e], x1[4 * e + 1], x1[4 * e + 2], x1[4 * e + 3]}; *(f32x4*)(o + 32 + 4 * e) = (f32x4){x2[4 * e], x2[4 * e + 1], x2[4 * e + 2], x2[4 * e + 3]}; } }
#pragma unroll
                for (int hf = 0; hf < 2; ++hf)
#pragma unroll
                    for (int e = 0; e < 2; ++e) { const u32x4 w = vw[kvh][2 * hf + e];
#pragma unroll
                        for (int q = 0; q < 4; ++q) { vd[(32 * hf + 8 * e + 2 * q) * VTP] = (u16)(w[q] & 0xffffu); vd[(32 * hf + 8 * e + 2 * q + 1) * VTP] = (u16)(w[q] >> 16); }
                        if (last) { float* ov = X.out + O_VP + oidx + 32 * hf + 8 * e; *(f32x4*)(ov) = (f32x4){bflo(w[0]), bfhi(w[0]), bflo(w[1]), bfhi(w[1])}; *(f32x4*)(ov + 4) = (f32x4){bflo(w[2]), bfhi(w[2]), bflo(w[3]), bfhi(w[3])}; } }
            }
        }
    }
    __syncthreads();
    const int kvh = wid >> 2; const float sink = X.in[I_SINK][l * 8 + wid] * 1.44269504089f;
    const float* qn = X.in[I_QN] + l * 64;
    u32x4 nqa, nqb; f32x4 ncs0, ncs1, nsn0, nsn1;
    {
        const int tq0 = nb * 128 + i; const size_t row0q = (size_t)b * 8192 + tq0;
        nqa = *(const u32x4*)(X.PROJ + row0q * NPROJ + 64 * wid + 8 * g); nqb = *(const u32x4*)(X.PROJ + row0q * NPROJ + 64 * wid + 32 + 8 * g);
        ncs0 = *(const f32x4*)(X.COS + (size_t)tq0 * 32 + 8 * g); ncs1 = *(const f32x4*)(X.COS + (size_t)tq0 * 32 + 8 * g + 4);
        nsn0 = *(const f32x4*)(X.SIN + (size_t)tq0 * 32 + 8 * g); nsn1 = *(const f32x4*)(X.SIN + (size_t)tq0 * 32 + 8 * g + 4);
    }
    for (int qt = 0; qt < 8; ++qt) {
        const int qi = 16 * qt + i, tq = nb * 128 + qi; const size_t row = (size_t)b * 8192 + tq;
        bf16x8 qf0, qf1;
        {
            const u32x4 wa = nqa, wb = nqb; const f32x4 c0 = ncs0, c1 = ncs1, s0v = nsn0, s1v = nsn1;
            {
                const int qn_ = qt < 7 ? qt + 1 : 7; const int tqn = nb * 128 + 16 * qn_ + i; const size_t rown = (size_t)b * 8192 + tqn;
                nqa = *(const u32x4*)(X.PROJ + rown * NPROJ + 64 * wid + 8 * g); nqb = *(const u32x4*)(X.PROJ + rown * NPROJ + 64 * wid + 32 + 8 * g);
                ncs0 = *(const f32x4*)(X.COS + (size_t)tqn * 32 + 8 * g); ncs1 = *(const f32x4*)(X.COS + (size_t)tqn * 32 + 8 * g + 4);
                nsn0 = *(const f32x4*)(X.SIN + (size_t)tqn * 32 + 8 * g); nsn1 = *(const f32x4*)(X.SIN + (size_t)tqn * 32 + 8 * g + 4);
            }
            float x1[8], x2[8]; float ss = 0.f;
#pragma unroll
            for (int q = 0; q < 4; ++q) { x1[2 * q] = bflo(wa[q]); x1[2 * q + 1] = bfhi(wa[q]); x2[2 * q] = bflo(wb[q]); x2[2 * q + 1] = bfhi(wb[q]); }
#pragma unroll
            for (int e = 0; e < 8; ++e) ss += x1[e] * x1[e] + x2[e] * x2[e];
            ss += __shfl_xor(ss, 16); ss += __shfl_xor(ss, 32);
            const float rs = rsqrtf(ss * (1.f / 64.f) + EPS) * (0.125f * 1.44269504089f);
            const float cs[8] = {c0.x, c0.y, c0.z, c0.w, c1.x, c1.y, c1.z, c1.w}, sn[8] = {s0v.x, s0v.y, s0v.z, s0v.w, s1v.x, s1v.y, s1v.z, s1v.w};
            float o1[8], o2[8];
#pragma unroll
            for (int e = 0; e < 8; ++e) { const float a = x1[e] * rs * qn[8 * g + e], bb = x2[e] * rs * qn[32 + 8 * g + e], c = cs[e], s = sn[e]; o1[e] = a * c - bb * s; o2[e] = bb * c + a * s; }
            u32x4 w0, w1; w0.x = pk2(o1[0], o1[1]); w0.y = pk2(o1[2], o1[3]); w0.z = pk2(o1[4], o1[5]); w0.w = pk2(o1[6], o1[7]);
            w1.x = pk2(o2[0], o2[1]); w1.y = pk2(o2[2], o2[3]); w1.z = pk2(o2[4], o2[5]); w1.w = pk2(o2[6], o2[7]);
            qf0 = __builtin_bit_cast(bf16x8, w0); qf1 = __builtin_bit_cast(bf16x8, w1);
        }
        f32x4 s[9]; float mx = -INFINITY;
#pragma unroll
        for (int kk = 0; kk < 9; ++kk) {
            const int kt = qt + kk; ldsp kp = (ldsp)(Kn + (kvh * 256 + 16 * kt + i) * KNP + 8 * g);
            f32x4 a = {0.f, 0.f, 0.f, 0.f}; a = mfma16(lds16(kp), qf0, a); a = mfma16(lds16(kp + 64), qf1, a);
#pragma unroll
            for (int j = 0; j < 4; ++j) {
                bool ok = (nb > 0) || (kt >= 8);
                if (kk == 0) ok = ok && (4 * g + j > i);
                if (kk == 8) ok = ok && (4 * g + j <= i);
                a[j] = ok ? a[j] : -INFINITY; mx = fmaxf(mx, a[j]); }
            s[kk] = a;
        }
        mx = fmaxf(mx, __shfl_xor(mx, 16)); mx = fmaxf(mx, __shfl_xor(mx, 32)); mx = fmaxf(mx, sink);
        float sum = 0.f;
#pragma unroll
        for (int kk = 0; kk < 9; ++kk)
#pragma unroll
            for (int j = 0; j < 4; ++j) { const float p = __builtin_amdgcn_exp2f(s[kk][j] - mx); s[kk][j] = p; sum += p; }
        sum += __shfl_xor(sum, 16); sum += __shfl_xor(sum, 32);
        const float inv = __builtin_amdgcn_rcpf(sum + __builtin_amdgcn_exp2f(sink - mx));
        f32x4 o[4];
#pragma unroll
        for (int dt = 0; dt < 4; ++dt) o[dt] = (f32x4){0.f, 0.f, 0.f, 0.f};
#pragma unroll
        for (int pi = 0; pi < 5; ++pi) {
            const int k0 = 2 * pi, k1 = (2 * pi + 1 < 9) ? 2 * pi + 1 : 2 * pi;
            u32x4 pw; pw.x = pk2(s[k0][0], s[k0][1]); pw.y = pk2(s[k0][2], s[k0][3]);
            if (2 * pi + 1 < 9) { pw.z = pk2(s[k1][0], s[k1][1]); pw.w = pk2(s[k1][2], s[k1][3]); } else { pw.z = 0u; pw.w = 0u; }
            const bf16x8 pf = __builtin_bit_cast(bf16x8, pw);
#pragma unroll
            for (int dt = 0; dt < 4; ++dt) {
                LAS u16* vr = Vt + (kvh * 64 + 16 * dt + i) * VTP + 4 * g;
                const bf16x8 vf = lds8x2((ldsp)(vr + 16 * (qt + k0)), (ldsp)(vr + 16 * (qt + k1)));
                o[dt] = mfma16(vf, pf, o[dt]);
            }
        }
#pragma unroll
        for (int dt = 0; dt < 4; ++dt) { u32x2 w; w.x = pk2(o[dt][0] * inv, o[dt][1] * inv); w.y = pk2(o[dt][2] * inv, o[dt][3] * inv);
            *(u32x2*)(X.YMIX + row * NMIX + 1024 + 64 * wid + 16 * dt + 4 * g) = w; }
    }
}

__device__ __forceinline__ void scan_unit(const Ctx& X, int l, int hs, int tid) {
    const int b = hs >> 7, h = (hs >> 3) & 15, pq = hs & 7;
    const int p = 8 * pq + (tid >> 6), n = (tid & 63) * 2;
    u16* base = X.ST + ((size_t)(b * 64) * 16 + h) * 8192 + p * 128 + n;
    const float* cd = X.CD + (b * 64) * 16 + h;
    float h0 = 0.f, h1 = 0.f;
    for (int c0 = 0; c0 < 64; c0 += 32) {
        unsigned st[32]; float dc[32];
#pragma unroll
        for (int e = 0; e < 32; ++e) { st[e] = *(const unsigned*)(base + (size_t)(c0 + e) * 16 * 8192); dc[e] = cd[(c0 + e) * 16]; }
#pragma unroll
        for (int e = 0; e < 32; ++e) {
            *(unsigned*)(base + (size_t)(c0 + e) * 16 * 8192) = pk2(h0, h1);
            h0 = fmaf(h0, dc[e], bflo(st[e])); h1 = fmaf(h1, dc[e], bfhi(st[e]));
        }
    }
    float* o = X.out + O_HP + ((size_t)((l * 4 + b) * 16 + h) * 64 + p) * 128 + n; o[0] = h0; o[1] = h1;
}

constexpr int KCP = 132;
__device__ __forceinline__ void attn_sample_unit(const Ctx& X, int l, int b, ldsp L, int tid, int wid, int lane) {
    LAS u16* KC = (LAS u16*)L;
    LAS u16* VC = (LAS u16*)(L + 34848);
    LAS float* QS = (LAS float*)(L + 69696);
    LAS float* SS = (LAS float*)(L + 77888);
    const int row0 = MP + b * 4;
#pragma unroll
    for (int k = 0; k < 8; ++k) {
        const int idx = tid + 512 * k, j = idx >> 5, c4 = (idx & 31) * 4; const size_t off = ((size_t)(l * 128 + b) * 128 + j) * 128 + c4;
        const f32x4 kv = *(const f32x4*)(X.in[I_CK] + off), vv = *(const f32x4*)(X.in[I_CV] + off);
        { u32x2 kw2; kw2.x = pk2(kv.x, kv.y); kw2.y = pk2(kv.z, kv.w); *(LAS u32x2*)(KC + j * KCP + c4) = kw2; u32x2 vw2; vw2.x = pk2(vv.x, vv.y); vw2.y = pk2(vv.z, vv.w); *(LAS u32x2*)(VC + j * KCP + c4) = vw2; }
        if (j >= 4) { const size_t oo = ((size_t)(l * 128 + b) * 128 + (j - 4)) * 128 + c4; *(f32x4*)(X.out + O_KS + oo) = kv; *(f32x4*)(X.out + O_VS + oo) = vv; }
    }
    {
        const int t = wid >> 1, kvh = wid & 1; const u16* src = X.PROJ + (size_t)(row0 + t) * NPROJ;
        const float x = bf2f(src[C_K + 64 * kvh + lane]); const float ss = wave_sum(x * x);
        const float xn = x * rsqrtf(ss * (1.f / 64.f) + EPS) * X.in[I_KN][l * 64 + lane]; const float pr = __shfl_xor(xn, 32);
        const float c = X.COS[(size_t)(8192 + t) * 32 + (lane & 31)], s = X.SIN[(size_t)(8192 + t) * 32 + (lane & 31)];
        const float o = lane < 32 ? xn * c - pr * s : xn * c + pr * s;
        KC[(128 + t) * KCP + kvh * 64 + lane] = (u16)f2bf(o);
        const size_t oo = ((size_t)(l * 128 + b) * 128 + 124 + t) * 128 + kvh * 64 + lane;
        X.out[O_KS + oo] = o;
        const unsigned vraw = src[C_V + 64 * kvh + lane]; VC[(128 + t) * KCP + kvh * 64 + lane] = (u16)vraw; X.out[O_VS + oo] = bf2f(vraw);
    }
#pragma unroll
    for (int k = 0; k < 4; ++k) {
        const int pair = 4 * wid + k, t = pair >> 3, head = pair & 7;
        const float x = bf2f(X.PROJ[(size_t)(row0 + t) * NPROJ + 64 * head + lane]); const float ss = wave_sum(x * x);
        const float xn = x * rsqrtf(ss * (1.f / 64.f) + EPS) * X.in[I_QN][l * 64 + lane]; const float pr = __shfl_xor(xn, 32);
        const float c = X.COS[(size_t)(8192 + t) * 32 + (lane & 31)], s = X.SIN[(size_t)(8192 + t) * 32 + (lane & 31)];
        QS[pair * 64 + lane] = (lane < 32 ? xn * c - pr * s : xn * c + pr * s) * 0.125f;
    }
    __syncthreads();
    for (int it = 0; it < 9; ++it) {
        const int idx = tid + 512 * it;
        if (idx < 32 * 132) {
            const int pair = idx / 132, key = idx - pair * 132, t = pair >> 3, head = pair & 7, kvh = head >> 2;
            const bool ok = key < 128 ? key > t : (key - 128) <= t;
            float s = 0.f;
#pragma unroll
            for (int d = 0; d < 64; d += 4) { const u32x2 kw2 = *(LAS u32x2*)(KC + key * KCP + kvh * 64 + d); const f32x4 q4 = *(LAS f32x4*)(QS + pair * 64 + d);
                s = fmaf(q4.x, bflo(kw2.x), s); s = fmaf(q4.y, bfhi(kw2.x), s); s = fmaf(q4.z, bflo(kw2.y), s); s = fmaf(q4.w, bfhi(kw2.y), s); }
            SS[pair * 136 + key] = ok ? s : -INFINITY;
        }
    }
    __syncthreads();
#pragma unroll
    for (int k = 0; k < 4; ++k) {
        const int pair = 4 * wid + k, head = pair & 7; const float sink = X.in[I_SINK][l * 8 + head];
        const float v0 = SS[pair * 136 + lane], v1 = SS[pair * 136 + 64 + lane], v2 = lane < 4 ? SS[pair * 136 + 128 + lane] : -INFINITY;
        const float mx = fmaxf(wave_max(fmaxf(fmaxf(v0, v1), v2)), sink);
        const float e0 = __expf(v0 - mx), e1 = __expf(v1 - mx), e2 = __expf(v2 - mx);
        const float inv = 1.f / (wave_sum(e0 + e1 + e2) + __expf(sink - mx));
        SS[pair * 136 + lane] = e0 * inv; SS[pair * 136 + 64 + lane] = e1 * inv; if (lane < 4) SS[pair * 136 + 128 + lane] = e2 * inv;
    }
    __syncthreads();
    {
        const int pair = tid >> 4, d4 = (tid & 15) * 4, head = pair & 7, kvh = head >> 2, t = pair >> 3;
        float a0 = 0.f, a1 = 0.f, a2 = 0.f, a3 = 0.f;
        for (int key = 0; key < 132; ++key) {
            const float p = SS[pair * 136 + key]; const u32x2 vw2 = *(LAS u32x2*)(VC + key * KCP + kvh * 64 + d4); const unsigned w0 = vw2.x, w1 = vw2.y;
            a0 = fmaf(p, bflo(w0), a0); a1 = fmaf(p, bfhi(w0), a1); a2 = fmaf(p, bflo(w1), a2); a3 = fmaf(p, bfhi(w1), a3);
        }
        u32x2 w; w.x = pk2(a0, a1); w.y = pk2(a2, a3); *(u32x2*)(X.YMIX + (size_t)(row0 + t) * NMIX + 1024 + 64 * head + d4) = w;
    }
}

constexpr int CNP = 136;
template <int MODE> __device__ __forceinline__ void ssd_out_unit(const Ctx& X, int l, int b, int c, ldsp L, int tid, int wid, int lane) {
    LAS float* DTL = (LAS float*)L; LAS float* ACL = (LAS float*)(L + 8192);
    LAS u16* CcL = (LAS u16*)(L + 16384);
    LAS u16* CBL = (LAS u16*)(L + 16384 + 34816);
    LAS float* SSQ = (LAS float*)(L + 16384 + 34816 + 18432);
    LAS u16* XT = (LAS u16*)(L + 73728);
    LAS u16* BcL = XT;
    const int i = lane & 15, g = lane >> 4, r0 = b * 8192 + c * 128;
    const float* cw = X.in[I_CW] + (size_t)l * 4 * 1536; const float* cb = X.in[I_CB] + (size_t)l * 1536;
    { const f32x4 d4 = *(const f32x4*)(X.DT + (size_t)r0 * 16 + tid * 4); const int s_ = tid >> 2, h0 = (tid & 3) * 4;
      DTL[(h0 + 0) * 128 + s_] = d4.x; DTL[(h0 + 1) * 128 + s_] = d4.y; DTL[(h0 + 2) * 128 + s_] = d4.z; DTL[(h0 + 3) * 128 + s_] = d4.w; }
    __syncthreads();
    acum_scan(DTL, ACL, X.in[I_ALOG] + l * 16, wid, lane);
    if (c == 63) for (int idx = tid; idx < 3 * 1536; idx += 512) { const int j = idx / 1536, col = idx - j * 1536;
        X.out[O_CP + ((size_t)(l * 4 + b) * 3 + j) * 1536 + col] = bf2f(X.PROJ[(size_t)(b * 8192 + 8189 + j) * NPROJ + C_X + col]); }
    __syncthreads();
    for (int grp = 0; grp < 2; ++grp) {
        {
            const int cg = lane, tok0 = 16 * wid, isC = cg >> 5, n0 = 4 * (cg & 31), xcol0 = 1024 + 256 * isC + 128 * grp + n0; const ConvW4 w = conv4_w(cw, cb, xcol0);
            float raw[19][4]; conv4_load<16>(raw, X.PROJ, r0 + tok0, !(c == 0 && tok0 == 0), xcol0);
            LAS u16* dst = (isC ? CcL : BcL) + tok0 * CNP + n0;
#pragma unroll
            for (int k = 0; k < 16; ++k) { u32x2 pw; pw.x = pk2(CONV4_TAP(w, raw, k, 0), CONV4_TAP(w, raw, k, 1)); pw.y = pk2(CONV4_TAP(w, raw, k, 2), CONV4_TAP(w, raw, k, 3)); *(LAS u32x2*)(dst + k * CNP) = pw; }
        }
        __syncthreads();
        if (MODE != 1) for (int tix = wid; tix < 36; tix += 8) {
            int qt = 0; while ((qt + 1) * (qt + 2) / 2 <= tix) ++qt; const int st = tix - qt * (qt + 1) / 2;
            f32x4 a = {0.f, 0.f, 0.f, 0.f};
#pragma unroll
            for (int kk = 0; kk < 4; ++kk) a = mfma16(lds16((ldsp)(BcL + (16 * st + i) * CNP + 32 * kk + 8 * g)), lds16((ldsp)(CcL + (16 * qt + i) * CNP + 32 * kk + 8 * g)), a);
            { u32x2 cw; cw.x = pk2(a[0], a[1]); cw.y = pk2(a[2], a[3]); *(LAS u32x2*)(CBL + (tix * 64 + lane) * 4) = cw; }
        }
        __syncthreads();
        for (int quad = 0; quad < 2; ++quad) {
            const int hq = 2 * grp + quad;
            bf16x8 hsf[4][4];
            {
                const int cg = lane, tok0 = 16 * wid, xcol0 = 256 * hq + 4 * cg; const ConvW4 w = conv4_w(cw, cb, xcol0);
                float raw[19][4]; conv4_load<16>(raw, X.PROJ, r0 + tok0, !(c == 0 && tok0 == 0), xcol0);
                {
                    const u16* hsb = X.ST + ((size_t)((b * 64 + c) * 16 + 4 * hq + (wid >> 1))) * 8192;
#pragma unroll
                    for (int pt = 0; pt < 4; ++pt)
#pragma unroll
                        for (int kk = 0; kk < 4; ++kk) hsf[pt][kk] = *(const bf16x8*)(hsb + (16 * pt + i) * 128 + 32 * kk + 8 * g);
                }
#pragma unroll
                for (int e = 0; e < 4; ++e)
#pragma unroll
                    for (int kq = 0; kq < 4; ++kq) { u32x2 pw; pw.x = pk2(CONV4_TAP(w, raw, 4 * kq, e), CONV4_TAP(w, raw, 4 * kq + 1, e)); pw.y = pk2(CONV4_TAP(w, raw, 4 * kq + 2, e), CONV4_TAP(w, raw, 4 * kq + 3, e));
                        *(LAS u32x2*)(XT + (4 * cg + e) * XTP + tok0 + 4 * kq) = pw; }
            }
            __syncthreads();
            if (MODE != 1) {
                const int hl = wid >> 1, half = wid & 1, h = 4 * hq + hl, hh = quad * 4 + hl;
                const float Dh = X.in[I_DSK][l * 16 + h];
                for (int qx = 0; qx < 4; ++qx) {
                    const int qt = qx == 0 ? half : (qx == 1 ? 3 - half : (qx == 2 ? 4 + half : 7 - half));
                    const int q = 16 * qt + i; const float aq = ACL[h * 128 + q], eaq = __builtin_amdgcn_exp2f(aq);
                    const size_t row = (size_t)r0 + q; u32x2 zw[4];
#pragma unroll
                    for (int pt = 0; pt < 4; ++pt) zw[pt] = *(const u32x2*)(X.PROJ + row * NPROJ + C_Z + 64 * h + 16 * pt + 4 * g);
                    f32x4 accy[4], acci[4];
#pragma unroll
                    for (int pt = 0; pt < 4; ++pt) { accy[pt] = (f32x4){0.f, 0.f, 0.f, 0.f}; acci[pt] = (f32x4){0.f, 0.f, 0.f, 0.f}; }
#pragma unroll
                    for (int kk = 0; kk < 4; ++kk) { const bf16x8 cf = lds16((ldsp)(CcL + q * CNP + 32 * kk + 8 * g));
#pragma unroll
                        for (int pt = 0; pt < 4; ++pt) accy[pt] = mfma16(hsf[pt][kk], cf, accy[pt]); }
                    const int tb = qt * (qt + 1) / 2, npair = qt / 2 + 1;
                    for (int pi = 0; pi < npair; ++pi) {
                        const int st0 = 2 * pi; const bool has1 = (st0 + 1) <= qt; const int st1 = has1 ? st0 + 1 : st0;
                        float m0[4], m1[4];
                        {
                            const int sa0 = 16 * st0 + 4 * g, sb0 = 16 * st1 + 4 * g;
                            const u32x2 cwa = *(LAS u32x2*)(CBL + ((tb + st0) * 64 + lane) * 4), cwb = *(LAS u32x2*)(CBL + ((tb + st1) * 64 + lane) * 4);
                            const f32x4 aca = *(LAS f32x4*)(ACL + h * 128 + sa0), acb = *(LAS f32x4*)(ACL + h * 128 + sb0);
                            const f32x4 dta = *(LAS f32x4*)(DTL + h * 128 + sa0), dtb = *(LAS f32x4*)(DTL + h * 128 + sb0);
                            const float ca[4] = {bflo(cwa.x), bfhi(cwa.x), bflo(cwa.y), bfhi(cwa.y)}, cb4[4] = {bflo(cwb.x), bfhi(cwb.x), bflo(cwb.y), bfhi(cwb.y)};
#pragma unroll
                            for (int j = 0; j < 4; ++j) {
                                const float va = ca[j] * __builtin_amdgcn_exp2f(aq - aca[j]) * dta[j], vb = cb4[j] * __builtin_amdgcn_exp2f(aq - acb[j]) * dtb[j];
                                const bool dj = (4 * g + j) <= i;
                                m0[j] = (st0 < qt || dj) ? va : 0.f; m1[j] = (has1 && (st1 < qt || dj)) ? vb : 0.f;
                            }
                        }
                        u32x4 mw; mw.x = pk2(m0[0], m0[1]); mw.y = pk2(m0[2], m0[3]); mw.z = pk2(m1[0], m1[1]); mw.w = pk2(m1[2], m1[3]);
                        const bf16x8 mf = __builtin_bit_cast(bf16x8, mw);
#pragma unroll
                        for (int pt = 0; pt < 4; ++pt) { LAS u16* xr = XT + (hl * 64 + 16 * pt + i) * XTP + 4 * g;
                            acci[pt] = mfma16(lds8x2((ldsp)(xr + 16 * st0), (ldsp)(xr + 16 * st1)), mf, acci[pt]); }
                    }
                    float ss = 0.f;
#pragma unroll
                    for (int pt = 0; pt < 4; ++pt) {
                        const int p0 = 16 * pt + 4 * g;
                        const float z[4] = {bflo(zw[pt].x), bfhi(zw[pt].x), bflo(zw[pt].y), bfhi(zw[pt].y)}; float o[4];
#pragma unroll
                        for (int j = 0; j < 4; ++j) { const float xv = bf2f(XT[(hl * 64 + p0 + j) * XTP + q]); const float y = acci[pt][j] + eaq * accy[pt][j] + Dh * xv; o[j] = y * silu_f(z[j]); ss += o[j] * o[j]; }
                        u32x2 w; w.x = pk2(o[0], o[1]); w.y = pk2(o[2], o[3]); *(u32x2*)(X.YMIX + row * NMIX + 64 * h + p0) = w;
                    }
                    ss += __shfl_xor(ss, 16); ss += __shfl_xor(ss, 32);
                    if (g == 0) SSQ[q * 8 + hh] = ss;
                }
            }
            __syncthreads();
        }
        if (MODE == 0 && tid < 128) {
            const f32x4 s0 = *(LAS f32x4*)(SSQ + tid * 8), s1 = *(LAS f32x4*)(SSQ + tid * 8 + 4);
            X.RS[((size_t)r0 + tid) * 2 + grp] = rsqrtf((((s0.x + s0.y) + (s0.z + s0.w)) + ((s1.x + s1.y) + (s1.z + s1.w))) * (1.f / 512.f) + EPS);
        }
        __syncthreads();
    }
}
constexpr int N_PHASES = 1 + 7 * NL;

__device__ __forceinline__ void small_res_unit(const u16* A, const u16* WT, int K, float* outf, u16* xb, float* ssp, int u, ldsp L, int tid, int wid, int lane) {
    const int rt = u >> 4, ct = u & 15, i = lane & 15, g = lane >> 4;
    const int trow = 32 * rt + 16 * (wid >> 2) + i, col0 = 64 * ct + 16 * (wid & 3);
    const u16* ap = A + (size_t)(MP + trow) * K + 8 * g; const u16* wp = WT + (size_t)(col0 + i) * K + 8 * g;
    f32x4 acc = {0.f, 0.f, 0.f, 0.f};
    if (K == NMIX) {
#pragma unroll 24
        for (int kk = 0; kk < NMIX / 32; ++kk) acc = mfma16(*(const bf16x8*)(wp + 32 * kk), *(const bf16x8*)(ap + 32 * kk), acc);
    } else {
#pragma unroll 22
        for (int kk = 0; kk < DFF / 32; ++kk) acc = mfma16(*(const bf16x8*)(wp + 32 * kk), *(const bf16x8*)(ap + 32 * kk), acc);
    }
    const size_t o = (size_t)(MP + trow) * DM + col0 + 4 * g;
    const u32x2 rw = *(const u32x2*)(xb + o); const f32x4 r = {bflo(rw.x), bfhi(rw.x), bflo(rw.y), bfhi(rw.y)};
    const f32x4 v = acc + r;
    if (outf) *(f32x4*)(outf + o) = v;
    u32x2 w; w.x = pk2(v[0], v[1]); w.y = pk2(v[2], v[3]); *(u32x2*)(xb + o) = w;
    float ss = (v[0] * v[0] + v[1] * v[1]) + (v[2] * v[2] + v[3] * v[3]); ss += __shfl_xor(ss, 16); ss += __shfl_xor(ss, 32);
    LAS float* red = (LAS float*)L;
    if (g == 0) red[wid * 16 + i] = ss;
    __syncthreads();
    if (tid < 32) { const int hw = tid >> 4, t = tid & 15; ssp[(size_t)(MP + 32 * rt + 16 * hw + t) * 16 + ct] = (red[(4 * hw) * 16 + t] + red[(4 * hw + 1) * 16 + t]) + (red[(4 * hw + 2) * 16 + t] + red[(4 * hw + 3) * 16 + t]); }
    __syncthreads();
}

__device__ __forceinline__ void small_swiglu_unit(const u16* A, const u16* WT, const float* ssp, u16* H, int u, int wid, int lane) {
    const int rt = u / 44, ct = u - rt * 44, i = lane & 15, g = lane >> 4;
    const int trow = MP + 32 * rt + 16 * (wid >> 2) + i, f0 = 64 * ct + 16 * (wid & 3);
    const int wrow = (f0 >> 7) * 256 + (f0 & 127) + i;
    const u16* ap = A + (size_t)trow * DM + 8 * g; const u16* gp = WT + (size_t)wrow * DM + 8 * g; const u16* up = gp + (size_t)128 * DM;
    f32x4 ag = {0.f, 0.f, 0.f, 0.f}, au = {0.f, 0.f, 0.f, 0.f};
#pragma unroll 8
    for (int kk = 0; kk < DM / 32; ++kk) { const bf16x8 a = *(const bf16x8*)(ap + 32 * kk); ag = mfma16(*(const bf16x8*)(gp + 32 * kk), a, ag); au = mfma16(*(const bf16x8*)(up + 32 * kk), a, au); }
    const float rs = rstd_row(ssp, trow);
    u32x2 w; w.x = pk2(silu_f(ag[0] * rs) * (au[0] * rs), silu_f(ag[1] * rs) * (au[1] * rs)); w.y = pk2(silu_f(ag[2] * rs) * (au[2] * rs), silu_f(ag[3] * rs) * (au[3] * rs));
    *(u32x2*)(H + (size_t)trow * DFF + f0 + 4 * g) = w;
}
#define XB_TMO      128
#define XB_XCNT(j)  (256  + 64 * (j))
#define XB_XSUB(j)  (1280 + 64 * (j))
#define XB_XGEN(j)  (2304 + 64 * (j))
#define XB_TOP      3328
#define XB_TOPGEN   3392
#define XCD_BAR_WORDS 3456
#define XB_SPIN_CAP (1u << 18)

__device__ __forceinline__ unsigned xb_ld(unsigned* p)              { return __hip_atomic_load(p, __ATOMIC_RELAXED, __HIP_MEMORY_SCOPE_AGENT); }
__device__ __forceinline__ unsigned xb_add(unsigned* p, unsigned v) { return __hip_atomic_fetch_add(p, v, __ATOMIC_RELAXED, __HIP_MEMORY_SCOPE_AGENT); }
__device__ __forceinline__ unsigned xb_xcc_id() { return (unsigned)__builtin_amdgcn_s_getreg((3 << 11) | 20) & 0xFu; }
#define XB_SPIN(cond, bar) do { unsigned _sp = 0; while (cond) { __builtin_amdgcn_s_sleep(1); \
    if ((++_sp & 255u) == 0u) { if (xb_ld(&(bar)[XB_TMO])) break; if (_sp > XB_SPIN_CAP) { atomicAdd(&(bar)[XB_TMO], 1u); break; } } } } while (0)

struct XcdBarrier {
    unsigned* bar; unsigned x;
    volatile LAS unsigned* st;
};

__device__ __forceinline__ XcdBarrier xcd_barrier_post(unsigned* bar, volatile LAS unsigned* st) {
    XcdBarrier b; b.bar = bar; b.x = xb_xcc_id(); b.st = st;
    if (threadIdx.x == 0) (void)xb_add(&bar[XB_XCNT(b.x)], 1u);
    return b;
}
__device__ __forceinline__ void xcd_barrier_complete(unsigned* bar, unsigned x, unsigned& nloc, unsigned& nx) {
    const unsigned G = gridDim.x * gridDim.y * gridDim.z;
    unsigned sum, cnt, mine, sp = 0u;
    for (;;) {
        sum = 0u; cnt = 0u; mine = 0u;
#pragma unroll
        for (unsigned j = 0; j < 16; ++j) { const unsigned c = xb_ld(&bar[XB_XCNT(j)]); sum += c; cnt += (c > 0u) ? 1u : 0u; mine = (j == x) ? c : mine; }
        if (sum == G) break;
        __builtin_amdgcn_s_sleep(1);
        if ((++sp & 255u) == 0u) { if (xb_ld(&bar[XB_TMO])) break; if (sp > XB_SPIN_CAP) { atomicAdd(&bar[XB_TMO], 1u); break; } }
    }
    nloc = mine > 0u ? mine : 1u; nx = cnt > 0u ? cnt : 1u;
}

__device__ __forceinline__ void xcd_barrier(const XcdBarrier& b) {
    asm volatile("s_waitcnt vmcnt(0)" ::: "memory");
    __syncthreads();
    if (threadIdx.x == 0) {
        unsigned* bar = b.bar;
        __builtin_amdgcn_s_waitcnt(0);
        unsigned nloc = b.st[0], nx = b.st[1];
        if (nloc == 0u) { xcd_barrier_complete(bar, b.x, nloc, nx); b.st[0] = nloc; b.st[1] = nx; }
        const unsigned old = xb_add(&bar[XB_XSUB(b.x)], 1u);
        const unsigned gen = old / nloc;
        if (old + 1u == (gen + 1u) * nloc) {
            __builtin_amdgcn_fence(__ATOMIC_RELEASE, "agent");
            asm volatile("s_waitcnt vmcnt(0)" ::: "memory");
            const unsigned og = xb_add(&bar[XB_TOP], 1u);
            const unsigned tg = og / nx;
            if (og + 1u == (tg + 1u) * nx) xb_add(&bar[XB_TOPGEN], 1u);
            else XB_SPIN(xb_ld(&bar[XB_TOPGEN]) == tg, bar);
            __builtin_amdgcn_fence(__ATOMIC_ACQUIRE, "agent");
            xb_add(&bar[XB_XGEN(b.x)], 1u);
            asm volatile("s_waitcnt vmcnt(0)" ::: "memory");
        } else {
            XB_SPIN(xb_ld(&bar[XB_XGEN(b.x)]) == gen, bar);
            __builtin_amdgcn_fence(__ATOMIC_ACQUIRE, "agent");
            asm volatile("s_waitcnt vmcnt(0)" ::: "memory");
        }
    }
    __syncthreads();
}

#ifndef REP_SUB
#define REP_SUB 0
#endif
#ifndef REP_PH
#define REP_PH -1
#endif
#ifndef REP_MASK
#define REP_MASK 0
#endif
#ifndef UN_MASK
#define UN_MASK 31
#endif
#ifndef PH_MASK
#define PH_MASK 255
#endif
__global__ void __launch_bounds__(512, 2) hymba_mk(Params P) {
    extern __shared__ __attribute__((aligned(16))) unsigned char lds_raw[];
    ldsp L = (ldsp)lds_raw;
    u16* HB;
    volatile LAS unsigned* bst = (volatile LAS unsigned*)(L + LDS_BYTES - 64);
    if (threadIdx.x < 2) bst[threadIdx.x] = 0u;
    __syncthreads();
    const XcdBarrier xbar = xcd_barrier_post((unsigned*)(P.ws + WS_BAR), bst);
    if (P.ph_hi < 0) cg::this_grid().sync();
    for (int phi = P.ph_lo; phi < P.ph_hi + (REP_PH >= 0 ? 1 : 0); ++phi) {
        if (phi > P.ph_lo) xcd_barrier(xbar);
        const int ph = (REP_PH >= 0 && phi > REP_PH) ? phi - 1 : phi; const int rep = (REP_PH >= 0 && phi == REP_PH + 1) ? 1 : 0;
#ifdef EXTRA_SYNCS
        if (phi == 1) for (int es = 0; es < EXTRA_SYNCS; ++es) xcd_barrier(xbar);
#endif
        const __attribute__((address_space(4))) Params* pp = (const __attribute__((address_space(4))) Params*)__builtin_amdgcn_kernarg_segment_ptr();
        asm volatile("" : "+s"(pp));
        int tid = threadIdx.x; asm volatile("" : "+v"(tid));
        int bx = blockIdx.x, G = gridDim.x; asm volatile("" : "+s"(bx), "+s"(G));
        const int lane = tid & 63, wid = __builtin_amdgcn_readfirstlane(tid >> 6);
        Ctx X;
#pragma unroll
        for (int k = 0; k < 21; ++k) X.in[k] = pp->in[k];
        X.out = pp->out; X.ws = pp->ws;
        X.WinT = (u16*)(X.ws + WS_WIN); X.WoutT = (u16*)(X.ws + WS_WOUT); X.WguT = (u16*)(X.ws + WS_WGU); X.WdnT = (u16*)(X.ws + WS_WDN);
        X.COS = (float*)(X.ws + WS_ROPE); X.SIN = (float*)(X.ws + WS_ROPE + SZ_ROPE); X.XB = (u16*)(X.ws + WS_XB); X.SSP = (float*)(X.ws + WS_SSP);
        X.PROJ = (u16*)(X.ws + WS_PROJ); X.YMIX = (u16*)(X.ws + WS_YMIX); X.DT = (float*)(X.ws + WS_DT); X.CD = (float*)(X.ws + WS_CD); X.ST = (u16*)(X.ws + WS_ST); X.RS = (float*)(X.ws + WS_RS);
        HB = X.PROJ;
        if (ph == 0) { if (PH_MASK & 128) phase_prologue(X, L, tid, wid, lane); if (REP_MASK & 128) { __syncthreads(); phase_prologue(X, L, tid, wid, lane); } continue; }
        const int l = (ph - 1) / 7, k = (ph - 1) % 7;
        {
        if (k == 0 && (PH_MASK & 1)) {
            pg8::Gemm g{X.XB, X.WinT + (size_t)l * NIN * DM, M, NPROJ, DM}; pg8::StaticOrder S; S.init(M, NPROJ, G, bx);
            EpiProj E{X.PROJ, X.SSP, L + 131072};
            pg8::gemm_phase<EpiProj, pg8::StaticOrder, true, true>(L, g, S, E, tid);
            if (l == 0 && rep == 0) idle_weight_items(X, L, 0, 130 * 13, G, bx, wid, lane);
        } else if (k == 1 && (PH_MASK & 2)) {
            for (int u = bx; u < 512; u += G) {
                __syncthreads(); asm volatile("" : "+v"(tid)); const int lane = tid & 63, wid = __builtin_amdgcn_readfirstlane(tid >> 6);
                if (rep && REP_SUB == 1 && u >= 256) continue; if (rep && REP_SUB == 2 && u < 256) continue;
                if (u < 256) { if (UN_MASK & 8) ssd_states_unit(X, l, u >> 6, u & 63, L, tid, wid, lane); }
                else { if (UN_MASK & 16) ssd_sample_unit(X, l, (u - 256) >> 1, (u - 256) & 1, L, tid, wid, lane); }
            }
        } else if (k == 2 && (PH_MASK & 4)) {
#define PHB_SYNC() do { __syncthreads(); asm volatile("" : "+v"(tid)); } while (0)
            for (int u = bx; u < 256; u += G) { PHB_SYNC(); const int lane = tid & 63, wid = __builtin_amdgcn_readfirstlane(tid >> 6); attn_prompt_unit(X, l, u >> 6, u & 63, L, tid, wid, lane); }
            for (int u = bx; u < 128; u += G) { PHB_SYNC(); const int lane = tid & 63, wid = __builtin_amdgcn_readfirstlane(tid >> 6); attn_sample_unit(X, l, u, L, tid, wid, lane); }
            {
                int s0 = bx, sn = bx < 512 ? (512 - bx + G - 1) / G : 0, ss = G;
                if (G == 256) { if (bx < 128) { s0 = bx; sn = 1; ss = 1; } else { s0 = 128 + 3 * (bx - 128); sn = 3; ss = 1; } }
                if (rep == 0) for (int i2 = 0; i2 < sn; ++i2) scan_unit(X, l, s0 + i2 * ss, tid);
            }
        } else if (k == 3 && (PH_MASK & 8)) {
            for (int u = bx; u < 256; u += G) { __syncthreads(); asm volatile("" : "+v"(tid)); const int lane = tid & 63, wid = __builtin_amdgcn_readfirstlane(tid >> 6); if (rep && REP_SUB != 0) ssd_out_unit<REP_SUB>(X, l, u >> 6, u & 63, L, tid, wid, lane); else ssd_out_unit<0>(X, l, u >> 6, u & 63, L, tid, wid, lane); }
        } else if (k == 4 && (PH_MASK & 16)) {
            pg8::Gemm g{X.YMIX, X.WoutT + (size_t)l * DM * NMIX, MP, DM, NMIX}; pg8::StaticOrder S; S.init(MP, DM, G, bx);
            EpiResT<true> E{X.XB, nullptr, X.SSP, X.RS};
            pg8::gemm_phase<EpiResT<true>, pg8::StaticOrder, true, true>(L, g, S, E, tid);
            for (int u = bx; u < 256; u += G) small_res_unit(X.YMIX, X.WoutT + (size_t)l * DM * NMIX, NMIX, nullptr, X.XB, X.SSP, u, L, tid, wid, lane);
#if (REP_MASK & 256)
            if (l == 0) for (int rr = 0; rr < 4; ++rr) for (int u = bx; u < 256; u += G) small_res_unit(X.YMIX, X.WoutT + (size_t)l * DM * NMIX, NMIX, nullptr, X.XB, X.SSP, u, L, tid, wid, lane);
#endif
        } else if (k == 5 && (PH_MASK & 32)) {
            pg8::Gemm g{X.XB, X.WguT + (size_t)l * NGU * DM, M, NGU, DM}; pg8::StaticOrder S; S.init(M, NGU, G, bx);
            EpiSwiglu E{HB, X.SSP, L + 131072};
            pg8::gemm_phase<EpiSwiglu, pg8::StaticOrder, true, true>(L, g, S, E, tid);
            if (l == 0 && rep == 0) idle_weight_items(X, L, 1, 130 * 22, G, bx, wid, lane);
        } else if (PH_MASK & 64) {
            pg8::Gemm g{HB, X.WdnT + (size_t)l * DM * DFF, MP, DM, DFF}; pg8::StaticOrder S; S.init(MP, DM, G, bx);
            EpiResT<false> E{X.XB, l == NL - 1 ? X.out : nullptr, X.SSP, nullptr};
            pg8::gemm_phase<EpiResT<false>, pg8::StaticOrder, true, true>(L, g, S, E, tid);
            for (int u = bx; u < 256; u += G) small_res_unit(HB, X.WdnT + (size_t)l * DM * DFF, DFF, l == NL - 1 ? X.out : nullptr, X.XB, X.SSP, u, L, tid, wid, lane);
        }
        }
    }
}

#ifndef MK_ONE_LAUNCH
#define MK_ONE_LAUNCH 1
#endif
extern "C" void kernel_launch(void* const* d_in, const int* in_sizes, int n_in, void* d_out, int out_size, void* d_ws, size_t ws_size, hipStream_t stream) {
    static int grid = 0;
    if (grid == 0) {
        if (n_in != 21 || (size_t)out_size != O_END || ws_size < WS_BAR + SZ_BAR) { fprintf(stderr, "kernel_launch: unexpected shapes (n_in %d out %d ws %zu)\n", n_in, out_size, ws_size); grid = -1; return; }
        int dev = 0, cus = 0, per_cu = 0;
        (void)hipGetDevice(&dev); (void)hipDeviceGetAttribute(&cus, hipDeviceAttributeMultiprocessorCount, dev);
        if (hipFuncSetAttribute((const void*)hymba_mk, hipFuncAttributeMaxDynamicSharedMemorySize, LDS_BYTES) != hipSuccess) { fprintf(stderr, "kernel_launch: hipFuncSetAttribute failed\n"); grid = -1; return; }
        if (hipOccupancyMaxActiveBlocksPerMultiprocessor(&per_cu, (const void*)hymba_mk, 512, LDS_BYTES) != hipSuccess || per_cu < 1) { fprintf(stderr, "kernel_launch: occupancy query gave %d\n", per_cu); per_cu = 1; }
        (void)hipGetLastError();
        grid = cus * per_cu;
    }
    if (grid < 0) return;
    Params p{};
    for (int i = 0; i < 21; ++i) p.in[i] = (const float*)d_in[i];
    p.out = (float*)d_out; p.ws = (unsigned char*)d_ws;
#if MK_ONE_LAUNCH
    p.ph_lo = 0; p.ph_hi = N_PHASES;
    (void)hipMemsetAsync((unsigned char*)d_ws + WS_BAR, 0, SZ_BAR, stream);
    void* args[] = {&p};
    hipError_t e = hipLaunchCooperativeKernel((const void*)hymba_mk, dim3(grid), dim3(512), args, LDS_BYTES, stream);
    if (e != hipSuccess) fprintf(stderr, "cooperative launch failed: %s (grid %d)\n", hipGetErrorString(e), grid);
#else
    for (int ph = 0; ph < N_PHASES; ++ph) { p.ph_lo = ph; p.ph_hi = ph + 1; hipLaunchKernelGGL(hymba_mk, dim3(grid), dim3(512), LDS_BYTES, stream, p); }
#endif
}
```

```cpp
#include <hip/hip_runtime.h>
#include <hip/hip_cooperative_groups.h>
#include <cstdio>
#include <cstdint>
#include <cmath>
namespace cg = cooperative_groups;
#pragma clang fp reassociate(on) contract(fast)
namespace pg8 {
#define PG8_LAS __attribute__((address_space(3)))
typedef unsigned short bf16_t;
typedef short bf16x8 __attribute__((ext_vector_type(8)));
typedef float f32x4 __attribute__((ext_vector_type(4)));
typedef unsigned u32x4 __attribute__((ext_vector_type(4)));
constexpr int BM = 256, BK = 64, HALF = 128, HTB = HALF * BK * 2  , STAGE_BYTES = 8 * HTB, NXCD = 8, WGM = 8;

__host__ __device__ __forceinline__ int lds_byte(int r, int c) { const int st = (r >> 4) * 2 + (c >> 5), rr = r & 15, cc = c & 31, ob = rr * 64 + cc * 2; return st * 1024 + (ob ^ (((ob >> 9) & 1) << 5)); }
__host__ __device__ __forceinline__ void stage_rc(int b, int& R, int& C) { const int st = b / 1024, sb = b % 1024, swz = sb ^ (((sb >> 9) & 1) << 5); R = (st >> 1) * 16 + swz / 64; C = (st & 1) * 32 + (swz % 64) / 2; }
__host__ __device__ __forceinline__ int perm32(int rho) { const int n = rho >> 4, i = rho & 15; return 8 * (i >> 2) + 4 * n + (i & 3); }

struct Unit { int pm, pn; };
struct Gemm { const bf16_t* A; const bf16_t* Bt; int M, N, K; };

struct StaticOrder {
    int nM, nN, nwg, G, c;
    __host__ __device__ void init(int M, int N, int G_, int c_) { nM = M / BM; nN = N / BM; nwg = nM * nN; G = G_; c = c_; }
    __host__ __device__ bool next(int i, Unit& u) const {
        const long L = (long)i * G + c; if (L >= nwg) return false;
        int wgid = (int)L; { const int q = nwg / NXCD, r = nwg % NXCD, xcd = wgid % NXCD, off = wgid / NXCD; wgid = (xcd < r ? xcd * (q + 1) : r * (q + 1) + (xcd - r) * q) + off; }
        const int nig = WGM * nN, gid = wgid / nig, fm = gid * WGM, gsz = (nM - fm) < WGM ? (nM - fm) : WGM;
        u.pm = fm + ((wgid % nig) % gsz); u.pn = (wgid % nig) / gsz; return true;
    }
    __device__ __forceinline__ void a_ready(const Unit&) const {}
    __device__ __forceinline__ void done(const Unit&) const {}
};
__device__ __forceinline__ unsigned cvt_pk_bf16(float lo, float hi) { unsigned r; asm volatile("v_cvt_pk_bf16_f32 %0, %1, %2" : "=v"(r) : "v"(lo), "v"(hi)); return r; }
typedef float f32x2 __attribute__((ext_vector_type(2)));
template <class Epi, class Sched, bool ALIGN_EPI = false, bool SP2 = false>
__device__ __forceinline__ void gemm_phase(PG8_LAS unsigned char* lds, const Gemm g, const Sched& S, const Epi& E, const int tid) {
    const int wid = __builtin_amdgcn_readfirstlane(tid >> 6), lane = tid & 63, wr = wid >> 2, wc = wid & 3, fr = lane & 15, fq = lane >> 4;
    const int K = g.K, nt = K / BK;
    unsigned voffA[2], voffB[2];
#pragma unroll
    for (int i = 0; i < 2; ++i) { int R, C; stage_rc(tid * 16 + i * 8192, R, C); const int Rb = Epi::PERM ? ((R & ~31) + perm32(R & 31)) : R;
        voffA[i] = (unsigned)(R * K + C) * 2u; voffB[i] = (unsigned)(Rb * K + C) * 2u; }
    const size_t kstep = (size_t)(BK * 2);
    const size_t hstep = (size_t)HALF * K * 2;
    const size_t tstep = 2 * hstep;
    const unsigned ldsw = (unsigned)wid * 1024u;
    const int aoff = lds_byte(wr * 64 + fr, fq * 8), boff = lds_byte(wc * 32 + fr, fq * 8);
#define PG8_SA(b, h) (((b) * 2 + (h)) * HTB)
#define PG8_SB(b, h) ((4 + (b) * 2 + (h)) * HTB)
#define PG8_STAGE(bufoff, gbase, voff) do { _Pragma("unroll") for (int _i = 0; _i < 2; ++_i) \
        __builtin_amdgcn_global_load_lds((const unsigned*)((const char*)(gbase) + (voff)[_i]), (PG8_LAS unsigned*)(lds + (bufoff) + ldsw + _i * 8192), 16, 0, 0); } while (0)
#define PG8_LDA(dst, b, h) do { _Pragma("unroll") for (int m = 0; m < 4; ++m) _Pragma("unroll") for (int k = 0; k < 2; ++k) dst[m][k] = *(const PG8_LAS bf16x8*)(lds + PG8_SA(b, h) + aoff + m * 2048 + k * 1024); } while (0)
#define PG8_LDB(dst, b, h) do { _Pragma("unroll") for (int n = 0; n < 2; ++n) _Pragma("unroll") for (int k = 0; k < 2; ++k) dst[n][k] = *(const PG8_LAS bf16x8*)(lds + PG8_SB(b, h) + boff + n * 2048 + k * 1024); } while (0)
#define PG8_MMA(ai, bj, At, Bt) do { __builtin_amdgcn_s_setprio(1); _Pragma("unroll") for (int m = 0; m < 4; ++m) _Pragma("unroll") for (int n = 0; n < 2; ++n) _Pragma("unroll") for (int k = 0; k < 2; ++k) \
        acc[ai][bj][m][n] = __builtin_amdgcn_mfma_f32_16x16x32_bf16(Bt[n][k], At[m][k], acc[ai][bj][m][n], 0, 0, 0); __builtin_amdgcn_s_setprio(0); } while (0)
#define PG8_WAIT_V(n) asm volatile("s_waitcnt vmcnt(" #n ")" ::: "memory")
#define PG8_WAIT_L(n) asm volatile("s_waitcnt lgkmcnt(" #n ")" ::: "memory")
#define PG8_BAR __builtin_amdgcn_s_barrier()
#define PG8_SCHED __builtin_amdgcn_sched_barrier(0)
    Unit cur, nxt; int ui = 0;
    if (!S.next(0, cur)) return;
    f32x4 acc[2][2][4][2];
#pragma unroll
    for (int a = 0; a < 2; ++a)
#pragma unroll
        for (int b = 0; b < 2; ++b)
#pragma unroll
            for (int m = 0; m < 4; ++m)
#pragma unroll
                for (int n = 0; n < 2; ++n) acc[a][b][m][n] = (f32x4){0.f, 0.f, 0.f, 0.f};
    bf16x8 At[4][2], B0[2][2], B1[2][2];
    const char* cA = (const char*)g.A + (size_t)cur.pm * tstep; const char* cB = (const char*)g.Bt + (size_t)cur.pn * tstep;
    S.a_ready(cur);
    if constexpr (SP2) {
        PG8_STAGE(PG8_SB(0, 0), cB, voffB); PG8_STAGE(PG8_SB(0, 1), cB + hstep, voffB); PG8_STAGE(PG8_SA(0, 0), cA, voffA); PG8_STAGE(PG8_SA(0, 1), cA + hstep, voffA);
        if (wr == 1) PG8_BAR;
        PG8_WAIT_V(2); PG8_BAR;
        PG8_STAGE(PG8_SB(1, 0), cB + kstep, voffB); PG8_STAGE(PG8_SA(1, 0), cA + kstep, voffA); PG8_STAGE(PG8_SB(1, 1), cB + hstep + kstep, voffB);
        PG8_WAIT_V(6); PG8_BAR;
    } else {
        PG8_STAGE(PG8_SB(0, 0), cB, voffB); PG8_STAGE(PG8_SA(0, 0), cA, voffA); PG8_STAGE(PG8_SB(0, 1), cB + hstep, voffB); PG8_STAGE(PG8_SA(0, 1), cA + hstep, voffA);
        if (wr == 1) PG8_BAR;
        PG8_WAIT_V(4); PG8_BAR;
        PG8_STAGE(PG8_SB(1, 0), cB + kstep, voffB); PG8_STAGE(PG8_SA(1, 0), cA + kstep, voffA); PG8_STAGE(PG8_SB(1, 1), cB + hstep + kstep, voffB);
        PG8_WAIT_V(6); PG8_BAR;
    }
    for (;;) {
        const bool has_next = S.next(ui + 1, nxt);
        const char* nA = has_next ? (const char*)g.A + (size_t)nxt.pm * tstep : cA; const char* nB = has_next ? (const char*)g.Bt + (size_t)nxt.pn * tstep : cB;
        for (int t = 0; t < nt; t += 2) {
            const bool last = (t == nt - 2);
            const char* a1 = cA + (size_t)(t + 1) * kstep;
            const char* a2 = last ? nA : cA + (size_t)(t + 2) * kstep; const char* b2 = last ? nB : cB + (size_t)(t + 2) * kstep;
            const char* a3 = a2 + kstep; const char* b3 = b2 + kstep;
            if (last && has_next) S.a_ready(nxt);
            if constexpr (Epi::KSCALE) E.kscale(acc, t, cur, wr, fr);
            if constexpr (SP2) {
            PG8_LDB(B0, 0, 0); PG8_LDB(B1, 0, 1); PG8_SCHED; PG8_LDA(At, 0, 0); PG8_STAGE(PG8_SA(1, 1), a1 + hstep, voffA);
            PG8_WAIT_V(8); PG8_WAIT_L(0); PG8_BAR; PG8_MMA(0, 0, At, B0); PG8_MMA(0, 1, At, B1); PG8_BAR; PG8_SCHED;
            PG8_LDA(At, 0, 1); PG8_STAGE(PG8_SB(0, 0), b2, voffB); PG8_STAGE(PG8_SB(0, 1), b2 + hstep, voffB); PG8_STAGE(PG8_SA(0, 0), a2, voffA);
            PG8_WAIT_V(8); PG8_WAIT_L(0); PG8_BAR; PG8_MMA(1, 0, At, B0); PG8_MMA(1, 1, At, B1); PG8_BAR; PG8_SCHED;
            PG8_LDB(B0, 1, 0); PG8_LDB(B1, 1, 1); PG8_SCHED; PG8_LDA(At, 1, 0); PG8_STAGE(PG8_SA(0, 1), a2 + hstep, voffA);
            PG8_WAIT_V(8); PG8_WAIT_L(0); PG8_BAR; PG8_MMA(0, 0, At, B0); PG8_MMA(0, 1, At, B1); PG8_BAR; PG8_SCHED;
            PG8_LDA(At, 1, 1); PG8_STAGE(PG8_SB(1, 0), b3, voffB); PG8_STAGE(PG8_SB(1, 1), b3 + hstep, voffB); PG8_STAGE(PG8_SA(1, 0), a3, voffA);
            PG8_WAIT_V(8); PG8_WAIT_L(0); PG8_BAR; PG8_MMA(1, 0, At, B0); PG8_MMA(1, 1, At, B1); PG8_BAR; PG8_SCHED;
            } else {
            PG8_LDB(B0, 0, 0); PG8_SCHED; PG8_LDA(At, 0, 0); PG8_STAGE(PG8_SA(1, 1), a1 + hstep, voffA);
            PG8_WAIT_L(8); PG8_BAR; PG8_WAIT_L(0); PG8_MMA(0, 0, At, B0); PG8_BAR; PG8_SCHED;
            PG8_LDB(B1, 0, 1); PG8_STAGE(PG8_SB(0, 0), b2, voffB);
            PG8_BAR; PG8_WAIT_L(0); PG8_MMA(0, 1, At, B1); PG8_BAR;
            PG8_LDA(At, 0, 1); PG8_STAGE(PG8_SA(0, 0), a2, voffA);
            PG8_BAR; PG8_WAIT_L(0); PG8_MMA(1, 0, At, B0); PG8_BAR; PG8_SCHED;
            PG8_STAGE(PG8_SB(0, 1), b2 + hstep, voffB);
            PG8_WAIT_V(6); PG8_BAR; PG8_MMA(1, 1, At, B1); PG8_BAR;
            PG8_LDB(B0, 1, 0); PG8_SCHED; PG8_LDA(At, 1, 0); PG8_STAGE(PG8_SA(0, 1), a2 + hstep, voffA);
            PG8_WAIT_L(8); PG8_BAR; PG8_WAIT_L(0); PG8_MMA(0, 0, At, B0); PG8_BAR; PG8_SCHED;
            PG8_LDB(B1, 1, 1); PG8_STAGE(PG8_SB(1, 0), b3, voffB);
            PG8_BAR; PG8_WAIT_L(0); PG8_MMA(0, 1, At, B1); PG8_BAR;
            PG8_LDA(At, 1, 1); PG8_STAGE(PG8_SA(1, 0), a3, voffA);
            PG8_BAR; PG8_WAIT_L(0); PG8_MMA(1, 0, At, B0); PG8_BAR; PG8_SCHED;
            PG8_STAGE(PG8_SB(1, 1), b3 + hstep, voffB);
            PG8_WAIT_V(6); PG8_BAR; PG8_MMA(1, 1, At, B1); PG8_BAR;
            }
        }
        if constexpr (ALIGN_EPI) { if (wr == 0) PG8_BAR; }
        if constexpr (!Epi::AFTER_DRAIN) { E(acc, cur, wr, wc, fr, fq); S.done(cur); }
        if (!has_next) break;
#pragma unroll
        for (int a = 0; a < 2; ++a)
#pragma unroll
            for (int b = 0; b < 2; ++b)
#pragma unroll
                for (int m = 0; m < 4; ++m)
#pragma unroll
                    for (int n = 0; n < 2; ++n) acc[a][b][m][n] = (f32x4){0.f, 0.f, 0.f, 0.f};
        cur = nxt; cA = nA; cB = nB; ++ui;
        if constexpr (ALIGN_EPI) { if (wr == 1) PG8_BAR; }
    }
    PG8_WAIT_V(0);
    if constexpr (!ALIGN_EPI) { if (wr == 0) PG8_BAR; }
    PG8_BAR;
    if constexpr (Epi::AFTER_DRAIN) { E.fused(acc, cur, wr, wc, fr, fq, lds, wid, lane); S.done(cur); }
#undef PG8_SA
#undef PG8_SB
#undef PG8_STAGE
#undef PG8_LDA
#undef PG8_LDB
#undef PG8_MMA
#undef PG8_WAIT_V
#undef PG8_WAIT_L
#undef PG8_BAR
#undef PG8_SCHED
}
}
#define LAS __attribute__((address_space(3)))
typedef unsigned short u16;
typedef short bf16x8 __attribute__((ext_vector_type(8)));
typedef float f32x4 __attribute__((ext_vector_type(4)));
typedef unsigned u32x4 __attribute__((ext_vector_type(4)));
typedef unsigned u32x2 __attribute__((ext_vector_type(2)));
typedef LAS unsigned char* ldsp;

constexpr int DM = 1024, NL = 2;
constexpr int MP = 4 * 8192, MS = 128 * 4, M = MP + MS;
constexpr int NPROJ = 3328, NIN = 3344, NMIX = 1536, DFF = 2816, NGU = 5632;
constexpr int C_K = 512, C_V = 640, C_Z = 768, C_X = 1792, C_B = 2816, C_C = 3072;
constexpr float EPS = 1e-6f;
constexpr int NPOS = 8196;

constexpr size_t WS_WIN = 0;
constexpr size_t SZ_WIN = (size_t)NIN * DM * 2;
constexpr size_t WS_WOUT = WS_WIN + NL * SZ_WIN;
constexpr size_t SZ_WOUT = (size_t)DM * NMIX * 2;
constexpr size_t WS_WGU = WS_WOUT + NL * SZ_WOUT;
constexpr size_t SZ_WGU = (size_t)NGU * DM * 2;
constexpr size_t WS_WDN = WS_WGU + NL * SZ_WGU;
constexpr size_t SZ_WDN = (size_t)DM * DFF * 2;
constexpr size_t WS_ROPE = WS_WDN + NL * SZ_WDN;
constexpr size_t SZ_ROPE = (size_t)NPOS * 32 * 4;
constexpr size_t WS_XB = WS_ROPE + 2 * SZ_ROPE;
constexpr size_t WS_SSP = WS_XB + (size_t)M * DM * 2;
constexpr size_t WS_PROJ = WS_SSP + (size_t)M * 16 * 4;
constexpr size_t WS_YMIX = WS_PROJ + (size_t)M * NPROJ * 2;
constexpr size_t WS_DT = WS_YMIX + (size_t)M * NMIX * 2;
constexpr size_t WS_CD = WS_DT + (size_t)MP * 16 * 4;
constexpr size_t WS_ST = WS_CD + (size_t)4 * 64 * 16 * 4;
constexpr size_t WS_END = WS_ST + (size_t)4 * 64 * 16 * 64 * 128 * 2;
constexpr size_t WS_RS = WS_END;
constexpr size_t WS_BAR = WS_RS + (size_t)MP * 2 * 4, SZ_BAR = 16384;
static_assert(WS_BAR + SZ_BAR <= (size_t)4 * MP * DM * 4 && WS_BAR % 256 == 0, "workspace");
static_assert(WS_XB % 256 == 0 && WS_SSP % 256 == 0 && WS_PROJ % 256 == 0 && WS_YMIX % 256 == 0 && WS_DT % 256 == 0 && WS_ST % 256 == 0 && WS_ROPE % 256 == 0, "align");

constexpr size_t O_Y = 0;
constexpr size_t O_KP = (size_t)M * DM;
constexpr size_t O_VP = O_KP + (size_t)2 * 4 * 128 * 128;
constexpr size_t O_CP = O_VP + (size_t)2 * 4 * 128 * 128;
constexpr size_t O_HP = O_CP + (size_t)2 * 4 * 3 * 1536;
constexpr size_t O_KS = O_HP + (size_t)2 * 4 * 16 * 64 * 128;
constexpr size_t O_VS = O_KS + (size_t)2 * 128 * 128 * 128;
constexpr size_t O_CS = O_VS + (size_t)2 * 128 * 128 * 128;
constexpr size_t O_HS = O_CS + (size_t)2 * 128 * 3 * 1536;
constexpr size_t O_END = O_HS + (size_t)2 * 128 * 16 * 64 * 128;

constexpr int LDS_BYTES = 147456;

enum { I_XP = 0, I_XS, I_CK, I_CV, I_SCONV, I_SSSM, I_NMIX, I_WIN, I_QN, I_KN, I_SINK, I_CW, I_CB, I_DTB, I_ALOG, I_DSK, I_SNORM, I_WOUT, I_NFFN, I_WGU, I_WDN };

struct Params { const float* in[21]; float* out; unsigned char* ws; int ph_lo, ph_hi; };

typedef float f32x2_t __attribute__((ext_vector_type(2))); typedef __bf16 bf16x2_t __attribute__((ext_vector_type(2)));
__device__ __forceinline__ unsigned pk2(float lo, float hi) { f32x2_t v = {lo, hi}; bf16x2_t b = __builtin_convertvector(v, bf16x2_t); return __builtin_bit_cast(unsigned, b); }
__device__ __forceinline__ unsigned f2bf(float f) { return pk2(f, 0.f) & 0xffffu; }
__device__ __forceinline__ float bf2f(unsigned h) { return __builtin_bit_cast(float, h << 16); }
__device__ __forceinline__ float bflo(unsigned w) { return __builtin_bit_cast(float, w << 16); }
__device__ __forceinline__ float bfhi(unsigned w) { return __builtin_bit_cast(float, w & 0xffff0000u); }
__device__ __forceinline__ float silu_f(float x) { return x * __builtin_amdgcn_rcpf(1.f + __expf(-x)); }
__device__ __forceinline__ float softplus_f(float x) { return x > 15.f ? x : log1pf(__expf(x)); }
__device__ __forceinline__ float wave_sum(float v) {
#pragma unroll
    for (int o = 1; o < 64; o <<= 1) v += __shfl_xor(v, o);
    return v;
}
__device__ __forceinline__ float wave_max(float v) {
#pragma unroll
    for (int o = 1; o < 64; o <<= 1) v = fmaxf(v, __shfl_xor(v, o));
    return v;
}
__device__ __forceinline__ float wave_incl_scan(float v, int lane) {
#pragma unroll
    for (int off = 1; off < 64; off <<= 1) { const float t = __shfl_up(v, off); if (lane >= off) v += t; }
    return v;
}
__device__ __forceinline__ bf16x8 mk8(u32x2 lo, u32x2 hi) { u32x4 w; w.x = lo.x; w.y = lo.y; w.z = hi.x; w.w = hi.y; return __builtin_bit_cast(bf16x8, w); }
__device__ __forceinline__ bf16x8 lds16(ldsp p) { return __builtin_bit_cast(bf16x8, *(LAS u32x4*)p); }
__device__ __forceinline__ bf16x8 lds8x2(ldsp p0, ldsp p1) { return mk8(*(LAS u32x2*)p0, *(LAS u32x2*)p1); }
__device__ __forceinline__ f32x4 mfma16(bf16x8 a, bf16x8 b, f32x4 c) { return __builtin_amdgcn_mfma_f32_16x16x32_bf16(a, b, c, 0, 0, 0); }
#define LDS_WAIT() asm volatile("s_waitcnt lgkmcnt(0)" ::: "memory")

__device__ __forceinline__ float rstd_row(const float* ssp, int row) {
    const f32x4* p = (const f32x4*)(ssp + (size_t)row * 16);
    const f32x4 a = p[0], b = p[1], c = p[2], d = p[3];
    const float s = (((a.x + a.y) + (a.z + a.w)) + ((b.x + b.y) + (b.z + b.w))) + (((c.x + c.y) + (c.z + c.w)) + ((d.x + d.y) + (d.z + d.w)));
    return rsqrtf(s * (1.f / 1024.f) + EPS);
}

struct EpiProj {
    static constexpr bool PERM = true, AFTER_DRAIN = false, KSCALE = false;
    u16* O; const float* ssp; ldsp rsl;
    __device__ __forceinline__ void operator()(const pg8::f32x4 (&acc)[2][2][4][2], const pg8::Unit& u, int wr, int wc, int fr, int fq) const {
        const int row0 = u.pm * 256 + wr * 64 + fr, col0 = u.pn * 256 + wc * 32 + 8 * fq;
        { const int t = wc * 64 + fq * 16 + fr; if (wr == 0) ((LAS float*)rsl)[t] = rstd_row(ssp, u.pm * 256 + t);
          asm volatile("s_waitcnt lgkmcnt(0)" ::: "memory"); __builtin_amdgcn_s_barrier(); asm volatile("" ::: "memory"); }
#pragma unroll
        for (int ai = 0; ai < 2; ++ai)
#pragma unroll
            for (int m = 0; m < 4; ++m) {
                const int row = row0 + ai * 128 + m * 16; const float rs = ((LAS float*)rsl)[wr * 64 + fr + ai * 128 + m * 16]; u16* rowp = O + (size_t)row * NPROJ + col0;
#pragma unroll
                for (int bj = 0; bj < 2; ++bj) {
                    const f32x4 v0 = acc[ai][bj][m][0] * rs, v1 = acc[ai][bj][m][1] * rs; u32x4 w;
                    w.x = pg8::cvt_pk_bf16(v0[0], v0[1]); w.y = pg8::cvt_pk_bf16(v0[2], v0[3]); w.z = pg8::cvt_pk_bf16(v1[0], v1[1]); w.w = pg8::cvt_pk_bf16(v1[2], v1[3]);
                    *(u32x4*)(rowp + bj * 128) = w; }
            }
    }
};
struct EpiSwiglu {
    static constexpr bool PERM = true, AFTER_DRAIN = false, KSCALE = false;
    u16* O; const float* ssp; ldsp rsl;
    __device__ __forceinline__ void operator()(const pg8::f32x4 (&acc)[2][2][4][2], const pg8::Unit& u, int wr, int wc, int fr, int fq) const {
        const int row0 = u.pm * 256 + wr * 64 + fr, col0 = u.pn * 128 + wc * 32 + 8 * fq;
        { const int t = wc * 64 + fq * 16 + fr; if (wr == 0) ((LAS float*)rsl)[t] = rstd_row(ssp, u.pm * 256 + t);
          asm volatile("s_waitcnt lgkmcnt(0)" ::: "memory"); __builtin_amdgcn_s_barrier(); asm volatile("" ::: "memory"); }
#pragma unroll
        for (int ai = 0; ai < 2; ++ai)
#pragma unroll
            for (int m = 0; m < 4; ++m) {
                const int row = row0 + ai * 128 + m * 16; const float rs = ((LAS float*)rsl)[wr * 64 + fr + ai * 128 + m * 16];
                float h[8];
#pragma unroll
                for (int n = 0; n < 2; ++n)
#pragma unroll
                    for (int j = 0; j < 4; ++j) { const float g = acc[ai][0][m][n][j] * rs, up = acc[ai][1][m][n][j] * rs; h[n * 4 + j] = silu_f(g) * up; }
                u32x4 w; w.x = pg8::cvt_pk_bf16(h[0], h[1]); w.y = pg8::cvt_pk_bf16(h[2], h[3]); w.z = pg8::cvt_pk_bf16(h[4], h[5]); w.w = pg8::cvt_pk_bf16(h[6], h[7]);
                *(u32x4*)(O + (size_t)row * DFF + col0) = w;
            }
    }
};
template <bool KS> struct EpiResT {
    static constexpr bool PERM = false, AFTER_DRAIN = false, KSCALE = KS;
    u16* xb; float* outf; float* ssp; const float* rs;
    __device__ __forceinline__ void kscale(pg8::f32x4 (&acc)[2][2][4][2], int t, const pg8::Unit& u, int wr, int fr) const {
        if (t != 8 && t != 16) return;
#pragma unroll
        for (int ai = 0; ai < 2; ++ai)
#pragma unroll
            for (int m = 0; m < 4; ++m) {
                const int row = u.pm * 256 + wr * 64 + fr + ai * 128 + m * 16; const float s0 = rs[2 * row], s1 = rs[2 * row + 1];
                const float f = t == 8 ? s0 * __builtin_amdgcn_rcpf(s1) : s1;
#pragma unroll
                for (int bj = 0; bj < 2; ++bj)
#pragma unroll
                    for (int n = 0; n < 2; ++n) acc[ai][bj][m][n] = acc[ai][bj][m][n] * f;
            }
    }
    __device__ __forceinline__ void operator()(const pg8::f32x4 (&acc)[2][2][4][2], const pg8::Unit& u, int wr, int wc, int fr, int fq) const {
        const int row0 = u.pm * 256 + wr * 64 + fr, col0 = u.pn * 256 + wc * 32 + 4 * fq;
#pragma unroll
        for (int ai = 0; ai < 2; ++ai) {
            u32x2 rw[4][2][2];
#pragma unroll
            for (int m = 0; m < 4; ++m)
#pragma unroll
                for (int bj = 0; bj < 2; ++bj)
#pragma unroll
                    for (int n = 0; n < 2; ++n) rw[m][bj][n] = *(const u32x2*)(xb + (size_t)(row0 + ai * 128 + m * 16) * DM + col0 + bj * 128 + n * 16);
#pragma unroll
            for (int m = 0; m < 4; ++m) {
                const int row = row0 + ai * 128 + m * 16;
                u16* xp = xb + (size_t)row * DM + col0; float ss = 0.f;
#pragma unroll
                for (int bj = 0; bj < 2; ++bj)
#pragma unroll
                    for (int n = 0; n < 2; ++n) {
                        const u32x2 w0 = rw[m][bj][n]; const f32x4 r = {bflo(w0.x), bfhi(w0.x), bflo(w0.y), bfhi(w0.y)}; const f32x4 v = acc[ai][bj][m][n] + r;
                        if (outf) *(f32x4*)(outf + (size_t)row * DM + col0 + bj * 128 + n * 16) = v;
                        u32x2 w; w.x = pg8::cvt_pk_bf16(v[0], v[1]); w.y = pg8::cvt_pk_bf16(v[2], v[3]);
                        *(u32x2*)(xp + bj * 128 + n * 16) = w; ss += (v[0] * v[0] + v[1] * v[1]) + (v[2] * v[2] + v[3] * v[3]); }
                ss += __shfl_xor(ss, 16); ss += __shfl_xor(ss, 32);
                if (fq == 0) ssp[(size_t)row * 16 + u.pn * 4 + wc] = ss;
            }
        }
    }
};
struct Ctx {
    const float* in[21]; float* out; unsigned char* ws;
    u16 *WinT, *WoutT, *WguT, *WdnT; float *COS, *SIN; u16* XB; float* SSP; u16* PROJ; u16* YMIX; float* DT; float* CD; u16* ST; float* RS;
};

__device__ __forceinline__ void tr_item(const float* __restrict__ W, int K, int N, const float* __restrict__ gk, u16* WT, int perm, LAS float* scr, int item, int lane) {
    const int nblk = (N + 31) >> 5, kb = item / nblk, nb = item - kb * nblk, k0 = 64 * kb, n0 = 32 * nb;
    const int kd0 = perm == 2 ? (k0 < 512 ? k0 + 1024 : k0 - 512) : k0;
    const int nn = n0 + (lane & 31);
    float wv[32];
#pragma unroll
    for (int i = 0; i < 32; ++i) { const int kk = 2 * i + (lane >> 5); wv[i] = (nn < N) ? W[(size_t)(k0 + kk) * N + nn] : 0.f; }
#pragma unroll
    for (int i = 0; i < 32; ++i) { const int kk = 2 * i + (lane >> 5); float v = wv[i]; if (gk) { if (perm == 2) { if (k0 >= 512) v *= gk[k0 + kk - 512]; } else v *= gk[k0 + kk]; } scr[kk * 33 + (lane & 31)] = v; }
    LDS_WAIT(); asm volatile("" ::: "memory");
    const int c = lane & 7;
#pragma unroll
    for (int j = 0; j < 4; ++j) {
        const int nl = (lane >> 3) + 8 * j, n = n0 + nl;
        if (n < N) {
            int dr = n; if (perm == 1) { const int up = n >= DFF, f = up ? n - DFF : n; dr = (f >> 7) * 256 + up * 128 + (f & 127); }
            const LAS float* s = scr + (8 * c) * 33 + nl;
            u32x4 o; o.x = pk2(s[0 * 33], s[1 * 33]); o.y = pk2(s[2 * 33], s[3 * 33]); o.z = pk2(s[4 * 33], s[5 * 33]); o.w = pk2(s[6 * 33], s[7 * 33]);
            *(u32x4*)(WT + (size_t)dr * K + kd0 + 8 * c) = o; }
    }
    LDS_WAIT(); asm volatile("" ::: "memory");
}
constexpr int I_IN = (DM / 64) * ((NIN + 31) / 32), I_OUT = (NMIX / 64) * (DM / 32), I_GU = (DM / 64) * (NGU / 32), I_DN = (DFF / 64) * (DM / 32), I_L = I_IN + I_OUT + I_GU + I_DN;
__device__ __forceinline__ void tr_layer_item(const Ctx& X, int l, int r, LAS float* scr, int lane) {
    if (r < I_IN) { tr_item(X.in[I_WIN] + (size_t)l * DM * NIN, DM, NIN, X.in[I_NMIX] + l * DM, X.WinT + (size_t)l * NIN * DM, 0, scr, r, lane); return; } r -= I_IN;
    if (r < I_OUT) { tr_item(X.in[I_WOUT] + (size_t)l * NMIX * DM, NMIX, DM, X.in[I_SNORM] + l * 1024, X.WoutT + (size_t)l * DM * NMIX, 2, scr, r, lane); return; } r -= I_OUT;
    if (r < I_GU) { tr_item(X.in[I_WGU] + (size_t)l * DM * NGU, DM, NGU, X.in[I_NFFN] + l * DM, X.WguT + (size_t)l * NGU * DM, 1, scr, r, lane); return; } r -= I_GU;
    tr_item(X.in[I_WDN] + (size_t)l * DFF * DM, DFF, DM, nullptr, X.WdnT + (size_t)l * DM * DFF, 0, scr, r, lane);
}
__device__ __forceinline__ void idle_weight_items(const Ctx& X, ldsp L, int stage, int nwg, int G, int bx, int wid, int lane) {
    const int nround = (nwg + G - 1) / G, first_idle = nwg - (nround - 1) * G;
    LAS float* scr = (LAS float*)(L + wid * 16384);
    int nw = (G - first_idle) * 8, wi = (bx - first_idle) * 8 + wid;
    if (first_idle >= G) { nw = G * 8; wi = bx * 8 + wid; }
    else if (bx < first_idle) return;
    if (stage == 0) { for (int r = I_IN + wi; r < I_L; r += nw) tr_layer_item(X, 0, r, scr, lane); }
    else { for (int r = wi; r < I_L; r += nw) tr_layer_item(X, 1, r, scr, lane); }
}
__device__ __forceinline__ void phase_prologue(const Ctx& X, ldsp L, int tid, int wid, int lane) {
    LAS float* scr = (LAS float*)(L + wid * 16384);
    const int gw = blockIdx.x * 8 + wid, NGW = gridDim.x * 8;
    for (int it = gw; it < I_IN; it += NGW) tr_layer_item(X, 0, it, scr, lane);
    for (int rb = gw * 4; rb < M; rb += NGW * 4) {
        f32x4 v[4][4];
#pragma unroll
        for (int rr = 0; rr < 4; ++rr) { const int row = rb + rr; const float* xr = row < MP ? X.in[I_XP] + (size_t)row * DM : X.in[I_XS] + (size_t)(row - MP) * DM;
#pragma unroll
            for (int j = 0; j < 4; ++j) v[rr][j] = ((const f32x4*)xr)[lane + 64 * j]; }
#pragma unroll
        for (int rr = 0; rr < 4; ++rr) { const int row = rb + rr; float ss = 0.f;
#pragma unroll
            for (int j = 0; j < 4; ++j) { const f32x4 w4 = v[rr][j]; ss += (w4.x * w4.x + w4.y * w4.y) + (w4.z * w4.z + w4.w * w4.w);
                u32x2 w; w.x = pk2(w4.x, w4.y); w.y = pk2(w4.z, w4.w); ((u32x2*)(X.XB + (size_t)row * DM))[lane + 64 * j] = w; }
            ss = wave_sum(ss);
            if (lane < 16) X.SSP[(size_t)row * 16 + lane] = lane == 0 ? ss : 0.f; }
    }
    for (int idx = blockIdx.x * 512 + tid; idx < NPOS * 32; idx += gridDim.x * 512) {
        const int pi = idx >> 5, j = idx & 31; const float pos = pi < 8192 ? (float)pi : (float)(16384 + pi - 8192);
        const float inv = powf(10000.f, -(float)j * (1.f / 32.f));
        float sv, cv; sincosf(pos * inv, &sv, &cv); X.COS[idx] = cv; X.SIN[idx] = sv;
    }
}

struct ConvCol { float w0, w1, w2, w3, bias, a, b, c; const u16* p; };
__device__ __forceinline__ void conv_init(ConvCol& cc, const u16* proj, int row, bool havePrev, int xcol, const float* cw, const float* cb) {
    cc.w0 = cw[xcol]; cc.w1 = cw[1536 + xcol]; cc.w2 = cw[2 * 1536 + xcol]; cc.w3 = cw[3 * 1536 + xcol]; cc.bias = cb[xcol];
    cc.p = proj + (size_t)row * NPROJ + C_X + xcol;
    cc.a = havePrev ? bf2f(cc.p[-3 * NPROJ]) : 0.f; cc.b = havePrev ? bf2f(cc.p[-2 * NPROJ]) : 0.f; cc.c = havePrev ? bf2f(cc.p[-1 * NPROJ]) : 0.f;
}
__device__ __forceinline__ float conv_step(ConvCol& cc) {
    const float d = bf2f(*cc.p); cc.p += NPROJ;
    const float v = fmaf(cc.a, cc.w0, fmaf(cc.b, cc.w1, fmaf(cc.c, cc.w2, fmaf(d, cc.w3, cc.bias))));
    cc.a = cc.b; cc.b = cc.c; cc.c = d; return silu_f(v);
}

struct ConvW { float w0, w1, w2, w3, bias; };
__device__ __forceinline__ ConvW conv_w(const float* cw, const float* cb, int xcol) { ConvW w; w.w0 = cw[xcol]; w.w1 = cw[1536 + xcol]; w.w2 = cw[2 * 1536 + xcol]; w.w3 = cw[3 * 1536 + xcol]; w.bias = cb[xcol]; return w; }
template <int NS> __device__ __forceinline__ void conv_load(float (&raw)[NS + 3], const u16* proj, int row, bool havePrev, int xcol) {
    const u16* p = proj + (size_t)row * NPROJ + C_X + xcol;
#pragma unroll
    for (int k = 0; k < NS + 3; ++k) { unsigned v = 0u; if (k >= 3 || havePrev) v = p[(k - 3) * NPROJ]; raw[k] = bf2f(v); }
}
__device__ __forceinline__ float conv_tap(const ConvW& w, float a, float b, float c, float d) { return silu_f(fmaf(a, w.w0, fmaf(b, w.w1, fmaf(c, w.w2, fmaf(d, w.w3, w.bias))))); }

struct ConvW4 { f32x4 w0, w1, w2, w3, bias; };
__device__ __forceinline__ ConvW4 conv4_w(const float* cw, const float* cb, int xcol0) { ConvW4 w; w.w0 = *(const f32x4*)(cw + xcol0); w.w1 = *(const f32x4*)(cw + 1536 + xcol0); w.w2 = *(const f32x4*)(cw + 2 * 1536 + xcol0); w.w3 = *(const f32x4*)(cw + 3 * 1536 + xcol0); w.bias = *(const f32x4*)(cb + xcol0); return w; }
template <int NT> __device__ __forceinline__ void conv4_load(float (&raw)[NT + 3][4], const u16* proj, int row, bool havePrev, int xcol0) {
    const u16* p = proj + (size_t)row * NPROJ + C_X + xcol0;
#pragma unroll
    for (int k = 0; k < NT + 3; ++k) { u32x2 v = {0u, 0u}; if (k >= 3 || havePrev) v = *(const u32x2*)(p + (k - 3) * NPROJ); raw[k][0] = bflo(v.x); raw[k][1] = bfhi(v.x); raw[k][2] = bflo(v.y); raw[k][3] = bfhi(v.y); }
}
#define CONV4_TAP(w, raw, k, e) silu_f(fmaf(raw[(k)][e], w.w0[e], fmaf(raw[(k) + 1][e], w.w1[e], fmaf(raw[(k) + 2][e], w.w2[e], fmaf(raw[(k) + 3][e], w.w3[e], w.bias[e])))))
__device__ __forceinline__ void acum_scan(LAS float* DTL, LAS float* ACL, const float* alog, int wid, int lane) {
#pragma unroll
    for (int hh = 0; hh < 2; ++hh) {
        const int h = 2 * wid + hh; const float A = -expf(alog[h]) * 1.44269504089f;
        float v0 = DTL[h * 128 + lane] * A, v1 = DTL[h * 128 + 64 + lane] * A;
        v0 = wave_incl_scan(v0, lane); v1 = wave_incl_scan(v1, lane); v1 += __shfl(v0, 63);
        ACL[h * 128 + lane] = v0; ACL[h * 128 + 64 + lane] = v1;
    }
}

constexpr int XTP = 132;
__device__ __forceinline__ void ssd_states_unit(const Ctx& X, int l, int b, int c, ldsp L, int tid, int wid, int lane) {
    LAS float* DTL = (LAS float*)L; LAS float* ACL = (LAS float*)(L + 8192);
    LAS u16* BT = (LAS u16*)(L + 16384);
    LAS u16* XT = (LAS u16*)(L + 16384 + 33792);
    const int i = lane & 15, g = lane >> 4, r0 = b * 8192 + c * 128;
    const float* cw = X.in[I_CW] + (size_t)l * 4 * 1536; const float* cb = X.in[I_CB] + (size_t)l * 1536;
    {
        const u16* ap = X.XB + (size_t)(r0 + 16 * wid + i) * DM + 8 * g; const u16* bp = X.WinT + (size_t)l * NIN * DM + (size_t)(NPROJ + i) * DM + 8 * g;
        f32x4 acc = {0.f, 0.f, 0.f, 0.f};
#pragma unroll 16
        for (int kk = 0; kk < 32; ++kk) { const bf16x8 a = *(const bf16x8*)(ap + 32 * kk), w = *(const bf16x8*)(bp + 32 * kk); acc = mfma16(a, w, acc); }
        const float bias = X.in[I_DTB][l * 16 + i];
#pragma unroll
        for (int j = 0; j < 4; ++j) { const int tok = 16 * wid + 4 * g + j; const float dt = softplus_f(acc[j] * rstd_row(X.SSP, r0 + tok) + bias);
            DTL[i * 128 + tok] = dt; X.DT[(size_t)(r0 + tok) * 16 + i] = dt; }
    }
    __syncthreads();
    acum_scan(DTL, ACL, X.in[I_ALOG] + l * 16, wid, lane);
    __syncthreads();
    if (tid < 16) X.CD[(b * 64 + c) * 16 + tid] = __builtin_amdgcn_exp2f(ACL[tid * 128 + 127]);
    LAS float* WSL = (LAS float*)(L + 16384 + 33792 + 67584);
#pragma unroll
    for (int e = 0; e < 4; ++e) { const int idx = tid * 4 + e, h = idx >> 7; WSL[idx] = DTL[idx] * __builtin_amdgcn_exp2f(ACL[h * 128 + 127] - ACL[idx]); }
    __syncthreads();
    for (int hq = 0; hq < 4; ++hq) {
        const int grp = hq >> 1;
        if ((hq & 1) == 0) {
            const int cg = lane & 31, tok0 = 16 * wid + 8 * (lane >> 5), xcol0 = 1024 + 128 * grp + 4 * cg; const ConvW4 w = conv4_w(cw, cb, xcol0);
            float raw[11][4]; conv4_load<8>(raw, X.PROJ, r0 + tok0, !(c == 0 && tok0 == 0), xcol0);
#pragma unroll
            for (int e = 0; e < 4; ++e)
#pragma unroll
                for (int kq = 0; kq < 2; ++kq) { u32x2 pw; pw.x = pk2(CONV4_TAP(w, raw, 4 * kq, e), CONV4_TAP(w, raw, 4 * kq + 1, e)); pw.y = pk2(CONV4_TAP(w, raw, 4 * kq + 2, e), CONV4_TAP(w, raw, 4 * kq + 3, e));
                    *(LAS u32x2*)(BT + (4 * cg + e) * XTP + tok0 + 4 * kq) = pw; }
        }
        {
            const int cg = lane, tok0 = 16 * wid, xcol0 = 256 * hq + 4 * cg, h = 4 * hq + (cg >> 4); const ConvW4 w = conv4_w(cw, cb, xcol0);
            float raw[19][4]; conv4_load<16>(raw, X.PROJ, r0 + tok0, !(c == 0 && tok0 == 0), xcol0);
            float ws[16];
#pragma unroll
            for (int k4 = 0; k4 < 4; ++k4) { const f32x4 t4 = *(LAS f32x4*)(WSL + h * 128 + tok0 + 4 * k4); ws[4 * k4] = t4.x; ws[4 * k4 + 1] = t4.y; ws[4 * k4 + 2] = t4.z; ws[4 * k4 + 3] = t4.w; }
#pragma unroll
            for (int e = 0; e < 4; ++e)
#pragma unroll
                for (int kq = 0; kq < 4; ++kq) { u32x2 pw; pw.x = pk2(CONV4_TAP(w, raw, 4 * kq, e) * ws[4 * kq], CONV4_TAP(w, raw, 4 * kq + 1, e) * ws[4 * kq + 1]); pw.y = pk2(CONV4_TAP(w, raw, 4 * kq + 2, e) * ws[4 * kq + 2], CONV4_TAP(w, raw, 4 * kq + 3, e) * ws[4 * kq + 3]);
                    *(LAS u32x2*)(XT + (4 * cg + e) * XTP + tok0 + 4 * kq) = pw; }
        }
        __syncthreads();
        {
            const int hl = wid >> 1, ph = wid & 1, h = 4 * hq + hl;
            f32x4 acc[2][8];
#pragma unroll
            for (int pp = 0; pp < 2; ++pp)
#pragma unroll
                for (int nt = 0; nt < 8; ++nt) acc[pp][nt] = (f32x4){0.f, 0.f, 0.f, 0.f};
#pragma unroll 1
            for (int ks = 0; ks < 4; ++ks) {
                bf16x8 bfr[8], xfr[2];
#pragma unroll
                for (int nt = 0; nt < 8; ++nt) { ldsp p = (ldsp)(BT + (16 * nt + i) * XTP + 32 * ks + 8 * g); bfr[nt] = lds8x2(p, p + 8); }
#pragma unroll
                for (int pp = 0; pp < 2; ++pp) { ldsp p = (ldsp)(XT + (hl * 64 + 16 * (2 * ph + pp) + i) * XTP + 32 * ks + 8 * g); xfr[pp] = lds8x2(p, p + 8); }
#pragma unroll
                for (int pp = 0; pp < 2; ++pp)
#pragma unroll
                    for (int nt = 0; nt < 8; ++nt) acc[pp][nt] = mfma16(bfr[nt], xfr[pp], acc[pp][nt]);
            }
            u16* sb = X.ST + ((size_t)((b * 64 + c) * 16 + h)) * 8192;
#pragma unroll
            for (int pp = 0; pp < 2; ++pp)
#pragma unroll
                for (int nt = 0; nt < 8; ++nt) { const int p = 16 * (2 * ph + pp) + i, n = 16 * nt + 4 * g; u32x2 w; w.x = pk2(acc[pp][nt][0], acc[pp][nt][1]); w.y = pk2(acc[pp][nt][2], acc[pp][nt][3]);
                    *(u32x2*)(sb + p * 128 + n) = w; }
        }
        __syncthreads();
    }
}

__device__ __forceinline__ void ssd_sample_unit(const Ctx& X, int l, int b, int grp, ldsp L, int tid, int wid, int lane) {
    LAS float* XS = (LAS float*)L;
    LAS float* BS = (LAS float*)(L + 8192);
    LAS float* CS = (LAS float*)(L + 10240);
    LAS float* DTS = (LAS float*)(L + 12288);
    LAS float* YG = (LAS float*)(L + 12544);
    const float* cw = X.in[I_CW] + (size_t)l * 4 * 1536; const float* cb = X.in[I_CB] + (size_t)l * 1536;
    const int row0 = MP + b * 4;
    const int p = tid >> 3, nq = tid & 7, n0 = 16 * nq;
    const float* sbase = X.in[I_SSSM] + ((size_t)((l * 128 + b) * 16 + 8 * grp) * 64 + p) * 128 + n0;
    f32x4 nx[4], nx1[4], nx2[4];
#pragma unroll
    for (int e4 = 0; e4 < 4; ++e4) { nx[e4] = *(const f32x4*)(sbase + 4 * e4); nx1[e4] = *(const f32x4*)(sbase + 8192 + 4 * e4); nx2[e4] = *(const f32x4*)(sbase + 2 * 8192 + 4 * e4); }
    for (int ci = tid; ci < 768; ci += 512) {
        const int xcol = ci < 512 ? 512 * grp + ci : (ci < 640 ? 1024 + 128 * grp + (ci - 512) : 1280 + 128 * grp + (ci - 640));
        float xp[7];
#pragma unroll
        for (int j = 0; j < 3; ++j) xp[j] = X.in[I_SCONV][((size_t)(l * 128 + b) * 3 + j) * 1536 + xcol];
#pragma unroll
        for (int t = 0; t < 4; ++t) xp[3 + t] = bf2f(X.PROJ[(size_t)(row0 + t) * NPROJ + C_X + xcol]);
        const float w0 = cw[xcol], w1 = cw[1536 + xcol], w2 = cw[2 * 1536 + xcol], w3 = cw[3 * 1536 + xcol], bias = cb[xcol];
#pragma unroll
        for (int t = 0; t < 4; ++t) {
            const float v = silu_f(fmaf(xp[t], w0, fmaf(xp[t + 1], w1, fmaf(xp[t + 2], w2, fmaf(xp[t + 3], w3, bias)))));
            if (ci < 512) XS[t * 512 + ci] = v; else if (ci < 640) BS[t * 128 + ci - 512] = v; else CS[t * 128 + ci - 640] = v;
        }
#pragma unroll
        for (int j = 0; j < 3; ++j) X.out[O_CS + ((size_t)(l * 128 + b) * 3 + j) * 1536 + xcol] = xp[4 + j];
    }
    {
        const int h = 8 * grp + wid; const u16* wp = X.WinT + (size_t)l * NIN * DM + (size_t)(NPROJ + h) * DM + lane * 16;
        const u32x4 wa = *(const u32x4*)wp, wb = *(const u32x4*)(wp + 8);
#pragma unroll
        for (int t = 0; t < 4; ++t) {
            const u16* xp = X.XB + (size_t)(row0 + t) * DM + lane * 16; const u32x4 xa = *(const u32x4*)xp, xb = *(const u32x4*)(xp + 8);
            float s = 0.f;
#pragma unroll
            for (int e = 0; e < 4; ++e) { s += bflo(xa[e]) * bflo(wa[e]) + bfhi(xa[e]) * bfhi(wa[e]); s += bflo(xb[e]) * bflo(wb[e]) + bfhi(xb[e]) * bfhi(wb[e]); }
            s = wave_sum(s);
            const float dt = softplus_f(s * rstd_row(X.SSP, row0 + t) + X.in[I_DTB][l * 16 + h]);
            if (lane == 0) DTS[t * 8 + wid] = dt;
        }
    }
    __syncthreads();
#pragma unroll 1
    for (int hh = 0; hh < 8; ++hh) {
        const int h = 8 * grp + hh; const size_t sidx = ((size_t)((l * 128 + b) * 16 + h) * 64 + p) * 128 + n0;
        unsigned zr[4];
#pragma unroll
        for (int t = 0; t < 4; ++t) zr[t] = X.PROJ[(size_t)(row0 + t) * NPROJ + C_Z + 64 * h + p];
        float hst[16];
#pragma unroll
        for (int e4 = 0; e4 < 4; ++e4) { const f32x4 v = nx[e4]; hst[4 * e4] = v.x; hst[4 * e4 + 1] = v.y; hst[4 * e4 + 2] = v.z; hst[4 * e4 + 3] = v.w; nx[e4] = nx1[e4]; nx1[e4] = nx2[e4]; }
        if (hh < 5) {
#pragma unroll
            for (int e4 = 0; e4 < 4; ++e4) nx2[e4] = *(const f32x4*)(sbase + (size_t)(hh + 3) * 8192 + 4 * e4);
        }
        const float A = -expf(X.in[I_ALOG][l * 16 + h]), Dh = X.in[I_DSK][l * 16 + h];
        float y[4];
#pragma unroll
        for (int t = 0; t < 4; ++t) {
            const float dt = DTS[t * 8 + hh], dA = __expf(dt * A), dx = dt * XS[t * 512 + hh * 64 + p]; float acc = 0.f;
#pragma unroll
            for (int e = 0; e < 16; ++e) { hst[e] = fmaf(hst[e], dA, dx * BS[t * 128 + n0 + e]); acc = fmaf(hst[e], CS[t * 128 + n0 + e], acc); }
            y[t] = acc;
        }
#pragma unroll
        for (int e4 = 0; e4 < 4; ++e4) { f32x4 v; v.x = hst[4 * e4]; v.y = hst[4 * e4 + 1]; v.z = hst[4 * e4 + 2]; v.w = hst[4 * e4 + 3]; *(f32x4*)(X.out + O_HS + sidx + 4 * e4) = v; }
#pragma unroll
        for (int t = 0; t < 4; ++t) {
            float yy = y[t]; yy += __shfl_xor(yy, 1); yy += __shfl_xor(yy, 2); yy += __shfl_xor(yy, 4);
            if (nq == 0) { const float yv = yy + Dh * XS[t * 512 + hh * 64 + p]; const float z = bf2f(zr[t]); YG[t * 512 + hh * 64 + p] = yv * silu_f(z); }
        }
    }
    __syncthreads();
    if (wid < 4) {
        const int t = wid; float ss = 0.f;
#pragma unroll
        for (int k = 0; k < 8; ++k) { const float v = YG[t * 512 + lane + 64 * k]; ss += v * v; }
        ss = wave_sum(ss); const float rs = rsqrtf(ss * (1.f / 512.f) + EPS);
#pragma unroll
        for (int k = 0; k < 8; ++k) { const int col = lane + 64 * k; X.YMIX[(size_t)(row0 + t) * NMIX + 512 * grp + col] = (u16)f2bf(YG[t * 512 + col] * rs); }
    }
}
constexpr int KNP = 72;
constexpr int VTP = 264;
__device__ __forceinline__ void attn_prompt_unit(const Ctx& X, int l, int b, int nb, ldsp L, int tid, int wid, int lane) {
    LAS u16* Kn = (LAS u16*)L;
    LAS u16* Vt = (LAS u16*)(L + 73728);
    const int i = lane & 15, g = lane >> 4;
    {
        const int key = tid >> 1, part = tid & 1, tk = nb * 128 - 128 + key; const bool last = (nb == 63) && key >= 128;
        if (tk < 0) {
#pragma unroll
            for (int kvh = 0; kvh < 2; ++kvh) {
                LAS u16* kd = Kn + (kvh * 256 + key) * KNP + 16 * part; LAS u16* vd = Vt + (kvh * 64 + 16 * part) * VTP + key;
                *(LAS u32x4*)(kd) = (u32x4){0u, 0u, 0u, 0u}; *(LAS u32x4*)(kd + 8) = (u32x4){0u, 0u, 0u, 0u}; *(LAS u32x4*)(kd + 32) = (u32x4){0u, 0u, 0u, 0u}; *(LAS u32x4*)(kd + 40) = (u32x4){0u, 0u, 0u, 0u};
#pragma unroll
                for (int d = 0; d < 16; ++d) { vd[d * VTP] = 0; vd[(32 + d) * VTP] = 0; }
            }
        } else {
            const u16* src0 = X.PROJ + (size_t)(b * 8192 + tk) * NPROJ + 16 * part;
            u32x4 kw[2][4], vw[2][4];
#pragma unroll
            for (int kvh = 0; kvh < 2; ++kvh) {
                const u16* src = src0 + 64 * kvh;
                kw[kvh][0] = *(const u32x4*)(src + C_K); kw[kvh][1] = *(const u32x4*)(src + C_K + 8); kw[kvh][2] = *(const u32x4*)(src + C_K + 32); kw[kvh][3] = *(const u32x4*)(src + C_K + 40);
                vw[kvh][0] = *(const u32x4*)(src + C_V); vw[kvh][1] = *(const u32x4*)(src + C_V + 8); vw[kvh][2] = *(const u32x4*)(src + C_V + 32); vw[kvh][3] = *(const u32x4*)(src + C_V + 40);
            }
            float cs[16], sn[16];
            {
                const f32x4* cp = (const f32x4*)(X.COS + (size_t)tk * 32 + 16 * part); const f32x4* sp = (const f32x4*)(X.SIN + (size_t)tk * 32 + 16 * part);
#pragma unroll
                for (int e = 0; e < 4; ++e) { const f32x4 c4 = cp[e], s4 = sp[e]; cs[4 * e] = c4.x; cs[4 * e + 1] = c4.y; cs[4 * e + 2] = c4.z; cs[4 * e + 3] = c4.w; sn[4 * e] = s4.x; sn[4 * e + 1] = s4.y; sn[4 * e + 2] = s4.z; sn[4 * e + 3] = s4.w; }
            }
            const float* kn = X.in[I_KN] + l * 64 + 16 * part;
#pragma unroll
            for (int kvh = 0; kvh < 2; ++kvh) {
                LAS u16* kd = Kn + (kvh * 256 + key) * KNP + 16 * part; LAS u16* vd = Vt + (kvh * 64 + 16 * part) * VTP + key;
                float x1[16], x2[16]; float ss = 0.f;
#pragma unroll
                for (int q = 0; q < 4; ++q) { x1[2 * q] = bflo(kw[kvh][0][q]); x1[2 * q + 1] = bfhi(kw[kvh][0][q]); x1[8 + 2 * q] = bflo(kw[kvh][1][q]); x1[8 + 2 * q + 1] = bfhi(kw[kvh][1][q]);
                    x2[2 * q] = bflo(kw[kvh][2][q]); x2[2 * q + 1] = bfhi(kw[kvh][2][q]); x2[8 + 2 * q] = bflo(kw[kvh][3][q]); x2[8 + 2 * q + 1] = bfhi(kw[kvh][3][q]); }
#pragma unroll
                for (int d = 0; d < 16; ++d) ss += x1[d] * x1[d] + x2[d] * x2[d];
                ss += __shfl_xor(ss, 1);
                const float rs = rsqrtf(ss * (1.f / 64.f) + EPS);
#pragma unroll
                for (int d = 0; d < 16; ++d) { const float u1 = x1[d] * rs * kn[d], u2 = x2[d] * rs * kn[d + 32], c = cs[d], sv = sn[d]; x1[d] = u1 * c - u2 * sv; x2[d] = u2 * c + u1 * sv; }
#pragma unroll
                for (int e = 0; e < 2; ++e) { u32x4 w; w.x = pk2(x1[8 * e], x1[8 * e + 1]); w.y = pk2(x1[8 * e + 2], x1[8 * e + 3]); w.z = pk2(x1[8 * e + 4], x1[8 * e + 5]); w.w = pk2(x1[8 * e + 6], x1[8 * e + 7]); *(LAS u32x4*)(kd + 8 * e) = w;
                    u32x4 v; v.x = pk2(x2[8 * e], x2[8 * e + 1]); v.y = pk2(x2[8 * e + 2], x2[8 * e + 3]); v.z = pk2(x2[8 * e + 4], x2[8 * e + 5]); v.w = pk2(x2[8 * e + 6], x2[8 * e + 7]); *(LAS u32x4*)(kd + 32 + 8 * e) = v; }
                const size_t oidx = (((size_t)(l * 4 + b) * 128 + (key - 128)) * 2 + kvh) * 64 + 16 * part;
                if (last) { float* o = X.out + O_KP + oidx;
#pragma unroll
                    for (int e = 0; e < 4; ++e) { *(f32x4*)(o + 4 * e) = (f32x4){x1[4 * e], x1[4 * e + 1], x1[4 * e + 2], x1[4 * e + 3]}; *(f32x4*)(o + 32 + 4 * e) = (f32x4){x2[4 * e], x2[4 * e + 1], x2[4 * e + 2], x2[4 * e + 3]}; } }
#pragma unroll
                for (int hf = 0; hf < 2; ++hf)
#pragma unroll
                    for (int e = 0; e < 2; ++e) { const u32x4 w = vw[kvh][2 * hf + e];
#pragma unroll
                        for (int q = 0; q < 4; ++q) { vd[(32 * hf + 8 * e + 2 * q) * VTP] = (u16)(w[q] & 0xffffu); vd[(32 * hf + 8 * e + 2 * q + 1) * VTP] = (u16)(w[q] >> 16); }
                        if (last) { float* ov = X.out + O_VP + oidx + 32 * hf + 8 * e; *(f32x4*)(ov) = (f32x4){bflo(w[0]), bfhi(w[0]), bflo(w[1]), bfhi(w[1])}; *(f32x4*)(ov + 4) = (f32x4){bflo(w[2]), bfhi(w[2]), bflo(w[3]), bfhi(w[3])}; } }
            }
        }
    }
    __syncthreads();
    const int kvh = wid >> 2; const float sink = X.in[I_SINK][l * 8 + wid] * 1.44269504089f;
    const float* qn = X.in[I_QN] + l * 64;
    u32x4 nqa, nqb; f32x4 ncs0, ncs1, nsn0, nsn1;
    {
        const int tq0 = nb * 128 + i; const size_t row0q = (size_t)b * 8192 + tq0;
        nqa = *(const u32x4*)(X.PROJ + row0q * NPROJ + 64 * wid + 8 * g); nqb = *(const u32x4*)(X.PROJ + row0q * NPROJ + 64 * wid + 32 + 8 * g);
        ncs0 = *(const f32x4*)(X.COS + (size_t)tq0 * 32 + 8 * g); ncs1 = *(const f32x4*)(X.COS + (size_t)tq0 * 32 + 8 * g + 4);
        nsn0 = *(const f32x4*)(X.SIN + (size_t)tq0 * 32 + 8 * g); nsn1 = *(const f32x4*)(X.SIN + (size_t)tq0 * 32 + 8 * g + 4);
    }
    for (int qt = 0; qt < 8; ++qt) {
        const int qi = 16 * qt + i, tq = nb * 128 + qi; const size_t row = (size_t)b * 8192 + tq;
        bf16x8 qf0, qf1;
        {
            const u32x4 wa = nqa, wb = nqb; const f32x4 c0 = ncs0, c1 = ncs1, s0v = nsn0, s1v = nsn1;
            {
                const int qn_ = qt < 7 ? qt + 1 : 7; const int tqn = nb * 128 + 16 * qn_ + i; const size_t rown = (size_t)b * 8192 + tqn;
                nqa = *(const u32x4*)(X.PROJ + rown * NPROJ + 64 * wid + 8 * g); nqb = *(const u32x4*)(X.PROJ + rown * NPROJ + 64 * wid + 32 + 8 * g);
                ncs0 = *(const f32x4*)(X.COS + (size_t)tqn * 32 + 8 * g); ncs1 = *(const f32x4*)(X.COS + (size_t)tqn * 32 + 8 * g + 4);
                nsn0 = *(const f32x4*)(X.SIN + (size_t)tqn * 32 + 8 * g); nsn1 = *(const f32x4*)(X.SIN + (size_t)tqn * 32 + 8 * g + 4);
            }
            float x1[8], x2[8]; float ss = 0.f;
#pragma unroll
            for (int q = 0; q < 4; ++q) { x1[2 * q] = bflo(wa[q]); x1[2 * q + 1] = bfhi(wa[q]); x2[2 * q] = bflo(wb[q]); x2[2 * q + 1] = bfhi(wb[q]); }
#pragma unroll
            for (int e = 0; e < 8; ++e) ss += x1[e] * x1[e] + x2[e] * x2[e];
            ss += __shfl_xor(ss, 16); ss += __shfl_xor(ss, 32);
            const float rs = rsqrtf(ss * (1.f / 64.f) + EPS) * (0.125f * 1.44269504089f);
            const float cs[8] = {c0.x, c0.y, c0.z, c0.w, c1.x, c1.y, c1.z, c1.w}, sn[8] = {s0v.x, s0v.y, s0v.z, s0v.w, s1v.x, s1v.y, s1v.z, s1v.w};
            float o1[8], o2[8];
#pragma unroll
            for (int e = 0; e < 8; ++e) { const float a = x1[e] * rs * qn[8 * g + e], bb = x2[e] * rs * qn[32 + 8 * g + e], c = cs[e], s = sn[e]; o1[e] = a * c - bb * s; o2[e] = bb * c + a * s; }
            u32x4 w0, w1; w0.x = pk2(o1[0], o1[1]); w0.y = pk2(o1[2], o1[3]); w0.z = pk2(o1[4], o1[5]); w0.w = pk2(o1[6], o1[7]);
            w1.x = pk2(o2[0], o2[1]); w1.y = pk2(o2[2], o2[3]); w1.z = pk2(o2[4], o2[5]); w1.w = pk2(o2[6], o2[7]);
            qf0 = __builtin_bit_cast(bf16x8, w0); qf1 = __builtin_bit_cast(bf16x8, w1);
        }
        f32x4 s[9]; float mx = -INFINITY;
#pragma unroll
        for (int kk = 0; kk < 9; ++kk) {
            const int kt = qt + kk; ldsp kp = (ldsp)(Kn + (kvh * 256 + 16 * kt + i) * KNP + 8 * g);
            f32x4 a = {0.f, 0.f, 0.f, 0.f}; a = mfma16(lds16(kp), qf0, a); a = mfma16(lds16(kp + 64), qf1, a);
#pragma unroll
            for (int j = 0; j < 4; ++j) {
                bool ok = (nb > 0) || (kt >= 8);
                if (kk == 0) ok = ok && (4 * g + j > i);
                if (kk == 8) ok = ok && (4 * g + j <= i);
                a[j] = ok ? a[j] : -INFINITY; mx = fmaxf(mx, a[j]); }
            s[kk] = a;
        }
        mx = fmaxf(mx, __shfl_xor(mx, 16)); mx = fmaxf(mx, __shfl_xor(mx, 32)); mx = fmaxf(mx, sink);
        float sum = 0.f;
#pragma unroll
        for (int kk = 0; kk < 9; ++kk)
#pragma unroll
            for (int j = 0; j < 4; ++j) { const float p = __builtin_amdgcn_exp2f(s[kk][j] - mx); s[kk][j] = p; sum += p; }
        sum += __shfl_xor(sum, 16); sum += __shfl_xor(sum, 32);
        const float inv = __builtin_amdgcn_rcpf(sum + __builtin_amdgcn_exp2f(sink - mx));
        f32x4 o[4];
#pragma unroll
        for (int dt = 0; dt < 4; ++dt) o[dt] = (f32x4){0.f, 0.f, 0.f, 0.f};
#pragma unroll
        for (int pi = 0; pi < 5; ++pi) {
            const int k0 = 2 * pi, k1 = (2 * pi + 1 < 9) ? 2 * pi + 1 : 2 * pi;
            u32x4 pw; pw.x = pk2(s[k0][0], s[k0][1]); pw.y = pk2(s[k0][2], s[k0][3]);
            if (2 * pi + 1 < 9) { pw.z = pk2(s[k1][0], s[k1][1]); pw.w = pk2(s[k1][2], s[k1][3]); } else { pw.z = 0u; pw.w = 0u; }
            const bf16x8 pf = __builtin_bit_cast(bf16x8, pw);
#pragma unroll
            for (int dt = 0; dt < 4; ++dt) {
                LAS u16* vr = Vt + (kvh * 64 + 16 * dt + i) * VTP + 4 * g;
                const bf16x8 vf = lds8x2((ldsp)(vr + 16 * (qt + k0)), (ldsp)(vr + 16 * (qt + k1)));
                o[dt] = mfma16(vf, pf, o[dt]);
            }
        }
#pragma unroll
        for (int dt = 0; dt < 4; ++dt) { u32x2 w; w.x = pk2(o[dt][0] * inv, o[dt][1] * inv); w.y = pk2(o[dt][2] * inv, o[dt][3] * inv);
            *(u32x2*)(X.YMIX + row * NMIX + 1024 + 64 * wid + 16 * dt + 4 * g) = w; }
    }
}

__device__ __forceinline__ void scan_unit(const Ctx& X, int l, int hs, int tid) {
    const int b = hs >> 7, h = (hs >> 3) & 15, pq = hs & 7;
    const int p = 8 * pq + (tid >> 6), n = (tid & 63) * 2;
    u16* base = X.ST + ((size_t)(b * 64) * 16 + h) * 8192 + p * 128 + n;
    const float* cd = X.CD + (b * 64) * 16 + h;
    float h0 = 0.f, h1 = 0.f;
    for (int c0 = 0; c0 < 64; c0 += 32) {
        unsigned st[32]; float dc[32];
#pragma unroll
        for (int e = 0; e < 32; ++e) { st[e] = *(const unsigned*)(base + (size_t)(c0 + e) * 16 * 8192); dc[e] = cd[(c0 + e) * 16]; }
#pragma unroll
        for (int e = 0; e < 32; ++e) {
            *(unsigned*)(base + (size_t)(c0 + e) * 16 * 8192) = pk2(h0, h1);
            h0 = fmaf(h0, dc[e], bflo(st[e])); h1 = fmaf(h1, dc[e], bfhi(st[e]));
        }
    }
    float* o = X.out + O_HP + ((size_t)((l * 4 + b) * 16 + h) * 64 + p) * 128 + n; o[0] = h0; o[1] = h1;
}

constexpr int KCP = 132;
__device__ __forceinline__ void attn_sample_unit(const Ctx& X, int l, int b, ldsp L, int tid, int wid, int lane) {
    LAS u16* KC = (LAS u16*)L;
    LAS u16* VC = (LAS u16*)(L + 34848);
    LAS float* QS = (LAS float*)(L + 69696);
    LAS float* SS = (LAS float*)(L + 77888);
    const int row0 = MP + b * 4;
#pragma unroll
    for (int k = 0; k < 8; ++k) {
        const int idx = tid + 512 * k, j = idx >> 5, c4 = (idx & 31) * 4; const size_t off = ((size_t)(l * 128 + b) * 128 + j) * 128 + c4;
        const f32x4 kv = *(const f32x4*)(X.in[I_CK] + off), vv = *(const f32x4*)(X.in[I_CV] + off);
        { u32x2 kw2; kw2.x = pk2(kv.x, kv.y); kw2.y = pk2(kv.z, kv.w); *(LAS u32x2*)(KC + j * KCP + c4) = kw2; u32x2 vw2; vw2.x = pk2(vv.x, vv.y); vw2.y = pk2(vv.z, vv.w); *(LAS u32x2*)(VC + j * KCP + c4) = vw2; }
        if (j >= 4) { const size_t oo = ((size_t)(l * 128 + b) * 128 + (j - 4)) * 128 + c4; *(f32x4*)(X.out + O_KS + oo) = kv; *(f32x4*)(X.out + O_VS + oo) = vv; }
    }
    {
        const int t = wid >> 1, kvh = wid & 1; const u16* src = X.PROJ + (size_t)(row0 + t) * NPROJ;
        const float x = bf2f(src[C_K + 64 * kvh + lane]); const float ss = wave_sum(x * x);
        const float xn = x * rsqrtf(ss * (1.f / 64.f) + EPS) * X.in[I_KN][l * 64 + lane]; const float pr = __shfl_xor(xn, 32);
        const float c = X.COS[(size_t)(8192 + t) * 32 + (lane & 31)], s = X.SIN[(size_t)(8192 + t) * 32 + (lane & 31)];
        const float o = lane < 32 ? xn * c - pr * s : xn * c + pr * s;
        KC[(128 + t) * KCP + kvh * 64 + lane] = (u16)f2bf(o);
        const size_t oo = ((size_t)(l * 128 + b) * 128 + 124 + t) * 128 + kvh * 64 + lane;
        X.out[O_KS + oo] = o;
        const unsigned vraw = src[C_V + 64 * kvh + lane]; VC[(128 + t) * KCP + kvh * 64 + lane] = (u16)vraw; X.out[O_VS + oo] = bf2f(vraw);
    }
#pragma unroll
    for (int k = 0; k < 4; ++k) {
        const int pair = 4 * wid + k, t = pair >> 3, head = pair & 7;
        const float x = bf2f(X.PROJ[(size_t)(row0 + t) * NPROJ + 64 * head + lane]); const float ss = wave_sum(x * x);
        const float xn = x * rsqrtf(ss * (1.f / 64.f) + EPS) * X.in[I_QN][l * 64 + lane]; const float pr = __shfl_xor(xn, 32);
        const float c = X.COS[(size_t)(8192 + t) * 32 + (lane & 31)], s = X.SIN[(size_t)(8192 + t) * 32 + (lane & 31)];
        QS[pair * 64 + lane] = (lane < 32 ? xn * c - pr * s : xn * c + pr * s) * 0.125f;
    }
    __syncthreads();
    for (int it = 0; it < 9; ++it) {
        const int idx = tid + 512 * it;
        if (idx < 32 * 132) {
            const int pair = idx / 132, key = idx - pair * 132, t = pair >> 3, head = pair & 7, kvh = head >> 2;
            const bool ok = key < 128 ? key > t : (key - 128) <= t;
            float s = 0.f;
#pragma unroll
            for (int d = 0; d < 64; d += 4) { const u32x2 kw2 = *(LAS u32x2*)(KC + key * KCP + kvh * 64 + d); const f32x4 q4 = *(LAS f32x4*)(QS + pair * 64 + d);
                s = fmaf(q4.x, bflo(kw2.x), s); s = fmaf(q4.y, bfhi(kw2.x), s); s = fmaf(q4.z, bflo(kw2.y), s); s = fmaf(q4.w, bfhi(kw2.y), s); }
            SS[pair * 136 + key] = ok ? s : -INFINITY;
        }
    }
    __syncthreads();
#pragma unroll
    for (int k = 0; k < 4; ++k) {
        const int pair = 4 * wid + k, head = pair & 7; const float sink = X.in[I_SINK][l * 8 + head];
        const float v0 = SS[pair * 136 + lane], v1 = SS[pair * 136 + 64 + lane], v2 = lane < 4 ? SS[pair * 136 + 128 + lane] : -INFINITY;
        const float mx = fmaxf(wave_max(fmaxf(fmaxf(v0, v1), v2)), sink);
        const float e0 = __expf(v0 - mx), e1 = __expf(v1 - mx), e2 = __expf(v2 - mx);
        const float inv = 1.f / (wave_sum(e0 + e1 + e2) + __expf(sink - mx));
        SS[pair * 136 + lane] = e0 * inv; SS[pair * 136 + 64 + lane] = e1 * inv; if (lane < 4) SS[pair * 136 + 128 + lane] = e2 * inv;
    }
    __syncthreads();
    {
        const int pair = tid >> 4, d4 = (tid & 15) * 4, head = pair & 7, kvh = head >> 2, t = pair >> 3;
        float a0 = 0.f, a1 = 0.f, a2 = 0.f, a3 = 0.f;
        for (int key = 0; key < 132; ++key) {
            const float p = SS[pair * 136 + key]; const u32x2 vw2 = *(LAS u32x2*)(VC + key * KCP + kvh * 64 + d4); const unsigned w0 = vw2.x, w1 = vw2.y;
            a0 = fmaf(p, bflo(w0), a0); a1 = fmaf(p, bfhi(w0), a1); a2 = fmaf(p, bflo(w1), a2); a3 = fmaf(p, bfhi(w1), a3);
        }
        u32x2 w; w.x = pk2(a0, a1); w.y = pk2(a2, a3); *(u32x2*)(X.YMIX + (size_t)(row0 + t) * NMIX + 1024 + 64 * head + d4) = w;
    }
}

constexpr int CNP = 136;
template <int MODE> __device__ __forceinline__ void ssd_out_unit(const Ctx& X, int l, int b, int c, ldsp L, int tid, int wid, int lane) {
    LAS float* DTL = (LAS float*)L; LAS float* ACL = (LAS float*)(L + 8192);
    LAS u16* CcL = (LAS u16*)(L + 16384);
    LAS u16* CBL = (LAS u16*)(L + 16384 + 34816);
    LAS float* SSQ = (LAS float*)(L + 16384 + 34816 + 18432);
    LAS u16* XT = (LAS u16*)(L + 73728);
    LAS u16* BcL = XT;
    const int i = lane & 15, g = lane >> 4, r0 = b * 8192 + c * 128;
    const float* cw = X.in[I_CW] + (size_t)l * 4 * 1536; const float* cb = X.in[I_CB] + (size_t)l * 1536;
    { const f32x4 d4 = *(const f32x4*)(X.DT + (size_t)r0 * 16 + tid * 4); const int s_ = tid >> 2, h0 = (tid & 3) * 4;
      DTL[(h0 + 0) * 128 + s_] = d4.x; DTL[(h0 + 1) * 128 + s_] = d4.y; DTL[(h0 + 2) * 128 + s_] = d4.z; DTL[(h0 + 3) * 128 + s_] = d4.w; }
    __syncthreads();
    acum_scan(DTL, ACL, X.in[I_ALOG] + l * 16, wid, lane);
    if (c == 63) for (int idx = tid; idx < 3 * 1536; idx += 512) { const int j = idx / 1536, col = idx - j * 1536;
        X.out[O_CP + ((size_t)(l * 4 + b) * 3 + j) * 1536 + col] = bf2f(X.PROJ[(size_t)(b * 8192 + 8189 + j) * NPROJ + C_X + col]); }
    __syncthreads();
    for (int grp = 0; grp < 2; ++grp) {
        {
            const int cg = lane, tok0 = 16 * wid, isC = cg >> 5, n0 = 4 * (cg & 31), xcol0 = 1024 + 256 * isC + 128 * grp + n0; const ConvW4 w = conv4_w(cw, cb, xcol0);
            float raw[19][4]; conv4_load<16>(raw, X.PROJ, r0 + tok0, !(c == 0 && tok0 == 0), xcol0);
            LAS u16* dst = (isC ? CcL : BcL) + tok0 * CNP + n0;
#pragma unroll
            for (int k = 0; k < 16; ++k) { u32x2 pw; pw.x = pk2(CONV4_TAP(w, raw, k, 0), CONV4_TAP(w, raw, k, 1)); pw.y = pk2(CONV4_TAP(w, raw, k, 2), CONV4_TAP(w, raw, k, 3)); *(LAS u32x2*)(dst + k * CNP) = pw; }
        }
        __syncthreads();
        if (MODE != 1) for (int tix = wid; tix < 36; tix += 8) {
            int qt = 0; while ((qt + 1) * (qt + 2) / 2 <= tix) ++qt; const int st = tix - qt * (qt + 1) / 2;
            f32x4 a = {0.f, 0.f, 0.f, 0.f};
#pragma unroll
            for (int kk = 0; kk < 4; ++kk) a = mfma16(lds16((ldsp)(BcL + (16 * st + i) * CNP + 32 * kk + 8 * g)), lds16((ldsp)(CcL + (16 * qt + i) * CNP + 32 * kk + 8 * g)), a);
            { u32x2 cw; cw.x = pk2(a[0], a[1]); cw.y = pk2(a[2], a[3]); *(LAS u32x2*)(CBL + (tix * 64 + lane) * 4) = cw; }
        }
        __syncthreads();
        for (int quad = 0; quad < 2; ++quad) {
            const int hq = 2 * grp + quad;
            bf16x8 hsf[4][4];
            {
                const int cg = lane, tok0 = 16 * wid, xcol0 = 256 * hq + 4 * cg; const ConvW4 w = conv4_w(cw, cb, xcol0);
                float raw[19][4]; conv4_load<16>(raw, X.PROJ, r0 + tok0, !(c == 0 && tok0 == 0), xcol0);
                {
                    const u16* hsb = X.ST + ((size_t)((b * 64 + c) * 16 + 4 * hq + (wid >> 1))) * 8192;
#pragma unroll
                    for (int pt = 0; pt < 4; ++pt)
#pragma unroll
                        for (int kk = 0; kk < 4; ++kk) hsf[pt][kk] = *(const bf16x8*)(hsb + (16 * pt + i) * 128 + 32 * kk + 8 * g);
                }
#pragma unroll
                for (int e = 0; e < 4; ++e)
#pragma unroll
                    for (int kq = 0; kq < 4; ++kq) { u32x2 pw; pw.x = pk2(CONV4_TAP(w, raw, 4 * kq, e), CONV4_TAP(w, raw, 4 * kq + 1, e)); pw.y = pk2(CONV4_TAP(w, raw, 4 * kq + 2, e), CONV4_TAP(w, raw, 4 * kq + 3, e));
                        *(LAS u32x2*)(XT + (4 * cg + e) * XTP + tok0 + 4 * kq) = pw; }
            }
            __syncthreads();
            if (MODE != 1) {
                const int hl = wid >> 1, half = wid & 1, h = 4 * hq + hl, hh = quad * 4 + hl;
                const float Dh = X.in[I_DSK][l * 16 + h];
                for (int qx = 0; qx < 4; ++qx) {
                    const int qt = qx == 0 ? half : (qx == 1 ? 3 - half : (qx == 2 ? 4 + half : 7 - half));
                    const int q = 16 * qt + i; const float aq = ACL[h * 128 + q], eaq = __builtin_amdgcn_exp2f(aq);
                    const size_t row = (size_t)r0 + q; u32x2 zw[4];
#pragma unroll
                    for (int pt = 0; pt < 4; ++pt) zw[pt] = *(const u32x2*)(X.PROJ + row * NPROJ + C_Z + 64 * h + 16 * pt + 4 * g);
                    f32x4 accy[4], acci[4];
#pragma unroll
                    for (int pt = 0; pt < 4; ++pt) { accy[pt] = (f32x4){0.f, 0.f, 0.f, 0.f}; acci[pt] = (f32x4){0.f, 0.f, 0.f, 0.f}; }
#pragma unroll
                    for (int kk = 0; kk < 4; ++kk) { const bf16x8 cf = lds16((ldsp)(CcL + q * CNP + 32 * kk + 8 * g));
#pragma unroll
                        for (int pt = 0; pt < 4; ++pt) accy[pt] = mfma16(hsf[pt][kk], cf, accy[pt]); }
                    const int tb = qt * (qt + 1) / 2, npair = qt / 2 + 1;
                    for (int pi = 0; pi < npair; ++pi) {
                        const int st0 = 2 * pi; const bool has1 = (st0 + 1) <= qt; const int st1 = has1 ? st0 + 1 : st0;
                        float m0[4], m1[4];
                        {
                            const int sa0 = 16 * st0 + 4 * g, sb0 = 16 * st1 + 4 * g;
                            const u32x2 cwa = *(LAS u32x2*)(CBL + ((tb + st0) * 64 + lane) * 4), cwb = *(LAS u32x2*)(CBL + ((tb + st1) * 64 + lane) * 4);
                            const f32x4 aca = *(LAS f32x4*)(ACL + h * 128 + sa0), acb = *(LAS f32x4*)(ACL + h * 128 + sb0);
                            const f32x4 dta = *(LAS f32x4*)(DTL + h * 128 + sa0), dtb = *(LAS f32x4*)(DTL + h * 128 + sb0);
                            const float ca[4] = {bflo(cwa.x), bfhi(cwa.x), bflo(cwa.y), bfhi(cwa.y)}, cb4[4] = {bflo(cwb.x), bfhi(cwb.x), bflo(cwb.y), bfhi(cwb.y)};
#pragma unroll
                            for (int j = 0; j < 4; ++j) {
                                const float va = ca[j] * __builtin_amdgcn_exp2f(aq - aca[j]) * dta[j], vb = cb4[j] * __builtin_amdgcn_exp2f(aq - acb[j]) * dtb[j];
                                const bool dj = (4 * g + j) <= i;
                                m0[j] = (st0 < qt || dj) ? va : 0.f; m1[j] = (has1 && (st1 < qt || dj)) ? vb : 0.f;
                            }
                        }
                        u32x4 mw; mw.x = pk2(m0[0], m0[1]); mw.y = pk2(m0[2], m0[3]); mw.z = pk2(m1[0], m1[1]); mw.w = pk2(m1[2], m1[3]);
                        const bf16x8 mf = __builtin_bit_cast(bf16x8, mw);
#pragma unroll
                        for (int pt = 0; pt < 4; ++pt) { LAS u16* xr = XT + (hl * 64 + 16 * pt + i) * XTP + 4 * g;
                            acci[pt] = mfma16(lds8x2((ldsp)(xr + 16 * st0), (ldsp)(xr + 16 * st1)), mf, acci[pt]); }
                    }
                    float ss = 0.f;
#pragma unroll
                    for (int pt = 0; pt < 4; ++pt) {
                        const int p0 = 16 * pt + 4 * g;
                        const float z[4] = {bflo(zw[pt].x), bfhi(zw[pt].x), bflo(zw[pt].y), bfhi(zw[pt].y)}; float o[4];
#pragma unroll
                        for (int j = 0; j < 4; ++j) { const float xv = bf2f(XT[(hl * 64 + p0 + j) * XTP + q]); const float y = acci[pt][j] + eaq * accy[pt][j] + Dh * xv; o[j] = y * silu_f(z[j]); ss += o[j] * o[j]; }
                        u32x2 w; w.x = pk2(o[0], o[1]); w.y = pk2(o[2], o[3]); *(u32x2*)(X.YMIX + row * NMIX + 64 * h + p0) = w;
                    }
                    ss += __shfl_xor(ss, 16); ss += __shfl_xor(ss, 32);
                    if (g == 0) SSQ[q * 8 + hh] = ss;
                }
            }
            __syncthreads();
        }
        if (MODE == 0 && tid < 128) {
            const f32x4 s0 = *(LAS f32x4*)(SSQ + tid * 8), s1 = *(LAS f32x4*)(SSQ + tid * 8 + 4);
            X.RS[((size_t)r0 + tid) * 2 + grp] = rsqrtf((((s0.x + s0.y) + (s0.z + s0.w)) + ((s1.x + s1.y) + (s1.z + s1.w))) * (1.f / 512.f) + EPS);
        }
        __syncthreads();
    }
}
constexpr int N_PHASES = 1 + 7 * NL;

__device__ __forceinline__ void small_res_unit(const u16* A, const u16* WT, int K, float* outf, u16* xb, float* ssp, int u, ldsp L, int tid, int wid, int lane) {
    const int rt = u >> 4, ct = u & 15, i = lane & 15, g = lane >> 4;
    const int trow = 32 * rt + 16 * (wid >> 2) + i, col0 = 64 * ct + 16 * (wid & 3);
    const u16* ap = A + (size_t)(MP + trow) * K + 8 * g; const u16* wp = WT + (size_t)(col0 + i) * K + 8 * g;
    f32x4 acc = {0.f, 0.f, 0.f, 0.f};
    if (K == NMIX) {
#pragma unroll 24
        for (int kk = 0; kk < NMIX / 32; ++kk) acc = mfma16(*(const bf16x8*)(wp + 32 * kk), *(const bf16x8*)(ap + 32 * kk), acc);
    } else {
#pragma unroll 22
        for (int kk = 0; kk < DFF / 32; ++kk) acc = mfma16(*(const bf16x8*)(wp + 32 * kk), *(const bf16x8*)(ap + 32 * kk), acc);
    }
    const size_t o = (size_t)(MP + trow) * DM + col0 + 4 * g;
    const u32x2 rw = *(const u32x2*)(xb + o); const f32x4 r = {bflo(rw.x), bfhi(rw.x), bflo(rw.y), bfhi(rw.y)};
    const f32x4 v = acc + r;
    if (outf) *(f32x4*)(outf + o) = v;
    u32x2 w; w.x = pk2(v[0], v[1]); w.y = pk2(v[2], v[3]); *(u32x2*)(xb + o) = w;
    float ss = (v[0] * v[0] + v[1] * v[1]) + (v[2] * v[2] + v[3] * v[3]); ss += __shfl_xor(ss, 16); ss += __shfl_xor(ss, 32);
    LAS float* red = (LAS float*)L;
    if (g == 0) red[wid * 16 + i] = ss;
    __syncthreads();
    if (tid < 32) { const int hw = tid >> 4, t = tid & 15; ssp[(size_t)(MP + 32 * rt + 16 * hw + t) * 16 + ct] = (red[(4 * hw) * 16 + t] + red[(4 * hw + 1) * 16 + t]) + (red[(4 * hw + 2) * 16 + t] + red[(4 * hw + 3) * 16 + t]); }
    __syncthreads();
}

__device__ __forceinline__ void small_swiglu_unit(const u16* A, const u16* WT, const float* ssp, u16* H, int u, int wid, int lane) {
    const int rt = u / 44, ct = u - rt * 44, i = lane & 15, g = lane >> 4;
    const int trow = MP + 32 * rt + 16 * (wid >> 2) + i, f0 = 64 * ct + 16 * (wid & 3);
    const int wrow = (f0 >> 7) * 256 + (f0 & 127) + i;
    const u16* ap = A + (size_t)trow * DM + 8 * g; const u16* gp = WT + (size_t)wrow * DM + 8 * g; const u16* up = gp + (size_t)128 * DM;
    f32x4 ag = {0.f, 0.f, 0.f, 0.f}, au = {0.f, 0.f, 0.f, 0.f};
#pragma unroll 8
    for (int kk = 0; kk < DM / 32; ++kk) { const bf16x8 a = *(const bf16x8*)(ap + 32 * kk); ag = mfma16(*(const bf16x8*)(gp + 32 * kk), a, ag); au = mfma16(*(const bf16x8*)(up + 32 * kk), a, au); }
    const float rs = rstd_row(ssp, trow);
    u32x2 w; w.x = pk2(silu_f(ag[0] * rs) * (au[0] * rs), silu_f(ag[1] * rs) * (au[1] * rs)); w.y = pk2(silu_f(ag[2] * rs) * (au[2] * rs), silu_f(ag[3] * rs) * (au[3] * rs));
    *(u32x2*)(H + (size_t)trow * DFF + f0 + 4 * g) = w;
}
#define XB_TMO      128
#define XB_XCNT(j)  (256  + 64 * (j))
#define XB_XSUB(j)  (1280 + 64 * (j))
#define XB_XGEN(j)  (2304 + 64 * (j))
#define XB_TOP      3328
#define XB_TOPGEN   3392
#define XCD_BAR_WORDS 3456
#define XB_SPIN_CAP (1u << 18)

__device__ __forceinline__ unsigned xb_ld(unsigned* p)              { return __hip_atomic_load(p, __ATOMIC_RELAXED, __HIP_MEMORY_SCOPE_AGENT); }
__device__ __forceinline__ unsigned xb_add(unsigned* p, unsigned v) { return __hip_atomic_fetch_add(p, v, __ATOMIC_RELAXED, __HIP_MEMORY_SCOPE_AGENT); }
__device__ __forceinline__ unsigned xb_xcc_id() { return (unsigned)__builtin_amdgcn_s_getreg((3 << 11) | 20) & 0xFu; }
#define XB_SPIN(cond, bar) do { unsigned _sp = 0; while (cond) { __builtin_amdgcn_s_sleep(1); \
    if ((++_sp & 255u) == 0u) { if (xb_ld(&(bar)[XB_TMO])) break; if (_sp > XB_SPIN_CAP) { atomicAdd(&(bar)[XB_TMO], 1u); break; } } } } while (0)

struct XcdBarrier {
    unsigned* bar; unsigned x;
    volatile LAS unsigned* st;
};

__device__ __forceinline__ XcdBarrier xcd_barrier_post(unsigned* bar, volatile LAS unsigned* st) {
    XcdBarrier b; b.bar = bar; b.x = xb_xcc_id(); b.st = st;
    if (threadIdx.x == 0) (void)xb_add(&bar[XB_XCNT(b.x)], 1u);
    return b;
}
__device__ __forceinline__ void xcd_barrier_complete(unsigned* bar, unsigned x, unsigned& nloc, unsigned& nx) {
    const unsigned G = gridDim.x * gridDim.y * gridDim.z;
    unsigned sum, cnt, mine, sp = 0u;
    for (;;) {
        sum = 0u; cnt = 0u; mine = 0u;
#pragma unroll
        for (unsigned j = 0; j < 16; ++j) { const unsigned c = xb_ld(&bar[XB_XCNT(j)]); sum += c; cnt += (c > 0u) ? 1u : 0u; mine = (j == x) ? c : mine; }
        if (sum == G) break;
        __builtin_amdgcn_s_sleep(1);
        if ((++sp & 255u) == 0u) { if (xb_ld(&bar[XB_TMO])) break; if (sp > XB_SPIN_CAP) { atomicAdd(&bar[XB_TMO], 1u); break; } }
    }
    nloc = mine > 0u ? mine : 1u; nx = cnt > 0u ? cnt : 1u;
}

__device__ __forceinline__ void xcd_barrier(const XcdBarrier& b) {
    asm volatile("s_waitcnt vmcnt(0)" ::: "memory");
    __syncthreads();
    if (threadIdx.x == 0) {
        unsigned* bar = b.bar;
        __builtin_amdgcn_s_waitcnt(0);
        unsigned nloc = b.st[0], nx = b.st[1];
        if (nloc == 0u) { xcd_barrier_complete(bar, b.x, nloc, nx); b.st[0] = nloc; b.st[1] = nx; }
        const unsigned old = xb_add(&bar[XB_XSUB(b.x)], 1u);
        const unsigned gen = old / nloc;
        if (old + 1u == (gen + 1u) * nloc) {
            __builtin_amdgcn_fence(__ATOMIC_RELEASE, "agent");
            asm volatile("s_waitcnt vmcnt(0)" ::: "memory");
            const unsigned og = xb_add(&bar[XB_TOP], 1u);
            const unsigned tg = og / nx;
            if (og + 1u == (tg + 1u) * nx) xb_add(&bar[XB_TOPGEN], 1u);
            else XB_SPIN(xb_ld(&bar[XB_TOPGEN]) == tg, bar);
            __builtin_amdgcn_fence(__ATOMIC_ACQUIRE, "agent");
            xb_add(&bar[XB_XGEN(b.x)], 1u);
            asm volatile("s_waitcnt vmcnt(0)" ::: "memory");
        } else {
            XB_SPIN(xb_ld(&bar[XB_XGEN(b.x)]) == gen, bar);
            __builtin_amdgcn_fence(__ATOMIC_ACQUIRE, "agent");
            asm volatile("s_waitcnt vmcnt(0)" ::: "memory");
        }
    }
    __syncthreads();
}

#ifndef REP_SUB
#define REP_SUB 0
#endif
#ifndef REP_PH
#define REP_PH -1
#endif
#ifndef REP_MASK
#define REP_MASK 0
#endif
#ifndef UN_MASK
#define UN_MASK 31
#endif
#ifndef PH_MASK
#define PH_MASK 255
#endif
__global__ void __launch_bounds__(512, 2) hymba_mk(Params P) {
    extern __shared__ __attribute__((aligned(16))) unsigned char lds_raw[];
    ldsp L = (ldsp)lds_raw;
    u16* HB;
    volatile LAS unsigned* bst = (volatile LAS unsigned*)(L + LDS_BYTES - 64);
    if (threadIdx.x < 2) bst[threadIdx.x] = 0u;
    __syncthreads();
    const XcdBarrier xbar = xcd_barrier_post((unsigned*)(P.ws + WS_BAR), bst);
    if (P.ph_hi < 0) cg::this_grid().sync();
    for (int phi = P.ph_lo; phi < P.ph_hi + (REP_PH >= 0 ? 1 : 0); ++phi) {
        if (phi > P.ph_lo) xcd_barrier(xbar);
        const int ph = (REP_PH >= 0 && phi > REP_PH) ? phi - 1 : phi; const int rep = (REP_PH >= 0 && phi == REP_PH + 1) ? 1 : 0;
#ifdef EXTRA_SYNCS
        if (phi == 1) for (int es = 0; es < EXTRA_SYNCS; ++es) xcd_barrier(xbar);
#endif
        const __attribute__((address_space(4))) Params* pp = (const __attribute__((address_space(4))) Params*)__builtin_amdgcn_kernarg_segment_ptr();
        asm volatile("" : "+s"(pp));
        int tid = threadIdx.x; asm volatile("" : "+v"(tid));
        int bx = blockIdx.x, G = gridDim.x; asm volatile("" : "+s"(bx), "+s"(G));
        const int lane = tid & 63, wid = __builtin_amdgcn_readfirstlane(tid >> 6);
        Ctx X;
#pragma unroll
        for (int k = 0; k < 21; ++k) X.in[k] = pp->in[k];
        X.out = pp->out; X.ws = pp->ws;
        X.WinT = (u16*)(X.ws + WS_WIN); X.WoutT = (u16*)(X.ws + WS_WOUT); X.WguT = (u16*)(X.ws + WS_WGU); X.WdnT = (u16*)(X.ws + WS_WDN);
        X.COS = (float*)(X.ws + WS_ROPE); X.SIN = (float*)(X.ws + WS_ROPE + SZ_ROPE); X.XB = (u16*)(X.ws + WS_XB); X.SSP = (float*)(X.ws + WS_SSP);
        X.PROJ = (u16*)(X.ws + WS_PROJ); X.YMIX = (u16*)(X.ws + WS_YMIX); X.DT = (float*)(X.ws + WS_DT); X.CD = (float*)(X.ws + WS_CD); X.ST = (u16*)(X.ws + WS_ST); X.RS = (float*)(X.ws + WS_RS);
        HB = X.PROJ;
        if (ph == 0) { if (PH_MASK & 128) phase_prologue(X, L, tid, wid, lane); if (REP_MASK & 128) { __syncthreads(); phase_prologue(X, L, tid, wid, lane); } continue; }
        const int l = (ph - 1) / 7, k = (ph - 1) % 7;
        {
        if (k == 0 && (PH_MASK & 1)) {
            pg8::Gemm g{X.XB, X.WinT + (size_t)l * NIN * DM, M, NPROJ, DM}; pg8::StaticOrder S; S.init(M, NPROJ, G, bx);
            EpiProj E{X.PROJ, X.SSP, L + 131072};
            pg8::gemm_phase<EpiProj, pg8::StaticOrder, true, true>(L, g, S, E, tid);
            if (l == 0 && rep == 0) idle_weight_items(X, L, 0, 130 * 13, G, bx, wid, lane);
        } else if (k == 1 && (PH_MASK & 2)) {
            for (int u = bx; u < 512; u += G) {
                __syncthreads(); asm volatile("" : "+v"(tid)); const int lane = tid & 63, wid = __builtin_amdgcn_readfirstlane(tid >> 6);
                if (rep && REP_SUB == 1 && u >= 256) continue; if (rep && REP_SUB == 2 && u < 256) continue;
                if (u < 256) { if (UN_MASK & 8) ssd_states_unit(X, l, u >> 6, u & 63, L, tid, wid, lane); }
                else { if (UN_MASK & 16) ssd_sample_unit(X, l, (u - 256) >> 1, (u - 256) & 1, L, tid, wid, lane); }
            }
        } else if (k == 2 && (PH_MASK & 4)) {
#define PHB_SYNC() do { __syncthreads(); asm volatile("" : "+v"(tid)); } while (0)
            for (int u = bx; u < 256; u += G) { PHB_SYNC(); const int lane = tid & 63, wid = __builtin_amdgcn_readfirstlane(tid >> 6); attn_prompt_unit(X, l, u >> 6, u & 63, L, tid, wid, lane); }
            for (int u = bx; u < 128; u += G) { PHB_SYNC(); const int lane = tid & 63, wid = __builtin_amdgcn_readfirstlane(tid >> 6); attn_sample_unit(X, l, u, L, tid, wid, lane); }
            {
                int s0 = bx, sn = bx < 512 ? (512 - bx + G - 1) / G : 0, ss = G;
                if (G == 256) { if (bx < 128) { s0 = bx; sn = 1; ss = 1; } else { s0 = 128 + 3 * (bx - 128); sn = 3; ss = 1; } }
                if (rep == 0) for (int i2 = 0; i2 < sn; ++i2) scan_unit(X, l, s0 + i2 * ss, tid);
            }
        } else if (k == 3 && (PH_MASK & 8)) {
            for (int u = bx; u < 256; u += G) { __syncthreads(); asm volatile("" : "+v"(tid)); const int lane = tid & 63, wid = __builtin_amdgcn_readfirstlane(tid >> 6); if (rep && REP_SUB != 0) ssd_out_unit<REP_SUB>(X, l, u >> 6, u & 63, L, tid, wid, lane); else ssd_out_unit<0>(X, l, u >> 6, u & 63, L, tid, wid, lane); }
        } else if (k == 4 && (PH_MASK & 16)) {
            pg8::Gemm g{X.YMIX, X.WoutT + (size_t)l * DM * NMIX, MP, DM, NMIX}; pg8::StaticOrder S; S.init(MP, DM, G, bx);
            EpiResT<true> E{X.XB, nullptr, X.SSP, X.RS};
            pg8::gemm_phase<EpiResT<true>, pg8::StaticOrder, true, true>(L, g, S, E, tid);
            for (int u = bx; u < 256; u += G) small_res_unit(X.YMIX, X.WoutT + (size_t)l * DM * NMIX, NMIX, nullptr, X.XB, X.SSP, u, L, tid, wid, lane);
#if (REP_MASK & 256)
            if (l == 0) for (int rr = 0; rr < 4; ++rr) for (int u = bx; u < 256; u += G) small_res_unit(X.YMIX, X.WoutT + (size_t)l * DM * NMIX, NMIX, nullptr, X.XB, X.SSP, u, L, tid, wid, lane);
#endif
        } else if (k == 5 && (PH_MASK & 32)) {
            pg8::Gemm g{X.XB, X.WguT + (size_t)l * NGU * DM, M, NGU, DM}; pg8::StaticOrder S; S.init(M, NGU, G, bx);
            EpiSwiglu E{HB, X.SSP, L + 131072};
            pg8::gemm_phase<EpiSwiglu, pg8::StaticOrder, true, true>(L, g, S, E, tid);
            if (l == 0 && rep == 0) idle_weight_items(X, L, 1, 130 * 22, G, bx, wid, lane);
        } else if (PH_MASK & 64) {
            pg8::Gemm g{HB, X.WdnT + (size_t)l * DM * DFF, MP, DM, DFF}; pg8::StaticOrder S; S.init(MP, DM, G, bx);
            EpiResT<false> E{X.XB, l == NL - 1 ? X.out : nullptr, X.SSP, nullptr};
            pg8::gemm_phase<EpiResT<false>, pg8::StaticOrder, true, true>(L, g, S, E, tid);
            for (int u = bx; u < 256; u += G) small_res_unit(HB, X.WdnT + (size_t)l * DM * DFF, DFF, l == NL - 1 ? X.out : nullptr, X.XB, X.SSP, u, L, tid, wid, lane);
        }
        }
    }
}

#ifndef MK_ONE_LAUNCH
#define MK_ONE_LAUNCH 1
#endif
extern "C" void kernel_launch(void* const* d_in, const int* in_sizes, int n_in, void* d_out, int out_size, void* d_ws, size_t ws_size, hipStream_t stream) {
    static int grid = 0;
    if (grid == 0) {
        if (n_in != 21 || (size_t)out_size != O_END || ws_size < WS_BAR + SZ_BAR) { fprintf(stderr, "kernel_launch: unexpected shapes (n_in %d out %d ws %zu)\n", n_in, out_size, ws_size); grid = -1; return; }
        int dev = 0, cus = 0, per_cu = 0;
        (void)hipGetDevice(&dev); (void)hipDeviceGetAttribute(&cus, hipDeviceAttributeMultiprocessorCount, dev);
        if (hipFuncSetAttribute((const void*)hymba_mk, hipFuncAttributeMaxDynamicSharedMemorySize, LDS_BYTES) != hipSuccess) { fprintf(stderr, "kernel_launch: hipFuncSetAttribute failed\n"); grid = -1; return; }
        if (hipOccupancyMaxActiveBlocksPerMultiprocessor(&per_cu, (const void*)hymba_mk, 512, LDS_BYTES) != hipSuccess || per_cu < 1) { fprintf(stderr, "kernel_launch: occupancy query gave %d\n", per_cu); per_cu = 1; }
        (void)hipGetLastError();
        grid = cus * per_cu;
    }
    if (grid < 0) return;
    Params p{};
    for (int i = 0; i < 21; ++i) p.in[i] = (const float*)d_in[i];
    p.out = (float*)d_out; p.ws = (unsigned char*)d_ws;
#if MK_ONE_LAUNCH
    p.ph_lo = 0; p.ph_hi = N_PHASES;
    (void)hipMemsetAsync((unsigned char*)d_ws + WS_BAR, 0, SZ_BAR, stream);
    void* args[] = {&p};
    hipError_t e = hipLaunchCooperativeKernel((const void*)hymba_mk, dim3(grid), dim3(512), args, LDS_BYTES, stream);
    if (e != hipSuccess) fprintf(stderr, "cooperative launch failed: %s (grid %d)\n", hipGetErrorString(e), grid);
#else
    for (int ph = 0; ph < N_PHASES; ++ph) { p.ph_lo = ph; p.ph_hi = ph + 1; hipLaunchKernelGGL(hymba_mk, dim3(grid), dim3(512), LDS_BYTES, stream, p); }
#endif
}
```
